# Optimizing an MI355X kernel written in HIP

```python
import math
import jax, jax.numpy as jnp
from jax import lax
import numpy as np

D_MODEL = 1024
BATCH = 2
SEQ = 16384
DEPTH = 4

BRANCH_WIDTH = 512
N_BRANCHES = 3
HEAD_DIM = 64
NSA_HEADS = BRANCH_WIDTH // HEAD_DIM
NSA_KV_GROUPS = 2
NSA_GROUP = NSA_HEADS // NSA_KV_GROUPS
NSA_WIDTH = NSA_HEADS * HEAD_DIM
CMP_LEN = 32
CMP_STRIDE = 16
SLC_BLOCK = 64
SLC_TOPN = 16
WINDOW = 512
CMP_HIDDEN = 256
Q_BLOCK = 128
CONV_WIDTH = BRANCH_WIDTH
CONV_K = 3
RET_HEADS = 4
RET_HEAD_DIM = BRANCH_WIDTH // RET_HEADS
RET_WIDTH = RET_HEADS * RET_HEAD_DIM
RET_CHUNK = 128
ROPE_BASE = 10000.0
D_FF = 3584
N_EXPERTS = 8
TOP_K = 2
N_DENSE = (DEPTH + 1) // 2
N_MOE = DEPTH // 2
LN_EPS = 1e-5
ALPHA = (2.0 * DEPTH) ** 0.25
BETA = (8.0 * DEPTH) ** -0.25
SPLIT_SIZES = (NSA_WIDTH, 6 * NSA_KV_GROUPS * HEAD_DIM, 3 * NSA_HEADS,
               CONV_WIDTH, CONV_WIDTH, CONV_WIDTH,
               RET_WIDTH, RET_WIDTH, RET_WIDTH, RET_WIDTH,
               N_BRANCHES * D_MODEL)
IN_COLS = sum(SPLIT_SIZES)

kernel_name = "hybrid_nsa_conv_retention_moe_deepnorm"


def split_points():
    pts, acc = [], 0
    for s in SPLIT_SIZES[:-1]:
        acc += s
        pts.append(acc)
    return pts


def layer_norm(x, g, b):
    xf = x.astype(jnp.float32)
    mu = xf.mean(-1, keepdims=True)
    var = jnp.square(xf - mu).mean(-1, keepdims=True)
    return ((xf - mu) * lax.rsqrt(var + LN_EPS)).astype(x.dtype) * g + b


def masked_softmax(s, mask):
    s = jnp.where(mask, s.astype(jnp.float32), -jnp.inf)
    m = jnp.max(s, axis=-1, keepdims=True)
    m = jnp.where(jnp.isfinite(m), m, 0.0)
    p = jnp.exp(s - m)
    return p / jnp.maximum(p.sum(-1, keepdims=True), 1e-30)


def nsa_compress(kv, pos, w1, b1, w2, b2):
    b, t, g, dh = kv.shape
    chunks = kv.reshape(b, t // CMP_STRIDE, CMP_STRIDE, g, dh)
    blocks = jnp.concatenate([chunks[:, :-1], chunks[:, 1:]], axis=2) + pos[:, None, :]
    nc = blocks.shape[1]
    flat = blocks.transpose(0, 1, 3, 2, 4).reshape(b, nc, g, CMP_LEN * dh)
    hid = jax.nn.gelu(flat @ w1 + b1)
    return hid @ w2 + b2


def nsa_attention(q, k_cmp, v_cmp, k_slc, v_slc, k_win, v_win, gates):
    b, t, h, dh = q.shape
    G, R = NSA_KV_GROUPS, NSA_GROUP
    qg = q.reshape(b, t, G, R, dh).transpose(0, 2, 3, 1, 4) * (dh ** -0.5)
    kc = k_cmp.transpose(0, 2, 1, 3)
    vc = v_cmp.transpose(0, 2, 1, 3)
    nc = kc.shape[2]
    n_sel = t // SLC_BLOCK
    topn = min(SLC_TOPN, n_sel)
    ratio = SLC_BLOCK // CMP_STRIDE
    ks = k_slc.transpose(0, 2, 1, 3).reshape(b, G, n_sel, SLC_BLOCK, dh)
    vs = v_slc.transpose(0, 2, 1, 3).reshape(b, G, n_sel, SLC_BLOCK, dh)
    pad_w = ((0, 0), (0, 0), (WINDOW, 0), (0, 0))
    kw = jnp.pad(k_win.transpose(0, 2, 1, 3), pad_w)
    vw = jnp.pad(v_win.transpose(0, 2, 1, 3), pad_w)
    cmp_end = jnp.arange(nc) * CMP_STRIDE + CMP_LEN - 1
    right_pad = ratio * (n_sel + 1) - 1 - nc
    b_idx = jnp.arange(b)[:, None, None, None]
    g_idx = jnp.arange(G)[None, :, None, None]
    j_blk = jnp.arange(n_sel)

    def block_fn(qb):
        q0 = qb * Q_BLOCK
        tq = q0 + jnp.arange(Q_BLOCK)
        qq = lax.dynamic_slice_in_dim(qg, q0, Q_BLOCK, axis=3)
        s_c = jnp.einsum('bgrqd,bgnd->bgrqn', qq, kc)
        p_c = masked_softmax(s_c, cmp_end[None, :] <= tq[:, None])
        o_c = jnp.einsum('bgrqn,bgnd->bgrqd', p_c.astype(vc.dtype), vc)
        p_grp = p_c.sum(axis=2)
        p_pad = jnp.pad(p_grp, ((0, 0), (0, 0), (0, 0), (1, right_pad)))
        P = p_pad.reshape(b, G, Q_BLOCK, n_sel + 1, ratio)
        score = (P[..., :n_sel, 0] + 2.0 * (P[..., :n_sel, 1] + P[..., :n_sel, 2] + P[..., :n_sel, 3])
                 + P[..., 1:, 0])
        cur = tq // SLC_BLOCK
        valid = j_blk[None, :] <= cur[:, None]
        forced = (j_blk[None, :] == 0) | (j_blk[None, :] == cur[:, None]) | (j_blk[None, :] == cur[:, None] - 1)
        score = jnp.where(forced, 1e9, score)
        score = jnp.where(valid, score, -1.0)
        _, idx = lax.top_k(score, topn)
        k_sel = ks[b_idx, g_idx, idx]
        v_sel = vs[b_idx, g_idx, idx]
        s_s = jnp.einsum('bgrqd,bgqnkd->bgrqnk', qq, k_sel).reshape(b, G, R, Q_BLOCK, -1)
        kpos_s = idx[..., None] * SLC_BLOCK + jnp.arange(SLC_BLOCK)
        m_s = (kpos_s <= tq[None, None, :, None, None]).reshape(b, G, 1, Q_BLOCK, -1)
        p_s = masked_softmax(s_s, m_s).reshape(b, G, R, Q_BLOCK, topn, SLC_BLOCK)
        o_s = jnp.einsum('bgrqnk,bgqnkd->bgrqd', p_s.astype(v_sel.dtype), v_sel)
        kwb = lax.dynamic_slice_in_dim(kw, q0, Q_BLOCK + WINDOW, axis=2)
        vwb = lax.dynamic_slice_in_dim(vw, q0, Q_BLOCK + WINDOW, axis=2)
        kpos_w = q0 - WINDOW + jnp.arange(Q_BLOCK + WINDOW)
        m_w = ((kpos_w[None, :] <= tq[:, None]) & (kpos_w[None, :] > tq[:, None] - WINDOW)
               & (kpos_w[None, :] >= 0))
        s_w = jnp.einsum('bgrqd,bgkd->bgrqk', qq, kwb)
        p_w = masked_softmax(s_w, m_w)
        o_w = jnp.einsum('bgrqk,bgkd->bgrqd', p_w.astype(vwb.dtype), vwb)
        return o_c, o_s, o_w

    o_c, o_s, o_w = lax.map(block_fn, jnp.arange(t // Q_BLOCK))

    def to_bthd(o):
        return o.transpose(1, 0, 4, 2, 3, 5).reshape(b, t, h, dh)

    y = gates[..., 0:1] * to_bthd(o_c) + gates[..., 1:2] * to_bthd(o_s) + gates[..., 2:3] * to_bthd(o_w)
    return y.reshape(b, t, h * dh)


def short_conv(bx, cx, hx, w_conv):
    u = cx * hx
    y = lax.conv_general_dilated(u, w_conv[:, None, :], window_strides=(1,), padding=((CONV_K - 1, 0),),
                                 dimension_numbers=('NWC', 'WIO', 'NWC'), feature_group_count=CONV_WIDTH)
    return bx * y


def rotary(x, pos):
    d = x.shape[-1]
    inv = ROPE_BASE ** (-jnp.arange(0, d, 2, dtype=jnp.float32) / d)
    ang = pos.astype(jnp.float32)[:, None] * inv[None, :]
    cos = jnp.cos(ang)[None, :, None, :].astype(x.dtype)
    sin = jnp.sin(ang)[None, :, None, :].astype(x.dtype)
    x1, x2 = x[..., : d // 2], x[..., d // 2:]
    return jnp.concatenate([x1 * cos - x2 * sin, x1 * sin + x2 * cos], axis=-1)


def retention(q, k, v):
    b, t, h, d = q.shape
    C = RET_CHUNK
    n = t // C
    log_g = jnp.log(1.0 - 2.0 ** (-5.0 - jnp.arange(h, dtype=jnp.float32)))
    idx = jnp.arange(C, dtype=jnp.float32)
    diff = idx[:, None] - idx[None, :]
    decay_in = jnp.where(diff >= 0, jnp.exp(log_g[:, None, None] * jnp.maximum(diff, 0.0)), 0.0)
    q_dec = jnp.exp(log_g[:, None] * (idx + 1.0))[None, :, :, None]
    k_dec = jnp.exp(log_g[:, None] * (C - 1.0 - idx))[None, :, :, None]
    chunk_dec = jnp.exp(log_g * C)[None, :, None, None]

    def chunks(a):
        return a.astype(jnp.float32).reshape(b, n, C, h, d).transpose(1, 0, 3, 2, 4)

    def step(state, inp):
        qi, ki, vi = inp
        inner = jnp.einsum('bhqd,bhkd->bhqk', qi, ki) * decay_in
        o = jnp.einsum('bhqk,bhkd->bhqd', inner, vi) + jnp.einsum('bhqd,bhde->bhqe', qi, state) * q_dec
        state = state * chunk_dec + jnp.einsum('bhkd,bhke->bhde', ki * k_dec, vi)
        return state, o

    state0 = jnp.zeros((b, h, d, d), jnp.float32)
    _, o = lax.scan(step, state0, (chunks(q), chunks(k), chunks(v)))
    return o.transpose(1, 0, 3, 2, 4).reshape(b, t, h, d).astype(q.dtype)


def group_norm(o, g, bias):
    of = o.astype(jnp.float32)
    mu = of.mean(-1, keepdims=True)
    var = jnp.square(of - mu).mean(-1, keepdims=True)
    y = ((of - mu) * lax.rsqrt(var + LN_EPS)).astype(o.dtype)
    return y.reshape(o.shape[0], o.shape[1], -1) * g + bias


def token_mixer(x, w_in, cmp_pos, cmp_w1, cmp_b1, cmp_w2, cmp_b2, conv_w, gn_g, gn_b, w_br, w_out):
    b, t, _ = x.shape
    hcat = x @ w_in
    (q, kv, ngate, cb, cc, ch, rq, rk, rv, rg, mgate) = jnp.split(hcat, split_points(), axis=-1)
    q = q.reshape(b, t, NSA_HEADS, HEAD_DIM)
    kv = kv.reshape(b, t, 3, 2, NSA_KV_GROUPS, HEAD_DIM)
    k_cmp = nsa_compress(kv[:, :, 0, 0], cmp_pos[0], cmp_w1[0], cmp_b1[0], cmp_w2[0], cmp_b2[0])
    v_cmp = nsa_compress(kv[:, :, 0, 1], cmp_pos[1], cmp_w1[1], cmp_b1[1], cmp_w2[1], cmp_b2[1])
    nsa_g = jax.nn.sigmoid(ngate).reshape(b, t, NSA_HEADS, 3)
    y_a = nsa_attention(q, k_cmp, v_cmp, kv[:, :, 1, 0], kv[:, :, 1, 1], kv[:, :, 2, 0], kv[:, :, 2, 1], nsa_g)
    y_b = short_conv(cb, cc, ch, conv_w)
    pos = jnp.arange(t)
    rq = rotary(rq.reshape(b, t, RET_HEADS, RET_HEAD_DIM), pos)
    rk = rotary(rk.reshape(b, t, RET_HEADS, RET_HEAD_DIM), pos) * (RET_HEAD_DIM ** -0.5)
    o_r = retention(rq, rk, rv.reshape(b, t, RET_HEADS, RET_HEAD_DIM))
    y_c = jax.nn.silu(rg) * group_norm(o_r, gn_g, gn_b)
    ys = jnp.stack([y_a, y_b, y_c], axis=2)
    proj = jnp.einsum('btcw,cwd->btcd', ys, w_br)
    gates = jax.nn.sigmoid(mgate).reshape(b, t, N_BRANCHES, D_MODEL)
    return jnp.sum(gates * proj, axis=2) @ w_out


def swiglu(x, w_gate, w_up, w_down):
    return (jax.nn.silu(x @ w_gate) * (x @ w_up)) @ w_down


def moe_swiglu(x, w_router, w_gate, w_up, w_down):
    logits = (x @ w_router).astype(jnp.float32)
    top_v, top_i = lax.top_k(logits, TOP_K)
    probs = jax.nn.softmax(top_v, axis=-1)
    combine = jnp.sum(jax.nn.one_hot(top_i, N_EXPERTS, dtype=jnp.float32) * probs[..., None], axis=-2)
    combine = combine.astype(x.dtype)
    out = jnp.zeros_like(x)
    for e in range(N_EXPERTS):
        out = out + combine[..., e:e + 1] * swiglu(x, w_gate[e], w_up[e], w_down[e])
    return out


def setup_inputs(seed: int = 0) -> dict:
    key = jax.random.key(seed)
    ks = jax.random.split(key, 24)
    f32 = jnp.float32

    def nrm(k, shape, scale):
        return jax.random.normal(k, shape, f32) * scale

    L = DEPTH
    return {
        "x": nrm(ks[0], (BATCH, SEQ, D_MODEL), 1.0),
        "w_in": nrm(ks[1], (L, D_MODEL, IN_COLS), D_MODEL ** -0.5),
        "cmp_pos": nrm(ks[2], (L, 2, CMP_LEN, HEAD_DIM), 0.1),
        "cmp_w1": nrm(ks[3], (L, 2, CMP_LEN * HEAD_DIM, CMP_HIDDEN), (CMP_LEN * HEAD_DIM) ** -0.5),
        "cmp_b1": nrm(ks[4], (L, 2, CMP_HIDDEN), 0.01),
        "cmp_w2": nrm(ks[5], (L, 2, CMP_HIDDEN, HEAD_DIM), CMP_HIDDEN ** -0.5),
        "cmp_b2": nrm(ks[6], (L, 2, HEAD_DIM), 0.01),
        "conv_w": nrm(ks[7], (L, CONV_K, CONV_WIDTH), CONV_K ** -0.5),
        "ret_gn_g": 1.0 + nrm(ks[8], (L, RET_WIDTH), 0.01),
        "ret_gn_b": nrm(ks[9], (L, RET_WIDTH), 0.01),
        "w_br": nrm(ks[10], (L, N_BRANCHES, BRANCH_WIDTH, D_MODEL), BETA * BRANCH_WIDTH ** -0.5),
        "w_out": nrm(ks[11], (L, D_MODEL, D_MODEL), BETA * D_MODEL ** -0.5),
        "ln1_g": 1.0 + nrm(ks[12], (L, D_MODEL), 0.01),
        "ln1_b": nrm(ks[13], (L, D_MODEL), 0.01),
        "ln2_g": 1.0 + nrm(ks[14], (L, D_MODEL), 0.01),
        "ln2_b": nrm(ks[15], (L, D_MODEL), 0.01),
        "ffn_gate": nrm(ks[16], (N_DENSE, D_MODEL, D_FF), D_MODEL ** -0.5),
        "ffn_up": nrm(ks[17], (N_DENSE, D_MODEL, D_FF), D_MODEL ** -0.5),
        "ffn_down": nrm(ks[18], (N_DENSE, D_FF, D_MODEL), BETA * D_FF ** -0.5),
        "moe_router": nrm(ks[19], (N_MOE, D_MODEL, N_EXPERTS), D_MODEL ** -0.5),
        "moe_gate": nrm(ks[20], (N_MOE, N_EXPERTS, D_MODEL, D_FF), D_MODEL ** -0.5),
        "moe_up": nrm(ks[21], (N_MOE, N_EXPERTS, D_MODEL, D_FF), D_MODEL ** -0.5),
        "moe_down": nrm(ks[22], (N_MOE, N_EXPERTS, D_FF, D_MODEL), BETA * D_FF ** -0.5),
    }


def reference(x, w_in, cmp_pos, cmp_w1, cmp_b1, cmp_w2, cmp_b2, conv_w, ret_gn_g, ret_gn_b, w_br, w_out,
              ln1_g, ln1_b, ln2_g, ln2_b, ffn_gate, ffn_up, ffn_down, moe_router, moe_gate, moe_up, moe_down):
    for l in range(DEPTH):
        m = token_mixer(x, w_in[l], cmp_pos[l], cmp_w1[l], cmp_b1[l], cmp_w2[l], cmp_b2[l], conv_w[l],
                        ret_gn_g[l], ret_gn_b[l], w_br[l], w_out[l])
        x = layer_norm(ALPHA * x + m, ln1_g[l], ln1_b[l])
        if l % 2 == 0:
            f = swiglu(x, ffn_gate[l // 2], ffn_up[l // 2], ffn_down[l // 2])
        else:
            f = moe_swiglu(x, moe_router[l // 2], moe_gate[l // 2], moe_up[l // 2], moe_down[l // 2])
        x = layer_norm(ALPHA * x + f, ln2_g[l], ln2_b[l])
    return x
```

```cpp
#include <hip/hip_runtime.h>
#include <cstdio>
#include <cstdint>

#define LAS __attribute__((address_space(3)))
#define GAS __attribute__((address_space(1)))
typedef unsigned short bf16_t;
typedef short bf16x8 __attribute__((ext_vector_type(8)));
typedef short bf16x4 __attribute__((ext_vector_type(4)));
typedef float f32x4 __attribute__((ext_vector_type(4)));
typedef float f32x2 __attribute__((ext_vector_type(2)));
typedef unsigned u32x4 __attribute__((ext_vector_type(4)));
typedef unsigned u32x2 __attribute__((ext_vector_type(2)));

constexpr int BATCH = 2, SEQ = 16384, MTOK = BATCH * SEQ, DM = 1024, DEPTH = 4;
constexpr int DFF = 3584, NEXP = 8;
constexpr int IN_COLS = 7960;
constexpr int NIN_A = 5120, NIN_B = 3072;
constexpr float LN_EPS = 1e-5f;
constexpr float ALPHA = 1.6817928305074290f;
constexpr float QSCALE = 0.125f * 1.4426950408889634f;
constexpr int NWAVES = 8, NTHREADS = 512;

constexpr size_t MiB = (size_t)1 << 20;
constexpr size_t WS_CTL = 0, CTL_ZERO_BYTES = 1 * MiB;
constexpr size_t WS_COS = 1 * MiB, WS_SIN = 5 * MiB;
constexpr size_t WS_META = 9 * MiB;
constexpr size_t WS_W = 12 * MiB;
constexpr size_t W_IN = WS_W, W_C1 = WS_W + 16 * MiB, W_C2 = WS_W + 18 * MiB, W_B1 = W_C2 + 64 * 1024, W_BR = WS_W + 19 * MiB, W_OUT = WS_W + 22 * MiB, W_FFN = WS_W + 24 * MiB;
constexpr size_t WS_XB = WS_W + 192 * MiB;
constexpr size_t WS_R = WS_XB + 64 * MiB;
constexpr size_t R_Q = WS_R, R_CMPRAW = WS_R + 32 * MiB, R_KNAT = WS_R + 49 * MiB, R_VT = WS_R + 65 * MiB, R_CONV = WS_R + 81 * MiB;
constexpr size_t R_RQ = WS_R + 177 * MiB, R_RK = WS_R + 209 * MiB, R_KT = WS_R + 241 * MiB, R_VTR = WS_R + 273 * MiB, R_RG = WS_R + 305 * MiB;
constexpr size_t R_NG = WS_R + 337 * MiB, R_HIDC = WS_R + 339 * MiB, R_KC = WS_R + 343 * MiB, R_VCT = R_KC + 512 * 1024;
constexpr size_t R_YS = WS_R + 344 * MiB, R_KVT = WS_R + 440 * MiB, R_ST = WS_R + 504 * MiB;
constexpr size_t R_GATES = WS_R + 536 * MiB, R_MERGED = R_KVT;
constexpr size_t R_HID = WS_R;
constexpr int MOE_ROWS = 2 * MTOK + NEXP * 256;
constexpr size_t R_APERM = WS_R, R_HIDM = WS_R + 132 * MiB, R_DN = WS_R + 594 * MiB;
constexpr size_t WS_END = WS_R + 728 * MiB;
static_assert((size_t)MOE_ROWS * DM * 2 <= 132 * MiB && (size_t)MOE_ROWS * DFF * 2 <= 462 * MiB, "moe map");

constexpr int CW_TMO = 0;
constexpr int CW_BAR = 4096;
constexpr int CW_MOE = 16384;

constexpr int RING_BYTES = 131072, MISC_OFF = RING_BYTES, LDS_BYTES = 147456;

#define LDS_WAIT() asm volatile("s_waitcnt lgkmcnt(0)" ::: "memory")
#define VM_WAIT() asm volatile("s_waitcnt vmcnt(0)" ::: "memory")
typedef __bf16 bf16x2_hw __attribute__((ext_vector_type(2)));
__device__ __forceinline__ unsigned cvt_pk_bf16(float lo, float hi) { const f32x2 v = {lo, hi}; const bf16x2_hw r = __builtin_convertvector(v, bf16x2_hw); return __builtin_bit_cast(unsigned, r); }
__device__ __forceinline__ float bf2f(unsigned short b) { return __uint_as_float(((unsigned)b) << 16); }
__device__ __forceinline__ float bflo(unsigned w) { return __uint_as_float(w << 16); }
__device__ __forceinline__ float bfhi(unsigned w) { return __uint_as_float(w & 0xffff0000u); }
__device__ __forceinline__ unsigned short f2bf(float f) { return (unsigned short)(cvt_pk_bf16(f, 0.f) & 0xffffu); }
__device__ __forceinline__ float fast_exp2(float x) { return __builtin_amdgcn_exp2f(x); }
__device__ __forceinline__ float fast_rcp(float x) { return __builtin_amdgcn_rcpf(x); }
__device__ __forceinline__ float sigmoidf_(float x) { return fast_rcp(1.0f + fast_exp2(-1.4426950408889634f * x)); }
__device__ __forceinline__ float siluf_(float x) { return x * sigmoidf_(x); }
__device__ __forceinline__ float wave_sum(float v) {
#pragma unroll
    for (int o = 1; o < 64; o <<= 1) v += __shfl_xor(v, o);
    return v;
}

#define XB_TMO      128
#define XB_XCNT(j)  (256  + 64 * (j))
#define XB_XSUB(j)  (1280 + 64 * (j))
#define XB_XGEN(j)  (2304 + 64 * (j))
#define XB_TOP      3328
#define XB_TOPGEN   3392
#define XCD_BAR_WORDS 3456
#define XB_SPIN_CAP (1u << 18)
__device__ __forceinline__ unsigned xb_ld(unsigned* p)              { return __hip_atomic_load(p, __ATOMIC_RELAXED, __HIP_MEMORY_SCOPE_AGENT); }
__device__ __forceinline__ unsigned xb_add(unsigned* p, unsigned v) { return __hip_atomic_fetch_add(p, v, __ATOMIC_RELAXED, __HIP_MEMORY_SCOPE_AGENT); }
__device__ __forceinline__ unsigned xb_xcc_id() { return (unsigned)__builtin_amdgcn_s_getreg((3 << 11) | 20) & 0xFu; }
#define XB_SPIN(cond, bar) do { unsigned _sp = 0; while (cond) { __builtin_amdgcn_s_sleep(1); \
    if ((++_sp & 255u) == 0u) { if (xb_ld(&(bar)[XB_TMO])) break; if (_sp > XB_SPIN_CAP) { atomicAdd(&(bar)[XB_TMO], 1u); break; } } } } while (0)
struct XcdBarrier { unsigned* bar; unsigned x; volatile LAS unsigned* st; };
__device__ __forceinline__ XcdBarrier xcd_barrier_post(unsigned* bar, volatile LAS unsigned* st) {
    XcdBarrier b; b.bar = bar; b.x = xb_xcc_id(); b.st = st;
    if (threadIdx.x == 0) (void)xb_add(&bar[XB_XCNT(b.x)], 1u);
    return b;
}
__device__ __forceinline__ void xcd_barrier_complete(unsigned* bar, unsigned x, unsigned& nloc, unsigned& nx) {
    const unsigned G = gridDim.x * gridDim.y * gridDim.z;
    unsigned sum, cnt, mine, sp = 0u;
    for (;;) {
        sum = 0u; cnt = 0u; mine = 0u;
#pragma unroll
        for (unsigned j = 0; j < 16; ++j) { const unsigned c = xb_ld(&bar[XB_XCNT(j)]); sum += c; cnt += (c > 0u) ? 1u : 0u; mine = (j == x) ? c : mine; }
        if (sum == G) break;
        __builtin_amdgcn_s_sleep(1);
        if ((++sp & 255u) == 0u) { if (xb_ld(&bar[XB_TMO])) break; if (sp > XB_SPIN_CAP) { atomicAdd(&bar[XB_TMO], 1u); break; } }
    }
    nloc = mine > 0u ? mine : 1u; nx = cnt > 0u ? cnt : 1u;
}
__device__ __forceinline__ void xcd_barrier(const XcdBarrier& b) {
    asm volatile("s_waitcnt vmcnt(0)" ::: "memory");
    __syncthreads();
    if (threadIdx.x == 0) {
        unsigned* bar = b.bar;
        __builtin_amdgcn_s_waitcnt(0);
        unsigned nloc = b.st[0], nx = b.st[1];
        if (nloc == 0u) { xcd_barrier_complete(bar, b.x, nloc, nx); b.st[0] = nloc; b.st[1] = nx; }
        const unsigned old = xb_add(&bar[XB_XSUB(b.x)], 1u);
        const unsigned gen = old / nloc;
        if (old + 1u == (gen + 1u) * nloc) {
            __builtin_amdgcn_fence(__ATOMIC_RELEASE, "agent");
            asm volatile("s_waitcnt vmcnt(0)" ::: "memory");
            const unsigned og = xb_add(&bar[XB_TOP], 1u);
            const unsigned tg = og / nx;
            if (og + 1u == (tg + 1u) * nx) xb_add(&bar[XB_TOPGEN], 1u);
            else XB_SPIN(xb_ld(&bar[XB_TOPGEN]) == tg, bar);
            __builtin_amdgcn_fence(__ATOMIC_ACQUIRE, "agent");
            xb_add(&bar[XB_XGEN(b.x)], 1u);
            asm volatile("s_waitcnt vmcnt(0)" ::: "memory");
        } else {
            XB_SPIN(xb_ld(&bar[XB_XGEN(b.x)]) == gen, bar);
            __builtin_amdgcn_fence(__ATOMIC_ACQUIRE, "agent");
            asm volatile("s_waitcnt vmcnt(0)" ::: "memory");
        }
    }
    __syncthreads();
}

namespace pg8 {
constexpr int BM = 256, BK = 64, HALF = 128, HTB = HALF * BK * 2, STAGE_BYTES = 8 * HTB;
__host__ __device__ __forceinline__ int lds_byte(int r, int c) { const int st = (r >> 4) * 2 + (c >> 5), rr = r & 15, cc = c & 31, ob = rr * 64 + cc * 2; return st * 1024 + (ob ^ (((ob >> 9) & 1) << 5)); }
__host__ __device__ __forceinline__ void stage_rc(int b, int& R, int& C) { const int st = b / 1024, sb = b % 1024, swz = sb ^ (((sb >> 9) & 1) << 5); R = (st >> 1) * 16 + swz / 64; C = (st & 1) * 32 + (swz % 64) / 2; }
__host__ __device__ __forceinline__ int perm32(int rho) { const int n = rho >> 4, i = rho & 15; return 8 * (i >> 2) + 4 * n + (i & 3); }
struct Unit { int pm, pn, x; };
struct Dims { int lda, ldb, K; };

template <class Epi, class Sched, bool ALIGN_EPI>
__device__ __forceinline__ void gemm_phase(LAS unsigned char* lds, const Dims g, const Sched& S, const Epi& E) {
    int tid_ = threadIdx.x; asm volatile("" : "+v"(tid_));
    const int tid = tid_, wid = __builtin_amdgcn_readfirstlane(tid >> 6), lane = tid & 63, wr = wid >> 2, wc = wid & 3, fr = lane & 15, fq = lane >> 4;
    const int K = g.K, nt = K / BK;
    unsigned voffA[2], voffB[2];
#pragma unroll
    for (int i = 0; i < 2; ++i) { int R, C; stage_rc(tid * 16 + i * 8192, R, C); const int Rb = Epi::PERM ? ((R & ~31) + perm32(R & 31)) : R;
        voffA[i] = (unsigned)(R * g.lda + C) * 2u; voffB[i] = (unsigned)(Rb * g.ldb + C) * 2u; }
    const size_t kstep = (size_t)(BK * 2);
    const size_t hA = (size_t)HALF * g.lda * 2, hB = (size_t)HALF * g.ldb * 2;
    const unsigned ldsw = (unsigned)wid * 1024u;
    const int aoff = lds_byte(wr * 64 + fr, fq * 8), boff = lds_byte(wc * 32 + fr, fq * 8);
#define PG8_SA(b, h) (((b) * 2 + (h)) * HTB)
#define PG8_SB(b, h) ((4 + (b) * 2 + (h)) * HTB)
#define PG8_STAGE(bufoff, gbase, voff) do { _Pragma("unroll") for (int _i = 0; _i < 2; ++_i) \
        __builtin_amdgcn_global_load_lds((const unsigned*)((const char*)(gbase) + (voff)[_i]), (LAS unsigned*)(lds + (bufoff) + ldsw + _i * 8192), 16, 0, 0); } while (0)
#define PG8_LDA(dst, b, h) do { _Pragma("unroll") for (int m = 0; m < 4; ++m) _Pragma("unroll") for (int k = 0; k < 2; ++k) dst[m][k] = *(const LAS bf16x8*)(lds + PG8_SA(b, h) + aoff + m * 2048 + k * 1024); } while (0)
#define PG8_LDB(dst, b, h) do { _Pragma("unroll") for (int n = 0; n < 2; ++n) _Pragma("unroll") for (int k = 0; k < 2; ++k) dst[n][k] = *(const LAS bf16x8*)(lds + PG8_SB(b, h) + boff + n * 2048 + k * 1024); } while (0)
#define PG8_MMA(ai, bj, At, Bt) do { __builtin_amdgcn_s_setprio(1); _Pragma("unroll") for (int m = 0; m < 4; ++m) _Pragma("unroll") for (int n = 0; n < 2; ++n) _Pragma("unroll") for (int k = 0; k < 2; ++k) \
        acc[ai][bj][m][n] = __builtin_amdgcn_mfma_f32_16x16x32_bf16(Bt[n][k], At[m][k], acc[ai][bj][m][n], 0, 0, 0); __builtin_amdgcn_s_setprio(0); } while (0)
#define PG8_WAIT_V(n) asm volatile("s_waitcnt vmcnt(" #n ")" ::: "memory")
#define PG8_WAIT_L(n) asm volatile("s_waitcnt lgkmcnt(" #n ")" ::: "memory")
#define PG8_BAR __builtin_amdgcn_s_barrier()
#define PG8_SCHED __builtin_amdgcn_sched_barrier(0)
    Unit cur, nxt; int ui = 0;
    if (!S.next(0, cur)) return;
    const char* cA; const char* cB; S.ptrs(cur, cA, cB);
    PG8_STAGE(PG8_SB(0, 0), cB, voffB); PG8_STAGE(PG8_SB(0, 1), cB + hB, voffB); PG8_STAGE(PG8_SA(0, 0), cA, voffA); PG8_STAGE(PG8_SA(0, 1), cA + hA, voffA);
    if (wr == 1) PG8_BAR;
    PG8_WAIT_V(2); PG8_BAR;
    PG8_STAGE(PG8_SB(1, 0), cB + kstep, voffB); PG8_STAGE(PG8_SA(1, 0), cA + kstep, voffA); PG8_STAGE(PG8_SB(1, 1), cB + hB + kstep, voffB);
    PG8_WAIT_V(6); PG8_BAR;
    asm volatile("" ::: "memory");
    f32x4 acc[2][2][4][2];
#pragma unroll
    for (int a = 0; a < 2; ++a)
#pragma unroll
        for (int b = 0; b < 2; ++b)
#pragma unroll
            for (int m = 0; m < 4; ++m)
#pragma unroll
                for (int n = 0; n < 2; ++n) acc[a][b][m][n] = (f32x4){0.f, 0.f, 0.f, 0.f};
    bf16x8 At[4][2], B0[2][2], B1[2][2];
    for (;;) {
        const bool has_next = S.next(ui + 1, nxt);
        const char* nA = cA; const char* nB = cB; if (has_next) S.ptrs(nxt, nA, nB);
        for (int t = 0; t < nt; t += 2) {
            const bool last = (t == nt - 2);
            const char* a1 = cA + (size_t)(t + 1) * kstep;
            const char* a2 = last ? nA : cA + (size_t)(t + 2) * kstep; const char* b2 = last ? nB : cB + (size_t)(t + 2) * kstep;
            const char* a3 = a2 + kstep; const char* b3 = b2 + kstep;
            PG8_LDB(B0, 0, 0); PG8_LDB(B1, 0, 1); PG8_SCHED; PG8_LDA(At, 0, 0); PG8_STAGE(PG8_SA(1, 1), a1 + hA, voffA);
            PG8_WAIT_V(8); PG8_WAIT_L(0); PG8_BAR; PG8_MMA(0, 0, At, B0); PG8_MMA(0, 1, At, B1); PG8_BAR; PG8_SCHED;
            PG8_LDA(At, 0, 1); PG8_STAGE(PG8_SB(0, 0), b2, voffB); PG8_STAGE(PG8_SB(0, 1), b2 + hB, voffB); PG8_STAGE(PG8_SA(0, 0), a2, voffA);
            PG8_WAIT_V(8); PG8_WAIT_L(0); PG8_BAR; PG8_MMA(1, 0, At, B0); PG8_MMA(1, 1, At, B1); PG8_BAR; PG8_SCHED;
            PG8_LDB(B0, 1, 0); PG8_LDB(B1, 1, 1); PG8_SCHED; PG8_LDA(At, 1, 0); PG8_STAGE(PG8_SA(0, 1), a2 + hA, voffA);
            PG8_WAIT_V(8); PG8_WAIT_L(0); PG8_BAR; PG8_MMA(0, 0, At, B0); PG8_MMA(0, 1, At, B1); PG8_BAR; PG8_SCHED;
            PG8_LDA(At, 1, 1); PG8_STAGE(PG8_SB(1, 0), b3, voffB); PG8_STAGE(PG8_SB(1, 1), b3 + hB, voffB); PG8_STAGE(PG8_SA(1, 0), a3, voffA);
            PG8_WAIT_V(8); PG8_WAIT_L(0); PG8_BAR; PG8_MMA(1, 0, At, B0); PG8_MMA(1, 1, At, B1); PG8_BAR; PG8_SCHED;
        }
        if constexpr (ALIGN_EPI) { if (wr == 0) PG8_BAR; }
        { Unit eu = cur; int e_fr = fr, e_fq = fq;
          asm volatile("" : "+v"(e_fr), "+v"(e_fq));
          E(acc, eu, wr, wc, e_fr, e_fq); }
        if (!has_next) break;
#pragma unroll
        for (int a = 0; a < 2; ++a)
#pragma unroll
            for (int b = 0; b < 2; ++b)
#pragma unroll
                for (int m = 0; m < 4; ++m)
#pragma unroll
                    for (int n = 0; n < 2; ++n) acc[a][b][m][n] = (f32x4){0.f, 0.f, 0.f, 0.f};
        cur = nxt; cA = nA; cB = nB; ++ui;
        if constexpr (ALIGN_EPI) { if (wr == 1) PG8_BAR; }
    }
    PG8_WAIT_V(0);
    if constexpr (!ALIGN_EPI) { if (wr == 0) PG8_BAR; }
    PG8_BAR;
#undef PG8_SA
#undef PG8_SB
#undef PG8_STAGE
#undef PG8_LDA
#undef PG8_LDB
#undef PG8_MMA
#undef PG8_WAIT_V
#undef PG8_WAIT_L
#undef PG8_BAR
#undef PG8_SCHED
}

struct PlainOrder {
    int nM, nN, nwg, G, c; const char* A; const char* Bt; size_t tA, tB;
    __device__ void init(const void* A_, const void* Bt_, int M, int N, int lda, int ldb, int G_, int c_) { nM = M / BM; nN = N / BM; nwg = nM * nN; G = G_; c = c_; A = (const char*)A_; Bt = (const char*)Bt_; tA = (size_t)BM * lda * 2; tB = (size_t)BM * ldb * 2; }
    __device__ __forceinline__ bool next(int i, Unit& u) const {
        const long L = (long)i * G + c; if (L >= nwg) return false;
        int wgid = (int)L; { const int q = nwg / 8, r = nwg % 8, xcd = wgid % 8, off = wgid / 8; wgid = (xcd < r ? xcd * (q + 1) : r * (q + 1) + (xcd - r) * q) + off; }
        const int nig = 8 * nN, gid = wgid / nig, fm = gid * 8, gsz = (nM - fm) < 8 ? (nM - fm) : 8;
        u.pm = fm + ((wgid % nig) % gsz); u.pn = (wgid % nig) / gsz; u.x = 0; return true;
    }
    __device__ __forceinline__ void ptrs(const Unit& u, const char*& a, const char*& b) const { a = A + (size_t)u.pm * tA; b = Bt + (size_t)u.pn * tB; }
};
}

struct Frame {
    LAS unsigned char* lds;
    volatile LAS unsigned* MISC;
    unsigned* ctl;
    unsigned char* ws;
    int tid, lane, wave, G, bid;
    const float* const* in;
    float* xf;
};
using pg8::Unit;
#define INP(i) ((const float*)(const GAS float*)F.in[i])

typedef const f32x4 (&AccRef)[2][2][4][2];
#define OPQ_S(x) asm volatile("" : "+s"(x))
#define OPQ_V(x) asm volatile("" : "+v"(x))

struct EpiRes {
    static constexpr bool PERM = false;
    float* xf;
    __device__ __forceinline__ void operator()(AccRef acc, const Unit& u, int wr, int wc, int fr, int fq) const {
        const int row0 = u.pm * 256 + wr * 64 + fr, col0 = u.pn * 256 + wc * 32 + 4 * fq;
#pragma unroll
        for (int ai = 0; ai < 2; ++ai)
#pragma unroll
            for (int m = 0; m < 4; ++m) { float* rowp = xf + (size_t)(row0 + ai * 128 + m * 16) * DM + col0;
#pragma unroll
                for (int bj = 0; bj < 2; ++bj)
#pragma unroll
                    for (int n = 0; n < 2; ++n) { f32x4* p = (f32x4*)(rowp + bj * 128 + n * 16); const f32x4 x = *p; *p = x * ALPHA + acc[ai][bj][m][n]; }
                if (m & 1) asm volatile("" ::: "memory"); }
    }
};
struct EpiSwiglu {
    static constexpr bool PERM = true;
    bf16_t* hid;
    __device__ __forceinline__ void operator()(AccRef acc, const Unit& u, int wr, int wc, int fr, int fq) const {
        const int row0 = u.pm * 256 + wr * 64 + fr, col0 = u.pn * 128 + wc * 32 + 8 * fq;
#pragma unroll
        for (int ai = 0; ai < 2; ++ai)
#pragma unroll
            for (int m = 0; m < 4; ++m) { bf16_t* rowp = hid + (size_t)(row0 + ai * 128 + m * 16) * DFF + col0;
                float h[8];
#pragma unroll
                for (int n = 0; n < 2; ++n)
#pragma unroll
                    for (int j = 0; j < 4; ++j) h[n * 4 + j] = siluf_(acc[ai][0][m][n][j]) * acc[ai][1][m][n][j];
                u32x4 w; w.x = cvt_pk_bf16(h[0], h[1]); w.y = cvt_pk_bf16(h[2], h[3]); w.z = cvt_pk_bf16(h[4], h[5]); w.w = cvt_pk_bf16(h[6], h[7]);
                *(u32x4*)rowp = w; }
    }
};
template <int ACT  > struct EpiBf16 {
    static constexpr bool PERM = true;
    bf16_t* out; int ldc;
    __device__ __forceinline__ void operator()(AccRef acc, const Unit& u, int wr, int wc, int fr, int fq) const {
        const int row0 = u.pm * 256 + wr * 64 + fr, col0 = u.pn * 256 + wc * 32 + 8 * fq;
#pragma unroll
        for (int ai = 0; ai < 2; ++ai)
#pragma unroll
            for (int m = 0; m < 4; ++m) { bf16_t* rowp = out + (size_t)(row0 + ai * 128 + m * 16) * ldc + col0;
#pragma unroll
                for (int bj = 0; bj < 2; ++bj) { f32x4 v0 = acc[ai][bj][m][0], v1 = acc[ai][bj][m][1];
                    if (ACT == 1) {
#pragma unroll
                        for (int j = 0; j < 4; ++j) { v0[j] = sigmoidf_(v0[j]); v1[j] = sigmoidf_(v1[j]); } }
                    u32x4 w; w.x = cvt_pk_bf16(v0[0], v0[1]); w.y = cvt_pk_bf16(v0[2], v0[3]); w.z = cvt_pk_bf16(v1[0], v1[1]); w.w = cvt_pk_bf16(v1[2], v1[3]);
                    *(u32x4*)(rowp + bj * 128) = w; } }
    }
};
struct EpiMerge {
    static constexpr bool PERM = true;
    const bf16_t* gates; bf16_t* merged;
    __device__ __forceinline__ void operator()(AccRef acc, const Unit& u, int wr, int wc, int fr, int fq) const {
        const int row0 = u.pm * 256 + wr * 64 + fr, col0 = u.pn * 256 + wc * 32 + 8 * fq; const int c = u.x;
#pragma unroll
        for (int ai = 0; ai < 2; ++ai)
#pragma unroll
            for (int m = 0; m < 4; ++m) { const size_t r = (size_t)(row0 + ai * 128 + m * 16);
#pragma unroll
                for (int bj = 0; bj < 2; ++bj) {
                    const u32x4 g = *(const u32x4*)(gates + r * NIN_B + c * DM + col0 + bj * 128);
                    bf16_t* op = merged + r * DM + col0 + bj * 128;
                    u32x4 o = (u32x4){0u, 0u, 0u, 0u}; if (c > 0) o = *(const u32x4*)op;
                    const f32x4 v0 = acc[ai][bj][m][0], v1 = acc[ai][bj][m][1];
                    u32x4 w;
                    w.x = cvt_pk_bf16(bflo(o.x) + bflo(g.x) * v0[0], bfhi(o.x) + bfhi(g.x) * v0[1]);
                    w.y = cvt_pk_bf16(bflo(o.y) + bflo(g.y) * v0[2], bfhi(o.y) + bfhi(g.y) * v0[3]);
                    w.z = cvt_pk_bf16(bflo(o.z) + bflo(g.z) * v1[0], bfhi(o.z) + bfhi(g.z) * v1[1]);
                    w.w = cvt_pk_bf16(bflo(o.w) + bflo(g.w) * v1[2], bfhi(o.w) + bfhi(g.w) * v1[3]);
                    *(u32x4*)op = w; }
                if (m & 1) asm volatile("" ::: "memory"); }
    }
};
struct EpiCmp1 {
    static constexpr bool PERM = true;
    bf16_t* hidc; const float* b1;
    __device__ __forceinline__ void operator()(AccRef acc, const Unit& u, int wr, int wc, int fr, int fq) const {
        const int kv = u.x; const int row0 = u.pm * 256 + wr * 64 + fr, col0 = wc * 32 + 8 * fq;
        f32x4 bv[2][2];
#pragma unroll
        for (int bj = 0; bj < 2; ++bj)
#pragma unroll
            for (int n = 0; n < 2; ++n) bv[bj][n] = *(const f32x4*)(b1 + kv * 256 + col0 + bj * 128 + 4 * n);
#pragma unroll
        for (int ai = 0; ai < 2; ++ai)
#pragma unroll
            for (int m = 0; m < 4; ++m) { bf16_t* rowp = hidc + ((size_t)kv * 4096 + (row0 + ai * 128 + m * 16)) * 256 + col0;
#pragma unroll
                for (int bj = 0; bj < 2; ++bj) { f32x4 v0 = acc[ai][bj][m][0] + bv[bj][0], v1 = acc[ai][bj][m][1] + bv[bj][1];
#pragma unroll
                    for (int j = 0; j < 4; ++j) { float x = v0[j]; v0[j] = x * sigmoidf_(1.5957691216057308f * (x + 0.044715f * x * x * x)); x = v1[j]; v1[j] = x * sigmoidf_(1.5957691216057308f * (x + 0.044715f * x * x * x)); }
                    u32x4 w; w.x = cvt_pk_bf16(v0[0], v0[1]); w.y = cvt_pk_bf16(v0[2], v0[3]); w.z = cvt_pk_bf16(v1[0], v1[1]); w.w = cvt_pk_bf16(v1[2], v1[3]);
                    *(u32x4*)(rowp + bj * 128) = w; } }
    }
};
struct EpiInA {
    static constexpr bool PERM = true;
    unsigned char* ws; const float* cs; const float* sn;
    __device__ __forceinline__ void operator()(AccRef acc, const Unit& u, int wr, int wc, int fr, int fq) const {
        const int pn = u.pn; const int row0 = u.pm * 256 + wr * 64 + fr; const int cc = wc * 32 + 8 * fq;
        if (pn < 2 || (pn >= 5 && pn <= 10) || pn == 17 || pn == 18) {
            bf16_t* base; int ldc, cb; float sc = 1.f; int act = 0;
            if (pn < 2) { base = (bf16_t*)(ws + R_Q); ldc = 512; cb = pn * 256; sc = QSCALE; }
            else if (pn <= 10) { base = (bf16_t*)(ws + R_CONV); ldc = 1536; cb = (pn - 5) * 256; }
            else { base = (bf16_t*)(ws + R_RG); ldc = 512; cb = (pn - 17) * 256; act = 1; }
#pragma unroll
            for (int ai = 0; ai < 2; ++ai)
#pragma unroll
                for (int m = 0; m < 4; ++m) { bf16_t* rowp = base + (size_t)(row0 + ai * 128 + m * 16) * ldc + cb + cc;
#pragma unroll
                    for (int bj = 0; bj < 2; ++bj) { f32x4 v0 = acc[ai][bj][m][0] * sc, v1 = acc[ai][bj][m][1] * sc;
                        if (act) {
#pragma unroll
                            for (int j = 0; j < 4; ++j) { v0[j] = siluf_(v0[j]); v1[j] = siluf_(v1[j]); } }
                        u32x4 w; w.x = cvt_pk_bf16(v0[0], v0[1]); w.y = cvt_pk_bf16(v0[2], v0[3]); w.z = cvt_pk_bf16(v1[0], v1[1]); w.w = cvt_pk_bf16(v1[2], v1[3]);
                        *(u32x4*)(rowp + bj * 128) = w; } }
        } else if (pn <= 4) {
#pragma unroll
            for (int bj = 0; bj < 2; ++bj) {
                const int colkv = (pn - 2) * 256 + bj * 128 + cc, c = colkv >> 6, d0 = colkv & 63, br = c >> 2, kvi = (c >> 1) & 1, g = c & 1;
#pragma unroll
                for (int ai = 0; ai < 2; ++ai)
#pragma unroll
                    for (int m = 0; m < 4; ++m) { const int row = row0 + ai * 128 + m * 16, b = row >> 14, t = row & (SEQ - 1);
                        const f32x4 v0 = acc[ai][bj][m][0], v1 = acc[ai][bj][m][1];
                        if (br == 0 || kvi == 0) {
                            bf16_t* base = (br == 0) ? (bf16_t*)(ws + R_CMPRAW) + ((size_t)((kvi * 2 + b) * 2 + g) * SEQ + t) * 64
                                                     : (bf16_t*)(ws + R_KNAT) + ((size_t)(((br - 1) * 2 + b) * 2 + g) * SEQ + t) * 64;
                            u32x4 w; w.x = cvt_pk_bf16(v0[0], v0[1]); w.y = cvt_pk_bf16(v0[2], v0[3]); w.z = cvt_pk_bf16(v1[0], v1[1]); w.w = cvt_pk_bf16(v1[2], v1[3]);
                            *(u32x4*)(base + d0) = w;
                        } else {
                            bf16_t* base = (bf16_t*)(ws + R_VT) + ((size_t)(((br - 1) * 2 + b) * 2 + g) * SEQ + (t & ~63)) * 64 + (t & 63);
#pragma unroll
                            for (int j = 0; j < 4; ++j) { base[(d0 + j) * 64] = f2bf(v0[j]); base[(d0 + 4 + j) * 64] = f2bf(v1[j]); }
                        } }
            }
        } else if (pn <= 14) {
            const int ti = pn - 11, isK = ti >> 1, hp = ti & 1, head = 2 * hp + (cc >> 6), i0 = cc & 63;
            const float sc = isK ? 0.08838834764831845f : 1.0f;
            const float l2g = __builtin_log2f(1.0f - __builtin_exp2f(-5.0f - (float)head));
            bf16_t* nat = (bf16_t*)(ws + (isK ? R_RK : R_RQ));
#pragma unroll
            for (int ai = 0; ai < 2; ++ai)
#pragma unroll
                for (int m = 0; m < 4; ++m) { const int row = row0 + ai * 128 + m * 16, b = row >> 14, t = row & (SEQ - 1);
                    float o1[8], o2[8];
#pragma unroll
                    for (int n = 0; n < 2; ++n) { const f32x4 c4 = *(const f32x4*)(cs + (size_t)t * 64 + i0 + 4 * n), s4 = *(const f32x4*)(sn + (size_t)t * 64 + i0 + 4 * n);
                        const f32x4 x1 = acc[ai][0][m][n], x2 = acc[ai][1][m][n];
#pragma unroll
                        for (int j = 0; j < 4; ++j) { o1[n * 4 + j] = (x1[j] * c4[j] - x2[j] * s4[j]) * sc; o2[n * 4 + j] = (x1[j] * s4[j] + x2[j] * c4[j]) * sc; } }
                    bf16_t* rowp = nat + (size_t)row * 512 + head * 128 + i0;
                    u32x4 w; w.x = cvt_pk_bf16(o1[0], o1[1]); w.y = cvt_pk_bf16(o1[2], o1[3]); w.z = cvt_pk_bf16(o1[4], o1[5]); w.w = cvt_pk_bf16(o1[6], o1[7]);
                    *(u32x4*)rowp = w;
                    w.x = cvt_pk_bf16(o2[0], o2[1]); w.y = cvt_pk_bf16(o2[2], o2[3]); w.z = cvt_pk_bf16(o2[4], o2[5]); w.w = cvt_pk_bf16(o2[6], o2[7]);
                    *(u32x4*)(rowp + 64) = w;
                    if (isK) {
                        const int tl = t & 127; const float kd = __builtin_exp2f(l2g * (float)(127 - tl));
                        bf16_t* base = (bf16_t*)(ws + R_KT) + ((size_t)((b * 4 + head) * 128 + (t >> 7)) * 128) * 128 + tl;
#pragma unroll
                        for (int j = 0; j < 8; ++j) { base[(i0 + j) * 128] = f2bf(o1[j] * kd); base[(64 + i0 + j) * 128] = f2bf(o2[j] * kd); }
                    } }
        } else if (pn <= 16) {
#pragma unroll
            for (int bj = 0; bj < 2; ++bj) { const int head = 2 * (pn - 15) + bj;
#pragma unroll
                for (int ai = 0; ai < 2; ++ai)
#pragma unroll
                    for (int m = 0; m < 4; ++m) { const int row = row0 + ai * 128 + m * 16, b = row >> 14, t = row & (SEQ - 1), tl = t & 127;
                        bf16_t* base = (bf16_t*)(ws + R_VTR) + ((size_t)((b * 4 + head) * 128 + (t >> 7)) * 128) * 128 + tl;
                        const f32x4 v0 = acc[ai][bj][m][0], v1 = acc[ai][bj][m][1];
#pragma unroll
                        for (int j = 0; j < 4; ++j) { base[(cc + j) * 128] = f2bf(v0[j]); base[(cc + 4 + j) * 128] = f2bf(v1[j]); } } }
        } else if (pn >= 20) {
#pragma unroll
            for (int ai = 0; ai < 2; ++ai)
#pragma unroll
                for (int m = 0; m < 4; ++m) { bf16_t* rowp = (bf16_t*)(ws + R_GATES) + (size_t)(row0 + ai * 128 + m * 16) * NIN_B + (pn - 20) * 256 + cc;
#pragma unroll
                    for (int bj = 0; bj < 2; ++bj) { f32x4 v0 = acc[ai][bj][m][0], v1 = acc[ai][bj][m][1];
#pragma unroll
                        for (int j = 0; j < 4; ++j) { v0[j] = sigmoidf_(v0[j]); v1[j] = sigmoidf_(v1[j]); }
                        u32x4 w; w.x = cvt_pk_bf16(v0[0], v0[1]); w.y = cvt_pk_bf16(v0[2], v0[3]); w.z = cvt_pk_bf16(v1[0], v1[1]); w.w = cvt_pk_bf16(v1[2], v1[3]);
                        *(u32x4*)(rowp + bj * 128) = w; } }
        } else {
            if (wc == 0 && fq < 3) {
#pragma unroll
                for (int ai = 0; ai < 2; ++ai)
#pragma unroll
                    for (int m = 0; m < 4; ++m) { const int row = row0 + ai * 128 + m * 16;
                        f32x4 v0 = acc[ai][0][m][0], v1 = acc[ai][0][m][1];
#pragma unroll
                        for (int j = 0; j < 4; ++j) { v0[j] = sigmoidf_(v0[j]); v1[j] = sigmoidf_(v1[j]); }
                        u32x4 w; w.x = cvt_pk_bf16(v0[0], v0[1]); w.y = cvt_pk_bf16(v0[2], v0[3]); w.z = cvt_pk_bf16(v1[0], v1[1]); w.w = cvt_pk_bf16(v1[2], v1[3]);
                        *(u32x4*)((bf16_t*)(ws + R_NG) + (size_t)row * 32 + 8 * fq) = w; }
            }
        }
    }
};

struct MergeOrder {
    int G, c; const char* A; const char* Bt;
    __device__ __forceinline__ bool next(int i, Unit& u) const {
        const int t = i / 3; const long L = (long)t * G + c; if (L >= 512) return false;
        u.pm = (int)(L >> 2); u.pn = (int)(L & 3); u.x = i - 3 * t; return true; }
    __device__ __forceinline__ void ptrs(const Unit& u, const char*& a, const char*& b) const {
        a = A + ((size_t)u.pm * 256 * 1536 + u.x * 512) * 2; b = Bt + ((size_t)u.pn * 256 * 1536 + u.x * 512) * 2; }
};
struct CmpOrder {
    int G, c; const char* A; const char* Bt;
    __device__ __forceinline__ bool next(int i, Unit& u) const { const int L = i * G + c; if (L >= 32) return false; u.x = L >> 4; u.pm = L & 15; u.pn = 0; return true; }
    __device__ __forceinline__ void ptrs(const Unit& u, const char*& a, const char*& b) const {
        a = A + ((size_t)u.x * 4 * SEQ * 64 + (size_t)u.pm * 256 * 1024) * 2; b = Bt + (size_t)u.x * 256 * 2048 * 2; }
};
struct MoeOrder {
    int G, c, NT; const LAS int* tab; const char* A; const char* Bt; size_t tA, tB, eB;
    __device__ __forceinline__ bool next(int i, Unit& u) const {
        const int TM = tab[8]; const long L = (long)i * G + c; if (L >= (long)TM * NT) return false;
        u.pm = (int)(L / NT); u.pn = (int)(L % NT); int e = 0;
#pragma unroll
        for (int k = 1; k < 8; ++k) e += (tab[k] <= u.pm) ? 1 : 0;
        u.x = e; return true; }
    __device__ __forceinline__ void ptrs(const Unit& u, const char*& a, const char*& b) const { a = A + (size_t)u.pm * tA; b = Bt + (size_t)u.x * eB + (size_t)u.pn * tB; }
};

__device__ __forceinline__ void cvt_item(const float* src, int ldw, int nvalid, bf16_t* dst, int ldk, LAS float* scr, int lane) {
    const int nl = lane & 31;
#pragma unroll 8
    for (int i = 0; i < 32; ++i) { const int kk = 2 * i + (lane >> 5); scr[kk * 33 + nl] = (nl < nvalid) ? src[(size_t)kk * ldw + nl] : 0.f; }
    LDS_WAIT(); asm volatile("" ::: "memory");
    const int c = lane & 7;
#pragma unroll
    for (int j = 0; j < 4; ++j) { const int n = (lane >> 3) + 8 * j; const LAS float* s = scr + (8 * c) * 33 + n;
        u32x4 o; o.x = cvt_pk_bf16(s[0 * 33], s[1 * 33]); o.y = cvt_pk_bf16(s[2 * 33], s[3 * 33]); o.z = cvt_pk_bf16(s[4 * 33], s[5 * 33]); o.w = cvt_pk_bf16(s[6 * 33], s[7 * 33]);
        *(u32x4*)(dst + (size_t)n * ldk + 8 * c) = o; }
    LDS_WAIT(); asm volatile("" ::: "memory");
}
__device__ __forceinline__ void win_map(int n0, int& c, int& nvalid) {
    nvalid = 32;
    if (n0 < 1280) c = n0;
    else if (n0 < 2816) c = n0 + 24;
    else if (n0 < 3840) { const int ti = (n0 - 2816) >> 8, tl = (n0 - 2816) & 255, base = ti < 2 ? 2840 : 3352, hp = ti & 1, half = tl >> 7, hh = (tl & 127) >> 6, i = tl & 63; c = base + (2 * hp + hh) * 128 + half * 64 + i; }
    else if (n0 < 4864) c = n0 + 24;
    else if (n0 == 4864) { c = 1280; nvalid = 24; }
    else if (n0 < 5120) { c = 0; nvalid = 0; }
    else c = 4888 + (n0 - 5120);
}
__device__ __forceinline__ void phase_weights(Frame& F, int l) {
    LAS float* scr = (LAS float*)(F.lds + F.wave * 16384);
    const int gw = F.bid * NWAVES + F.wave, NGW = F.G * NWAVES;
    const bool moe = (l & 1);
    const float* w_in = INP(1) + (size_t)l * DM * IN_COLS;
    const float* cw1 = INP(3) + (size_t)l * 2 * 2048 * 256;
    const float* cw2 = INP(5) + (size_t)l * 2 * 256 * 64;
    const float* wbr = INP(10) + (size_t)l * 3 * 512 * DM;
    const float* wout = INP(11) + (size_t)l * DM * DM;
    const int I_IN = 256 * 16, I_C1 = 2 * 8 * 32, I_C2 = 2 * 2 * 4, I_BR = 3 * 32 * 8, I_OUT = 32 * 16, I_GU = 224 * 16, I_DN = 32 * 56;
    const int nE = moe ? NEXP : 1;
    const int NITEMS = I_IN + I_C1 + I_C2 + I_BR + I_OUT + nE * (I_GU + I_DN);
    for (int it = gw; it < NITEMS; it += NGW) {
        int r = it;
        if (r < I_IN) { const int nb = r >> 4, kb = r & 15; int c, nv; win_map(nb * 32, c, nv);
            cvt_item(w_in + (size_t)(kb * 64) * IN_COLS + c, IN_COLS, nv, (bf16_t*)(F.ws + W_IN) + (size_t)(nb * 32) * DM + kb * 64, DM, scr, F.lane); continue; }
        r -= I_IN;
        if (r < I_C1) { const int kv = r >> 8, q = r & 255, nb = q >> 5, kb = q & 31;
            cvt_item(cw1 + ((size_t)kv * 2048 + kb * 64) * 256 + nb * 32, 256, 32, (bf16_t*)(F.ws + W_C1) + ((size_t)kv * 256 + nb * 32) * 2048 + kb * 64, 2048, scr, F.lane); continue; }
        r -= I_C1;
        if (r < I_C2) { const int kv = r >> 3, q = r & 7, nb = q >> 2, kb = q & 3;
            cvt_item(cw2 + ((size_t)kv * 256 + kb * 64) * 64 + nb * 32, 64, 32, (bf16_t*)(F.ws + W_C2) + ((size_t)kv * 64 + nb * 32) * 256 + kb * 64, 256, scr, F.lane); continue; }
        r -= I_C2;
        if (r < I_BR) { const int c = r >> 8, q = r & 255, nb = q >> 3, kb = q & 7;
            cvt_item(wbr + ((size_t)c * 512 + kb * 64) * DM + nb * 32, DM, 32, (bf16_t*)(F.ws + W_BR) + (size_t)(nb * 32) * 1536 + c * 512 + kb * 64, 1536, scr, F.lane); continue; }
        r -= I_BR;
        if (r < I_OUT) { const int nb = r >> 4, kb = r & 15;
            cvt_item(wout + (size_t)(kb * 64) * DM + nb * 32, DM, 32, (bf16_t*)(F.ws + W_OUT) + (size_t)(nb * 32) * DM + kb * 64, DM, scr, F.lane); continue; }
        r -= I_OUT;
        { const int e = r / (I_GU + I_DN); r -= e * (I_GU + I_DN);
          const size_t wsz = (size_t)DM * DFF;
          const float* wg = moe ? INP(20) + ((size_t)(l >> 1) * NEXP + e) * wsz : INP(16) + (size_t)(l >> 1) * wsz;
          const float* wu = moe ? INP(21) + ((size_t)(l >> 1) * NEXP + e) * wsz : INP(17) + (size_t)(l >> 1) * wsz;
          const float* wd = moe ? INP(22) + ((size_t)(l >> 1) * NEXP + e) * wsz : INP(18) + (size_t)(l >> 1) * wsz;
          bf16_t* gu_t = (bf16_t*)(F.ws + W_FFN) + (size_t)e * 3 * wsz; bf16_t* dn_t = gu_t + 2 * wsz;
          if (r < I_GU) { const int nb = r >> 4, kb = r & 15, n0 = nb * 32, pn = n0 >> 8, j = n0 & 255;
              const float* src = (j < 128) ? wg + pn * 128 + j : wu + pn * 128 + (j - 128);
              cvt_item(src + (size_t)(kb * 64) * DFF, DFF, 32, gu_t + (size_t)n0 * DM + kb * 64, DM, scr, F.lane); continue; }
          r -= I_GU;
          { const int nb = r / 56, kb = r % 56;
            cvt_item(wd + (size_t)(kb * 64) * DM + nb * 32, DM, 32, dn_t + (size_t)(nb * 32) * DFF + kb * 64, DFF, scr, F.lane); } }
    }
    { const float* pos = INP(2) + (size_t)l * 2 * 2048; float* part = (float*)(F.ws + W_B1);
      for (int it = gw; it < 128; it += NGW) { const int kc = it >> 3, q = it & 7, kv = q >> 2, nb = q & 3; const int n = nb * 64 + F.lane;
          const float* w = cw1 + ((size_t)kv * 2048 + kc * 128) * 256 + n; const float* p = pos + kv * 2048 + kc * 128; float s = 0.f;
#pragma unroll 16
          for (int k = 0; k < 128; ++k) s += p[k] * w[(size_t)k * 256];
          part[kc * 512 + kv * 256 + n] = s; } }
}

__device__ __forceinline__ void phase_bias(Frame& F, int l) {
    if (F.bid == 0) { const float* part = (const float*)(F.ws + W_B1); float s = INP(4)[(size_t)l * 512 + F.tid];
        for (int kc = 0; kc < 16; ++kc) s += part[kc * 512 + F.tid];
        ((float*)(F.ws + W_B1))[16 * 512 + F.tid] = s; }
}
__device__ __forceinline__ void phase_init(Frame& F) {
    const int gw = F.bid * NWAVES + F.wave, NGW = F.G * NWAVES;
    const float* x = INP(0); bf16_t* xb = (bf16_t*)(F.ws + WS_XB);
    for (int m = gw; m < MTOK; m += NGW) {
#pragma unroll
        for (int j = 0; j < 4; ++j) { const f32x4 v = *(const f32x4*)(x + (size_t)m * DM + 4 * F.lane + 256 * j);
            *(f32x4*)(F.xf + (size_t)m * DM + 4 * F.lane + 256 * j) = v;
            u32x2 w; w.x = cvt_pk_bf16(v[0], v[1]); w.y = cvt_pk_bf16(v[2], v[3]); *(u32x2*)(xb + (size_t)m * DM + 4 * F.lane + 256 * j) = w; } }
    float* cs = (float*)(F.ws + WS_COS); float* sn = (float*)(F.ws + WS_SIN);
    const float inv = powf(10000.0f, -(float)(2 * F.lane) / 128.0f);
    for (int t = gw; t < SEQ; t += NGW) { const float ang = (float)t * inv; float s, c; sincosf(ang, &s, &c); cs[(size_t)t * 64 + F.lane] = c; sn[(size_t)t * 64 + F.lane] = s; }
}
template <int MODE>
__device__ __forceinline__ void phase_ln(Frame& F, const float* gam, const float* bet, bool write_xb, int moe_idx) {
    const int gw = F.bid * NWAVES + F.wave, NGW = F.G * NWAVES;
    bf16_t* xb = (bf16_t*)(F.ws + WS_XB);
    f32x4 g4[4], b4[4];
#pragma unroll
    for (int j = 0; j < 4; ++j) { g4[j] = *(const f32x4*)(gam + 4 * F.lane + 256 * j); b4[j] = *(const f32x4*)(bet + 4 * F.lane + 256 * j); }
    volatile LAS unsigned* lcnt = F.MISC + 16;
    if (MODE == 1) { if (F.tid < 8) lcnt[F.tid] = 0u; __syncthreads(); }
    const float* wr = (MODE == 1) ? INP(19) + (size_t)moe_idx * DM * NEXP : nullptr;
    u32x4* meta = (u32x4*)(F.ws + WS_META);
    const u32x2* tokslot = (const u32x2*)(F.ws + WS_META + 1 * MiB);
    const bf16_t* dn = (const bf16_t*)(F.ws + R_DN);
    for (int m = gw; m < MTOK; m += NGW) {
        float* row = F.xf + (size_t)m * DM;
        f32x4 v[4]; float s = 0.f;
#pragma unroll
        for (int j = 0; j < 4; ++j) v[j] = *(const f32x4*)(row + 4 * F.lane + 256 * j);
        if (MODE == 2) {
            const u32x2 sl = tokslot[m]; const float p1 = __uint_as_float(meta[m].w), p2 = 1.0f - p1;
#pragma unroll
            for (int j = 0; j < 4; ++j) { const u32x2 a = *(const u32x2*)(dn + (size_t)sl.x * DM + 4 * F.lane + 256 * j), b = *(const u32x2*)(dn + (size_t)sl.y * DM + 4 * F.lane + 256 * j);
                v[j][0] = v[j][0] * ALPHA + p1 * bflo(a.x) + p2 * bflo(b.x); v[j][1] = v[j][1] * ALPHA + p1 * bfhi(a.x) + p2 * bfhi(b.x);
                v[j][2] = v[j][2] * ALPHA + p1 * bflo(a.y) + p2 * bflo(b.y); v[j][3] = v[j][3] * ALPHA + p1 * bfhi(a.y) + p2 * bfhi(b.y); } }
#pragma unroll
        for (int j = 0; j < 4; ++j) s += (v[j][0] + v[j][1]) + (v[j][2] + v[j][3]);
        const float mean = wave_sum(s) * (1.f / DM); float s2 = 0.f;
#pragma unroll
        for (int j = 0; j < 4; ++j) { v[j] = v[j] - mean; s2 += (v[j][0] * v[j][0] + v[j][1] * v[j][1]) + (v[j][2] * v[j][2] + v[j][3] * v[j][3]); }
        const float rstd = 1.f / sqrtf(wave_sum(s2) * (1.f / DM) + LN_EPS);
#pragma unroll
        for (int j = 0; j < 4; ++j) { v[j] = v[j] * rstd * g4[j] + b4[j];
            *(f32x4*)(row + 4 * F.lane + 256 * j) = v[j];
            if (write_xb) { u32x2 w; w.x = cvt_pk_bf16(v[j][0], v[j][1]); w.y = cvt_pk_bf16(v[j][2], v[j][3]); *(u32x2*)(xb + (size_t)m * DM + 4 * F.lane + 256 * j) = w; } }
        if (MODE == 1) {
            float lg[8];
#pragma unroll
            for (int e = 0; e < 8; ++e) lg[e] = 0.f;
#pragma unroll
            for (int j = 0; j < 4; ++j)
#pragma unroll
                for (int i = 0; i < 4; ++i) { const float* w = wr + (size_t)(4 * F.lane + 256 * j + i) * 8; const f32x4 w0 = *(const f32x4*)w, w1 = *(const f32x4*)(w + 4); const float xv = v[j][i];
                    lg[0] += xv * w0[0]; lg[1] += xv * w0[1]; lg[2] += xv * w0[2]; lg[3] += xv * w0[3]; lg[4] += xv * w1[0]; lg[5] += xv * w1[1]; lg[6] += xv * w1[2]; lg[7] += xv * w1[3]; }
#pragma unroll
            for (int e = 0; e < 8; ++e) lg[e] = wave_sum(lg[e]);
            int e1 = 0; float v1 = lg[0];
#pragma unroll
            for (int e = 1; e < 8; ++e) if (lg[e] > v1) { v1 = lg[e]; e1 = e; }
            int e2 = -1; float v2 = -3.0e38f;
#pragma unroll
            for (int e = 0; e < 8; ++e) if (e != e1 && lg[e] > v2) { v2 = lg[e]; e2 = e; }
            const float p1 = 1.0f / (1.0f + __expf(v2 - v1));
            if (F.lane == 0) { const unsigned r1 = __hip_atomic_fetch_add((LAS unsigned*)(lcnt + e1), 1u, __ATOMIC_RELAXED, __HIP_MEMORY_SCOPE_WORKGROUP);
                const unsigned r2 = __hip_atomic_fetch_add((LAS unsigned*)(lcnt + e2), 1u, __ATOMIC_RELAXED, __HIP_MEMORY_SCOPE_WORKGROUP);
                meta[m] = (u32x4){(unsigned)e1 | ((unsigned)e2 << 4) | ((unsigned)F.bid << 8), r1, r2, __float_as_uint(p1)}; }
        }
    }
    if (MODE == 1) {
        __syncthreads();
        if (F.tid < 8) { const unsigned base = __hip_atomic_fetch_add(F.ctl + CW_MOE + moe_idx * 1024 + F.tid * 64, lcnt[F.tid], __ATOMIC_RELAXED, __HIP_MEMORY_SCOPE_AGENT);
            ((unsigned*)(F.ws + WS_META + 2 * MiB))[F.bid * 8 + F.tid] = base; }
    }
}
__device__ __forceinline__ void moe_table(Frame& F, int moe_idx) {
    volatile LAS int* tab = (volatile LAS int*)(F.MISC + 32);
    if (F.tid == 0) { int acc = 0;
        for (int e = 0; e < 8; ++e) { const unsigned c = __hip_atomic_load(F.ctl + CW_MOE + moe_idx * 1024 + e * 64, __ATOMIC_RELAXED, __HIP_MEMORY_SCOPE_AGENT); tab[e] = acc; F.MISC[48 + e] = c; acc += (int)((c + 255u) >> 8); }
        tab[8] = acc; }
    __syncthreads();
}
__device__ __forceinline__ void phase_moe_permute(Frame& F, int moe_idx) {
    moe_table(F, moe_idx);
    volatile LAS int* tab = (volatile LAS int*)(F.MISC + 32);
    const int gw = F.bid * NWAVES + F.wave, NGW = F.G * NWAVES;
    const u32x4* meta = (const u32x4*)(F.ws + WS_META); u32x2* tokslot = (u32x2*)(F.ws + WS_META + 1 * MiB);
    const unsigned* wgbase = (const unsigned*)(F.ws + WS_META + 2 * MiB);
    const bf16_t* xb = (const bf16_t*)(F.ws + WS_XB); bf16_t* ap = (bf16_t*)(F.ws + R_APERM);
    for (int m = gw; m < MTOK; m += NGW) {
        const u32x4 mt = meta[m]; const int e1 = mt.x & 15, e2 = (mt.x >> 4) & 15, wg = mt.x >> 8;
        const unsigned s1 = (unsigned)tab[e1] * 256u + wgbase[wg * 8 + e1] + mt.y, s2 = (unsigned)tab[e2] * 256u + wgbase[wg * 8 + e2] + mt.z;
        const u32x4 a = *(const u32x4*)(xb + (size_t)m * DM + 8 * F.lane), b = *(const u32x4*)(xb + (size_t)m * DM + 512 + 8 * F.lane);
        *(u32x4*)(ap + (size_t)s1 * DM + 8 * F.lane) = a; *(u32x4*)(ap + (size_t)s1 * DM + 512 + 8 * F.lane) = b;
        *(u32x4*)(ap + (size_t)s2 * DM + 8 * F.lane) = a; *(u32x4*)(ap + (size_t)s2 * DM + 512 + 8 * F.lane) = b;
        if (F.lane == 0) tokslot[m] = (u32x2){s1, s2};
    }
    for (int it = gw; it < 8 * 256; it += NGW) {
        const int e = it >> 8, k = it & 255; const int cnt = (int)F.MISC[48 + e]; const int mt = (cnt + 255) >> 8; const int r = cnt + k;
        if (r < mt * 256) { bf16_t* p = ap + ((size_t)tab[e] * 256 + r) * DM; *(u32x4*)(p + 8 * F.lane) = (u32x4){0u, 0u, 0u, 0u}; *(u32x4*)(p + 512 + 8 * F.lane) = (u32x4){0u, 0u, 0u, 0u}; }
    }
}

#ifndef NSA_WIN
#define NSA_WIN 1
#endif
#ifndef NSA_CMP
#define NSA_CMP 1
#endif
#ifndef NSA_SLC
#define NSA_SLC 1
#endif
#define MFMA16(a, b, c) __builtin_amdgcn_mfma_f32_16x16x32_bf16(a, b, c, 0, 0, 0)
__device__ __forceinline__ bf16x8 ld16(const bf16_t* p) { return *(const bf16x8*)p; }
__device__ __forceinline__ bf16x8 pack8(const f32x4& a, const f32x4& b) {
    u32x4 w; w.x = cvt_pk_bf16(a[0], a[1]); w.y = cvt_pk_bf16(a[2], a[3]); w.z = cvt_pk_bf16(b[0], b[1]); w.w = cvt_pk_bf16(b[2], b[3]);
    return __builtin_bit_cast(bf16x8, w);
}
__device__ __forceinline__ float gq_max(float v) { v = fmaxf(v, __shfl_xor(v, 16)); return fmaxf(v, __shfl_xor(v, 32)); }
__device__ __forceinline__ float gq_sum(float v) { v += __shfl_xor(v, 16); return v + __shfl_xor(v, 32); }

__device__ __forceinline__ void phase_conv(Frame& F, int l) {
    const bf16_t* cv = (const bf16_t*)(F.ws + R_CONV); bf16_t* ys = (bf16_t*)(F.ws + R_YS);
    const float* w = INP(7) + (size_t)l * 3 * 512;
    const int c0 = 8 * F.lane;
    float w0[8], w1[8], w2[8];
#pragma unroll
    for (int j = 0; j < 8; ++j) { w0[j] = w[c0 + j]; w1[j] = w[512 + c0 + j]; w2[j] = w[1024 + c0 + j]; }
    const int gw = F.bid * NWAVES + F.wave, NGW = F.G * NWAVES;
    for (int r = gw; r < MTOK / 16; r += NGW) {
        const int m0 = r * 16; const int t0 = m0 & (SEQ - 1);
        float um2[8], um1[8];
#pragma unroll
        for (int j = 0; j < 8; ++j) { um2[j] = 0.f; um1[j] = 0.f; }
        if (t0 >= 2) {
            const u32x4 a2 = *(const u32x4*)(cv + (size_t)(m0 - 2) * 1536 + 512 + c0), h2 = *(const u32x4*)(cv + (size_t)(m0 - 2) * 1536 + 1024 + c0);
            const u32x4 a1 = *(const u32x4*)(cv + (size_t)(m0 - 1) * 1536 + 512 + c0), h1 = *(const u32x4*)(cv + (size_t)(m0 - 1) * 1536 + 1024 + c0);
#pragma unroll
            for (int q = 0; q < 4; ++q) { um2[2 * q] = bflo(a2[q]) * bflo(h2[q]); um2[2 * q + 1] = bfhi(a2[q]) * bfhi(h2[q]); um1[2 * q] = bflo(a1[q]) * bflo(h1[q]); um1[2 * q + 1] = bfhi(a1[q]) * bfhi(h1[q]); }
        }
        for (int i = 0; i < 16; ++i) {
            const size_t m = (size_t)(m0 + i);
            const u32x4 bq = *(const u32x4*)(cv + m * 1536 + c0), a = *(const u32x4*)(cv + m * 1536 + 512 + c0), h = *(const u32x4*)(cv + m * 1536 + 1024 + c0);
            float u[8], y[8];
#pragma unroll
            for (int q = 0; q < 4; ++q) { u[2 * q] = bflo(a[q]) * bflo(h[q]); u[2 * q + 1] = bfhi(a[q]) * bfhi(h[q]); }
#pragma unroll
            for (int q = 0; q < 4; ++q) { y[2 * q] = bflo(bq[q]) * (w0[2 * q] * um2[2 * q] + w1[2 * q] * um1[2 * q] + w2[2 * q] * u[2 * q]);
                                          y[2 * q + 1] = bfhi(bq[q]) * (w0[2 * q + 1] * um2[2 * q + 1] + w1[2 * q + 1] * um1[2 * q + 1] + w2[2 * q + 1] * u[2 * q + 1]); }
            u32x4 o; o.x = cvt_pk_bf16(y[0], y[1]); o.y = cvt_pk_bf16(y[2], y[3]); o.z = cvt_pk_bf16(y[4], y[5]); o.w = cvt_pk_bf16(y[6], y[7]);
            *(u32x4*)(ys + m * 1536 + 512 + c0) = o;
#pragma unroll
            for (int j = 0; j < 8; ++j) { um2[j] = um1[j]; um1[j] = u[j]; }
        }
    }
}

__device__ __forceinline__ void phase_ret_kv(Frame& F) {
    const bf16_t* KT = (const bf16_t*)(F.ws + R_KT); const bf16_t* VTR = (const bf16_t*)(F.ws + R_VTR); float* KVT = (float*)(F.ws + R_KVT);
    const int i16 = F.lane & 15, gq = F.lane >> 4, w = F.wave;
    for (int it = F.bid; it < 1024; it += F.G) {
        const bf16_t* kt = KT + (size_t)it * 16384; const bf16_t* vt = VTR + (size_t)it * 16384;
        bf16x8 yf[4];
#pragma unroll
        for (int ks = 0; ks < 4; ++ks) yf[ks] = ld16(kt + (w * 16 + i16) * 128 + ks * 32 + gq * 8);
        float* out = KVT + (size_t)it * 16384;
#pragma unroll
        for (int et = 0; et < 8; ++et) {
            f32x4 acc = (f32x4){0.f, 0.f, 0.f, 0.f};
#pragma unroll
            for (int ks = 0; ks < 4; ++ks) acc = MFMA16(ld16(vt + (et * 16 + i16) * 128 + ks * 32 + gq * 8), yf[ks], acc);
#pragma unroll
            for (int r = 0; r < 4; ++r) out[(et * 16 + gq * 4 + r) * 128 + w * 16 + i16] = acc[r];
        }
    }
}
__device__ __forceinline__ void phase_ret_scan(Frame& F) {
    const float* KVT = (const float*)(F.ws + R_KVT); bf16_t* ST = (bf16_t*)(F.ws + R_ST);
    for (int idx = F.bid * NTHREADS + F.tid; idx < 8 * 16384; idx += F.G * NTHREADS) {
        const int bh = idx >> 14, ed = idx & 16383, h = bh & 3;
        const float cd = __builtin_exp2f(128.0f * __builtin_log2f(1.0f - __builtin_exp2f(-5.0f - (float)h)));
        const float* src = KVT + (size_t)bh * 128 * 16384 + ed; bf16_t* dst = ST + (size_t)bh * 128 * 16384 + ed;
        float s = 0.f;
#pragma unroll 8
        for (int i = 0; i < 128; ++i) { dst[(size_t)i * 16384] = f2bf(s); s = s * cd + src[(size_t)i * 16384]; }
    }
}
__device__ __forceinline__ void phase_ret_out(Frame& F, int l) {
    const bf16_t* RQ = (const bf16_t*)(F.ws + R_RQ); const bf16_t* RK = (const bf16_t*)(F.ws + R_RK); const bf16_t* VTR = (const bf16_t*)(F.ws + R_VTR);
    const bf16_t* ST = (const bf16_t*)(F.ws + R_ST); const bf16_t* RG = (const bf16_t*)(F.ws + R_RG); bf16_t* ys = (bf16_t*)(F.ws + R_YS);
    const float* gng = INP(8) + (size_t)l * 512; const float* gnb = INP(9) + (size_t)l * 512;
    const int i16 = F.lane & 15, gq = F.lane >> 4, w = F.wave;
    for (int it = F.bid; it < 1024; it += F.G) {
        const int bh = it >> 7, ch = it & 127, b = bh >> 2, h = bh & 3;
        const float l2g = __builtin_log2f(1.0f - __builtin_exp2f(-5.0f - (float)h));
        const size_t row0 = (size_t)b * SEQ + ch * 128;
        const int tl = w * 16 + i16;
        bf16x8 qf[4];
#pragma unroll
        for (int ks = 0; ks < 4; ++ks) qf[ks] = ld16(RQ + (row0 + tl) * 512 + h * 128 + ks * 32 + gq * 8);
        f32x4 o[8];
        const bf16_t* st = ST + (size_t)it * 16384;
#pragma unroll
        for (int et = 0; et < 8; ++et) { f32x4 acc = (f32x4){0.f, 0.f, 0.f, 0.f};
#pragma unroll
            for (int ks = 0; ks < 4; ++ks) acc = MFMA16(ld16(st + (et * 16 + i16) * 128 + ks * 32 + gq * 8), qf[ks], acc);
            o[et] = acc; }
        const float qd = __builtin_exp2f(l2g * (float)(tl + 1));
#pragma unroll
        for (int et = 0; et < 8; ++et) o[et] = o[et] * qd;
        const bf16_t* vt = VTR + (size_t)it * 16384;
        const int kr = (i16 >> 2) * 8 + (i16 & 3);
        for (int ss = 0; ss <= (w >> 1); ++ss) {
            f32x4 s0 = (f32x4){0.f, 0.f, 0.f, 0.f}, s1 = s0;
#pragma unroll
            for (int ks = 0; ks < 4; ++ks) { s0 = MFMA16(ld16(RK + (row0 + ss * 32 + kr) * 512 + h * 128 + ks * 32 + gq * 8), qf[ks], s0);
                                             s1 = MFMA16(ld16(RK + (row0 + ss * 32 + kr + 4) * 512 + h * 128 + ks * 32 + gq * 8), qf[ks], s1); }
#pragma unroll
            for (int r = 0; r < 4; ++r) { const int sl0 = ss * 32 + gq * 8 + r, sl1 = sl0 + 4;
                s0[r] = (tl >= sl0) ? s0[r] * __builtin_exp2f(l2g * (float)(tl - sl0)) : 0.f;
                s1[r] = (tl >= sl1) ? s1[r] * __builtin_exp2f(l2g * (float)(tl - sl1)) : 0.f; }
            const bf16x8 pb = pack8(s0, s1);
#pragma unroll
            for (int et = 0; et < 8; ++et) o[et] = MFMA16(ld16(vt + (et * 16 + i16) * 128 + ss * 32 + gq * 8), pb, o[et]);
        }
        float s = 0.f;
#pragma unroll
        for (int et = 0; et < 8; ++et) s += (o[et][0] + o[et][1]) + (o[et][2] + o[et][3]);
        const float mean = gq_sum(s) * (1.0f / 128.0f); float q = 0.f;
#pragma unroll
        for (int et = 0; et < 8; ++et) { o[et] = o[et] - mean; q += (o[et][0] * o[et][0] + o[et][1] * o[et][1]) + (o[et][2] * o[et][2] + o[et][3] * o[et][3]); }
        const float rstd = 1.0f / sqrtf(gq_sum(q) * (1.0f / 128.0f) + LN_EPS);
#pragma unroll
        for (int et = 0; et < 8; ++et) { const int e = et * 16 + gq * 4;
            const f32x4 g4 = *(const f32x4*)(gng + h * 128 + e), b4 = *(const f32x4*)(gnb + h * 128 + e);
            const u32x2 rg = *(const u32x2*)(RG + (row0 + tl) * 512 + h * 128 + e);
            const float y0 = (o[et][0] * rstd * g4[0] + b4[0]) * bflo(rg.x), y1 = (o[et][1] * rstd * g4[1] + b4[1]) * bfhi(rg.x);
            const float y2 = (o[et][2] * rstd * g4[2] + b4[2]) * bflo(rg.y), y3 = (o[et][3] * rstd * g4[3] + b4[3]) * bfhi(rg.y);
            u32x2 wv; wv.x = cvt_pk_bf16(y0, y1); wv.y = cvt_pk_bf16(y2, y3);
            *(u32x2*)(ys + (row0 + tl) * 1536 + 1024 + h * 128 + e) = wv; }
    }
}

__device__ __forceinline__ void phase_cmp2(Frame& F, int l) {
    const bf16_t* HID = (const bf16_t*)(F.ws + R_HIDC); const bf16_t* W2 = (const bf16_t*)(F.ws + W_C2);
    bf16_t* KC = (bf16_t*)(F.ws + R_KC); bf16_t* VCT = (bf16_t*)(F.ws + R_VCT);
    const float* b2 = INP(6) + (size_t)l * 128;
    const int i16 = F.lane & 15, gq = F.lane >> 4;
    const int gw = F.bid * NWAVES + F.wave, NGW = F.G * NWAVES;
    for (int it = gw; it < 512; it += NGW) {
        const int kv = it >> 8, rt = it & 255; const bf16_t* hid = HID + ((size_t)kv * 4096 + rt * 16) * 256; const bf16_t* w2 = W2 + (size_t)kv * 64 * 256;
        bf16x8 hf[8];
#pragma unroll
        for (int ks = 0; ks < 8; ++ks) hf[ks] = ld16(hid + i16 * 256 + ks * 32 + gq * 8);
#pragma unroll
        for (int dt = 0; dt < 4; ++dt) {
            f32x4 acc = (f32x4){0.f, 0.f, 0.f, 0.f};
            if (kv == 0) {
#pragma unroll
                for (int ks = 0; ks < 8; ++ks) acc = MFMA16(ld16(w2 + (dt * 16 + i16) * 256 + ks * 32 + gq * 8), hf[ks], acc);
                const int n = rt * 16 + i16, dd = dt * 16 + gq * 4; const f32x4 bb = *(const f32x4*)(b2 + dd);
                const bool z = (n & 1023) == 1023;
                u32x2 wv; wv.x = z ? 0u : cvt_pk_bf16(acc[0] + bb[0], acc[1] + bb[1]); wv.y = z ? 0u : cvt_pk_bf16(acc[2] + bb[2], acc[3] + bb[3]);
                *(u32x2*)(KC + (size_t)n * 64 + dd) = wv;
            } else {
#pragma unroll
                for (int ks = 0; ks < 8; ++ks) acc = MFMA16(hf[ks], ld16(w2 + (dt * 16 + i16) * 256 + ks * 32 + gq * 8), acc);
                const int n0 = rt * 16 + gq * 4, dd = dt * 16 + i16; const float bb = b2[64 + dd];
                float v[4];
#pragma unroll
                for (int r = 0; r < 4; ++r) v[r] = (((n0 + r) & 1023) == 1023) ? 0.f : acc[r] + bb;
                u32x2 wv; wv.x = cvt_pk_bf16(v[0], v[1]); wv.y = cvt_pk_bf16(v[2], v[3]);
                *(u32x2*)(VCT + ((size_t)(n0 >> 6) * 64 + dd) * 64 + (n0 & 63)) = wv;
            }
        }
    }
}

template <int NT, class MaskF>
__device__ __forceinline__ void attn_step(const bf16_t* kp, const bf16_t* vtp, const bf16x8 (&qf)[NT][2], f32x4 (&o)[NT][4], float (&m)[NT], float (&l)[NT], int kbase, const int (&tq)[NT], MaskF mask, int lane) {
    const int i16 = lane & 15, gq = lane >> 4, kr = (i16 >> 2) * 8 + (i16 & 3);
    const bf16x8 k00 = ld16(kp + kr * 64 + gq * 8), k01 = ld16(kp + kr * 64 + 32 + gq * 8), k10 = ld16(kp + (kr + 4) * 64 + gq * 8), k11 = ld16(kp + (kr + 4) * 64 + 32 + gq * 8);
    bf16x8 vf[4];
#pragma unroll
    for (int dt = 0; dt < 4; ++dt) vf[dt] = ld16(vtp + (dt * 16 + i16) * 64 + gq * 8);
#pragma unroll
    for (int nt = 0; nt < NT; ++nt) {
        f32x4 s0 = (f32x4){0.f, 0.f, 0.f, 0.f}, s1 = s0;
        s0 = MFMA16(k00, qf[nt][0], s0); s0 = MFMA16(k01, qf[nt][1], s0);
        s1 = MFMA16(k10, qf[nt][0], s1); s1 = MFMA16(k11, qf[nt][1], s1);
        float mx = -INFINITY;
#pragma unroll
        for (int r = 0; r < 4; ++r) { const int kp0 = kbase + gq * 8 + r;
            s0[r] = mask(kp0, tq[nt]) ? s0[r] : -INFINITY; s1[r] = mask(kp0 + 4, tq[nt]) ? s1[r] : -INFINITY;
            mx = fmaxf(mx, fmaxf(s0[r], s1[r])); }
        mx = gq_max(mx);
        const float mnew = fmaxf(m[nt], mx), alpha = fast_exp2(m[nt] - mnew);
        float rs = 0.f;
#pragma unroll
        for (int r = 0; r < 4; ++r) { s0[r] = fast_exp2(s0[r] - mnew); s1[r] = fast_exp2(s1[r] - mnew); rs += s0[r] + s1[r]; }
        rs = gq_sum(rs);
        l[nt] = l[nt] * alpha + rs; m[nt] = mnew;
        const bf16x8 pb = pack8(s0, s1);
#pragma unroll
        for (int dt = 0; dt < 4; ++dt) { o[nt][dt] = o[nt][dt] * alpha; o[nt][dt] = MFMA16(vf[dt], pb, o[nt][dt]); }
    }
}
template <bool ACCUM>
__device__ __forceinline__ void attn_store(bf16_t* ys, const bf16_t* ng, size_t row, int hh, int gi, const f32x4 (&o)[4], float l, int gq) {
    const float g = bf2f(ng[row * 32 + hh * 3 + gi]) / fmaxf(l, 1e-30f);
#pragma unroll
    for (int dt = 0; dt < 4; ++dt) { bf16_t* p = ys + row * 1536 + hh * 64 + dt * 16 + gq * 4;
        float a0 = 0.f, a1 = 0.f, a2 = 0.f, a3 = 0.f;
        if (ACCUM) { const u32x2 old = *(const u32x2*)p; a0 = bflo(old.x); a1 = bfhi(old.x); a2 = bflo(old.y); a3 = bfhi(old.y); }
        u32x2 wv; wv.x = cvt_pk_bf16(a0 + g * o[dt][0], a1 + g * o[dt][1]); wv.y = cvt_pk_bf16(a2 + g * o[dt][2], a3 + g * o[dt][3]);
        *(u32x2*)p = wv; }
}

__device__ __forceinline__ void phase_nsa_window(Frame& F, bool dry = false) {
    const bf16_t* Q = (const bf16_t*)(F.ws + R_Q); const bf16_t* NG = (const bf16_t*)(F.ws + R_NG); bf16_t* ys = (bf16_t*)(F.ws + R_YS);
    const int lane = F.lane, i16 = lane & 15, gq = lane >> 4, w = F.wave;
    for (int u = F.bid; u < 1024; u += F.G) {
        const int bg = u >> 8, qb = u & 255, b = bg >> 1, g = bg & 1, q0 = qb * 64;
        const bf16_t* K = (const bf16_t*)(F.ws + R_KNAT) + (size_t)(4 + bg) * SEQ * 64;
        const bf16_t* VT = (const bf16_t*)(F.ws + R_VT) + (size_t)(4 + bg) * SEQ * 64;
        int tq[2]; bf16x8 qf[2][2]; const int hh = g * 4 + (i16 & 3);
#pragma unroll
        for (int nt = 0; nt < 2; ++nt) { tq[nt] = q0 + w * 8 + nt * 4 + (i16 >> 2);
#pragma unroll
            for (int ks = 0; ks < 2; ++ks) qf[nt][ks] = ld16(Q + ((size_t)b * SEQ + tq[nt]) * 512 + hh * 64 + ks * 32 + gq * 8); }
        f32x4 o[2][4]; float m[2], l[2];
#pragma unroll
        for (int nt = 0; nt < 2; ++nt) { m[nt] = -1e30f; l[nt] = 0.f;
#pragma unroll
            for (int dt = 0; dt < 4; ++dt) o[nt][dt] = (f32x4){0.f, 0.f, 0.f, 0.f}; }
        const int tlo = q0 + w * 8; int klo = tlo - 511; if (klo < 0) klo = 0; klo &= ~31; const int khi = tlo + 8;
        for (int kb = klo; kb < khi; kb += 32)
            attn_step<2>(K + (size_t)kb * 64, VT + (size_t)(kb >> 6) * 4096 + (kb & 63), qf, o, m, l, kb, tq, [](int kp, int t) { return kp <= t && kp > t - 512; }, lane);
#pragma unroll
        for (int nt = 0; nt < 2; ++nt) { if (!NSA_WIN) { for (int dt = 0; dt < 4; ++dt) o[nt][dt] = (f32x4){0.f, 0.f, 0.f, 0.f}; } if (!dry) attn_store<false>(ys, NG, (size_t)b * SEQ + tq[nt], hh, 2, o[nt], l[nt], gq); else if (l[nt] == 12345.f) ys[0] = 0; }
    }
}

constexpr int SC_STRIDE = 260;
__device__ __forceinline__ void phase_nsa_cmp_slc(Frame& F, bool dry = false) {
    const bf16_t* Q = (const bf16_t*)(F.ws + R_Q); const bf16_t* NG = (const bf16_t*)(F.ws + R_NG); bf16_t* ys = (bf16_t*)(F.ws + R_YS);
    const int lane = F.lane, i16 = lane & 15, gq = lane >> 4, w = F.wave, kr = (i16 >> 2) * 8 + (i16 & 3);
    LAS float* sc = (LAS float*)F.lds + (size_t)w * 8 * SC_STRIDE;
    LAS int* sel = (LAS int*)(F.lds + 64 * SC_STRIDE * 4) + w * 8 * 17;
    for (int u = F.bid; u < 1024; u += F.G) {
        const int bg = u >> 8, qb = u & 255, b = bg >> 1, g = bg & 1, q0 = qb * 64, cur = qb;
        const bf16_t* KC = (const bf16_t*)(F.ws + R_KC) + (size_t)bg * 1024 * 64; const bf16_t* VCT = (const bf16_t*)(F.ws + R_VCT) + (size_t)bg * 1024 * 64;
        const int hh = g * 4 + (i16 & 3);
        int tq[2], nc[2]; bf16x8 qf[2][2];
#pragma unroll
        for (int nt = 0; nt < 2; ++nt) { tq[nt] = q0 + w * 8 + nt * 4 + (i16 >> 2); nc[nt] = tq[nt] >= 31 ? ((tq[nt] - 31) >> 4) + 1 : 0;
#pragma unroll
            for (int ks = 0; ks < 2; ++ks) qf[nt][ks] = ld16(Q + ((size_t)b * SEQ + tq[nt]) * 512 + hh * 64 + ks * 32 + gq * 8); }
        const int tmax = q0 + w * 8 + 7, ncmax = tmax >= 31 ? ((tmax - 31) >> 4) + 1 : 0;
        for (int i = lane; i < 8 * SC_STRIDE; i += 64) sc[i] = 0.f;
        float m[2] = {-1e30f, -1e30f}, l[2] = {0.f, 0.f};
        for (int nb = 0; nb < ncmax; nb += 32) {
            const bf16_t* kp = KC + (size_t)nb * 64;
            const bf16x8 k00 = ld16(kp + kr * 64 + gq * 8), k01 = ld16(kp + kr * 64 + 32 + gq * 8), k10 = ld16(kp + (kr + 4) * 64 + gq * 8), k11 = ld16(kp + (kr + 4) * 64 + 32 + gq * 8);
#pragma unroll
            for (int nt = 0; nt < 2; ++nt) {
                f32x4 s0 = (f32x4){0.f, 0.f, 0.f, 0.f}, s1 = s0;
                s0 = MFMA16(k00, qf[nt][0], s0); s0 = MFMA16(k01, qf[nt][1], s0); s1 = MFMA16(k10, qf[nt][0], s1); s1 = MFMA16(k11, qf[nt][1], s1);
                float mx = -INFINITY;
#pragma unroll
                for (int r = 0; r < 4; ++r) { const int n0 = nb + gq * 8 + r; s0[r] = (n0 < nc[nt]) ? s0[r] : -INFINITY; s1[r] = (n0 + 4 < nc[nt]) ? s1[r] : -INFINITY; mx = fmaxf(mx, fmaxf(s0[r], s1[r])); }
                mx = gq_max(mx);
                const float mnew = fmaxf(m[nt], mx), alpha = fast_exp2(m[nt] - mnew); float rs = 0.f;
#pragma unroll
                for (int r = 0; r < 4; ++r) rs += fast_exp2(s0[r] - mnew) + fast_exp2(s1[r] - mnew);
                l[nt] = l[nt] * alpha + gq_sum(rs); m[nt] = mnew;
            }
        }
        f32x4 o[2][4]; float il[2];
#pragma unroll
        for (int nt = 0; nt < 2; ++nt) { il[nt] = l[nt] > 0.f ? 1.0f / l[nt] : 0.f;
#pragma unroll
            for (int dt = 0; dt < 4; ++dt) o[nt][dt] = (f32x4){0.f, 0.f, 0.f, 0.f}; }
        LDS_WAIT();
        for (int nb = 0; nb < ncmax; nb += 32) {
            const bf16_t* kp = KC + (size_t)nb * 64; const bf16_t* vtp = VCT + (size_t)(nb >> 6) * 4096 + (nb & 63);
            const bf16x8 k00 = ld16(kp + kr * 64 + gq * 8), k01 = ld16(kp + kr * 64 + 32 + gq * 8), k10 = ld16(kp + (kr + 4) * 64 + gq * 8), k11 = ld16(kp + (kr + 4) * 64 + 32 + gq * 8);
            bf16x8 vf[4];
#pragma unroll
            for (int dt = 0; dt < 4; ++dt) vf[dt] = ld16(vtp + (dt * 16 + i16) * 64 + gq * 8);
#pragma unroll
            for (int nt = 0; nt < 2; ++nt) {
                f32x4 s0 = (f32x4){0.f, 0.f, 0.f, 0.f}, s1 = s0;
                s0 = MFMA16(k00, qf[nt][0], s0); s0 = MFMA16(k01, qf[nt][1], s0); s1 = MFMA16(k10, qf[nt][0], s1); s1 = MFMA16(k11, qf[nt][1], s1);
#pragma unroll
                for (int r = 0; r < 4; ++r) { const int n0 = nb + gq * 8 + r;
                    s0[r] = (n0 < nc[nt]) ? fast_exp2(s0[r] - m[nt]) * il[nt] : 0.f; s1[r] = (n0 + 4 < nc[nt]) ? fast_exp2(s1[r] - m[nt]) * il[nt] : 0.f; }
                const bf16x8 pb = pack8(s0, s1);
#pragma unroll
                for (int dt = 0; dt < 4; ++dt) o[nt][dt] = MFMA16(vf[dt], pb, o[nt][dt]);
                float a0 = 2.0f * (s0[0] + s0[1] + s0[2]) + s0[3], b0 = s0[3], a1 = 2.0f * (s1[0] + s1[1] + s1[2]) + s1[3], b1 = s1[3];
                a0 += __shfl_xor(a0, 1); a0 += __shfl_xor(a0, 2); b0 += __shfl_xor(b0, 1); b0 += __shfl_xor(b0, 2);
                a1 += __shfl_xor(a1, 1); a1 += __shfl_xor(a1, 2); b1 += __shfl_xor(b1, 1); b1 += __shfl_xor(b1, 2);
                if ((i16 & 3) == 0) { const int ql = nt * 4 + (i16 >> 2), j0 = (nb >> 2) + gq * 2; LAS float* row = sc + ql * SC_STRIDE;
                    row[j0] += a0; LDS_WAIT(); row[j0 + 1] += b0 + a1; LDS_WAIT(); if (j0 + 2 < 256) row[j0 + 2] += b1; LDS_WAIT(); }
            }
        }
        if (NSA_CMP && !dry) for (int nt = 0; nt < 2; ++nt) attn_store<true>(ys, NG, (size_t)b * SEQ + tq[nt], hh, 0, o[nt], 1.0f, gq);
        LDS_WAIT(); VM_WAIT();
        for (int ql = 0; ql < 8; ++ql) {
            const LAS float* row = sc + ql * SC_STRIDE; unsigned key[4];
#pragma unroll
            for (int i = 0; i < 4; ++i) { const int j = lane * 4 + i; const float v = row[j];
                const bool valid = j <= cur, forced = (j == 0) || (j == cur) || (j == cur - 1);
                const unsigned vb = forced ? 0x7F000000u : ((__float_as_uint(fmaxf(v, 0.f)) & 0xFFFFFF00u) + 0x100u);
                key[i] = valid ? (vb | (unsigned)(255 - j)) : (unsigned)(255 - j); }
            int cnt = 0;
            for (int it = 0; it < 16; ++it) {
                unsigned mx = key[0] > key[1] ? key[0] : key[1]; const unsigned m2 = key[2] > key[3] ? key[2] : key[3]; mx = mx > m2 ? mx : m2;
#pragma unroll
                for (int off = 1; off < 64; off <<= 1) { const unsigned o2 = (unsigned)__shfl_xor((int)mx, off); mx = mx > o2 ? mx : o2; }
                if (mx < 0x100u) break;
                const int j = 255 - (int)(mx & 255u);
#pragma unroll
                for (int i = 0; i < 4; ++i) if (lane * 4 + i == j) key[i] = 0u;
                if (lane == 0) sel[ql * 17 + 1 + cnt] = j;
                ++cnt;
            }
            if (lane == 0) sel[ql * 17] = cnt;
        }
        LDS_WAIT();
        const bf16_t* KS = (const bf16_t*)(F.ws + R_KNAT) + (size_t)bg * SEQ * 64; const bf16_t* VTS = (const bf16_t*)(F.ws + R_VT) + (size_t)bg * SEQ * 64;
        for (int ql = 0; ql < 8; ++ql) {
            const int t = q0 + w * 8 + ql; const size_t row = (size_t)b * SEQ + t;
            bf16x8 q1[1][2]; int tq1[1] = {t};
#pragma unroll
            for (int ks = 0; ks < 2; ++ks) q1[0][ks] = ld16(Q + row * 512 + hh * 64 + ks * 32 + gq * 8);
            f32x4 o1[1][4]; float m1[1] = {-1e30f}, l1[1] = {0.f};
#pragma unroll
            for (int dt = 0; dt < 4; ++dt) o1[0][dt] = (f32x4){0.f, 0.f, 0.f, 0.f};
            const int cnt = sel[(ql) * 17];
            for (int c = 0; c < cnt; ++c) { const int jb = sel[ql * 17 + 1 + c];
#pragma unroll
                for (int hs = 0; hs < 2; ++hs) { const int kb = jb * 64 + hs * 32;
                    attn_step<1>(KS + (size_t)kb * 64, VTS + (size_t)jb * 4096 + hs * 32, q1, o1, m1, l1, kb, tq1, [](int kp, int tt) { return kp <= tt; }, lane); } }
            if (NSA_SLC && i16 < 4 && !dry) attn_store<true>(ys, NG, row, hh, 1, o1[0], l1[0], gq); else if (l1[0] == 12345.f) ys[0] = 0;
        }
        LDS_WAIT(); VM_WAIT();
    }
}

#ifndef DBG_CHECK
#define DBG_CHECK 0
#endif
#if DBG_CHECK
#ifndef DBG_LAYER
#define DBG_LAYER 0
#endif
constexpr size_t WS_DBG = WS_END;
constexpr int CW_DBG = 32768;
__device__ __forceinline__ int dbg_row(int k) { return (k < 4) ? (k == 0 ? 0 : k == 1 ? 1 : k == 2 ? 16383 : 16384) : (int)(((unsigned)k * 8191u + 77u) % (unsigned)MTOK); }
__device__ __forceinline__ float block_sum(Frame& F, float v, LAS float* red) {
    v = wave_sum(v); __syncthreads(); if (F.lane == 0) red[F.wave] = v; __syncthreads();
    float s = 0.f; for (int w = 0; w < 8; ++w) s += red[w]; __syncthreads(); return s;
}
__device__ __forceinline__ void dbg_snapshot(Frame& F) {
    const int row = dbg_row(F.bid); float* dst = (float*)(F.ws + WS_DBG) + (size_t)F.bid * DM;
    for (int i = F.tid; i < DM; i += NTHREADS) dst[i] = F.xf[(size_t)row * DM + i];
}
__device__ __forceinline__ void dbg_check_ffn(Frame& F, int l) {
    LAS float* x1 = (LAS float*)F.lds; LAS float* h = x1 + 1024; LAS float* f = h + 3584; LAS float* red = f + 1024; LAS float* misc = red + 16;
    const int row = dbg_row(F.bid); const float* src = (const float*)(F.ws + WS_DBG) + (size_t)F.bid * DM;
    for (int i = F.tid; i < DM; i += NTHREADS) { x1[i] = src[i]; f[i] = 0.f; }
    __syncthreads();
    const bool moe = (l & 1); int ne = 1;
    if (moe) { if (F.tid < 8) { const float* wr = INP(19) + (size_t)(l >> 1) * DM * 8; float s = 0.f; for (int k = 0; k < DM; ++k) s += x1[k] * wr[k * 8 + F.tid]; misc[F.tid] = s; }
        __syncthreads();
        if (F.tid == 0) { int e1 = 0; for (int e = 1; e < 8; ++e) if (misc[e] > misc[e1]) e1 = e; int e2 = -1; for (int e = 0; e < 8; ++e) if (e != e1 && (e2 < 0 || misc[e] > misc[e2])) e2 = e;
            const float p1 = 1.0f / (1.0f + expf(misc[e2] - misc[e1])); misc[8] = (float)e1; misc[9] = (float)e2; misc[10] = p1; }
        __syncthreads(); ne = 2; }
    for (int q = 0; q < ne; ++q) {
        const size_t wsz = (size_t)DM * DFF; const float* wg; const float* wu; const float* wd; float pw = 1.f;
        if (moe) { const int e = (int)misc[8 + q]; pw = q == 0 ? misc[10] : 1.0f - misc[10]; const size_t o = ((size_t)(l >> 1) * NEXP + e) * wsz; wg = INP(20) + o; wu = INP(21) + o; wd = INP(22) + o; }
        else { const size_t o = (size_t)(l >> 1) * wsz; wg = INP(16) + o; wu = INP(17) + o; wd = INP(18) + o; }
        for (int j = F.tid; j < DFF; j += NTHREADS) { float g = 0.f, u = 0.f; for (int k = 0; k < DM; ++k) { g += x1[k] * wg[(size_t)k * DFF + j]; u += x1[k] * wu[(size_t)k * DFF + j]; } h[j] = g / (1.0f + expf(-g)) * u; }
        __syncthreads();
        for (int d = F.tid; d < DM; d += NTHREADS) { float s = 0.f; for (int j = 0; j < DFF; ++j) s += h[j] * wd[(size_t)j * DM + d]; f[d] += pw * s; }
        __syncthreads();
    }
    float v0 = ALPHA * x1[F.tid] + f[F.tid], v1 = ALPHA * x1[F.tid + 512] + f[F.tid + 512];
    const float mean = block_sum(F, v0 + v1, red) * (1.f / DM); v0 -= mean; v1 -= mean;
    const float rstd = 1.f / sqrtf(block_sum(F, v0 * v0 + v1 * v1, red) * (1.f / DM) + LN_EPS);
    const float* gam = INP(14) + l * DM; const float* bet = INP(15) + l * DM;
    const float r0 = v0 * rstd * gam[F.tid] + bet[F.tid], r1 = v1 * rstd * gam[F.tid + 512] + bet[F.tid + 512];
    const float d0 = F.xf[(size_t)row * DM + F.tid] - r0, d1 = F.xf[(size_t)row * DM + F.tid + 512] - r1;
    const float sd = block_sum(F, d0 * d0 + d1 * d1, red), sr = block_sum(F, r0 * r0 + r1 * r1, red);
    if (F.tid == 0) { atomicAdd((float*)(F.ctl + CW_DBG), sd); atomicAdd((float*)(F.ctl + CW_DBG + 1), sr); atomicMax(F.ctl + CW_DBG + 2, __float_as_uint(sd / fmaxf(sr, 1e-30f))); }
}

#ifndef DBG_SEL
#define DBG_SEL 0
#endif
__device__ __forceinline__ void dbg_snapshot_mixer(Frame& F, int l) {
    const int row = dbg_row(F.bid), t = row & (SEQ - 1); float* dst = (float*)(F.ws + WS_DBG) + (size_t)F.bid * DM; float* dst2 = (float*)(F.ws + WS_DBG + 2 * MiB) + (size_t)F.bid * 512;
    for (int i = F.tid; i < DM; i += NTHREADS) dst[i] = F.xf[(size_t)row * DM + i];
    const float* w_in = INP(1) + (size_t)l * DM * IN_COLS; const float* cw = INP(7) + (size_t)l * 3 * 512; const int c = F.tid;
    float acc = 0.f;
    for (int dt = 0; dt < 3; ++dt) { if (t - dt < 0) continue; const float* xr = F.xf + (size_t)(row - dt) * DM; float cc = 0.f, ch = 0.f;
        for (int k = 0; k < DM; ++k) { cc += xr[k] * w_in[(size_t)k * IN_COLS + 1816 + c]; ch += xr[k] * w_in[(size_t)k * IN_COLS + 2328 + c]; }
        acc += cw[(2 - dt) * 512 + c] * cc * ch; }
    float cb = 0.f; { const float* xr = F.xf + (size_t)row * DM; for (int k = 0; k < DM; ++k) cb += xr[k] * w_in[(size_t)k * IN_COLS + 1304 + c]; }
    dst2[c] = cb * acc;
}
__device__ __forceinline__ void dbg_check_mixer(Frame& F, int l) {
    LAS float* x0 = (LAS float*)F.lds; LAS float* mg = x0 + 1024; LAS float* red = mg + 1024;
    const int row = dbg_row(F.bid); const float* src = (const float*)(F.ws + WS_DBG) + (size_t)F.bid * DM; const float* yref = (const float*)(F.ws + WS_DBG + 2 * MiB) + (size_t)F.bid * 512;
    const bf16_t* ys = (const bf16_t*)(F.ws + R_YS) + (size_t)row * 1536;
    float sd, sr;
    if (DBG_SEL == 1) { const float a = bf2f(ys[512 + F.tid]), r = yref[F.tid]; sd = block_sum(F, (a - r) * (a - r), red); sr = block_sum(F, r * r, red); }
    else {
        for (int i = F.tid; i < DM; i += NTHREADS) x0[i] = src[i];
        __syncthreads();
        const float* w_in = INP(1) + (size_t)l * DM * IN_COLS; const float* wbr = INP(10) + (size_t)l * 3 * 512 * DM; const float* wout = INP(11) + (size_t)l * DM * DM;
        float gsd = 0.f, gsr = 0.f; const bf16_t* gk = (const bf16_t*)(F.ws + R_GATES) + (size_t)row * NIN_B;
        for (int d = F.tid; d < DM; d += NTHREADS) { float m = 0.f;
            for (int c = 0; c < 3; ++c) { float g = 0.f; for (int k = 0; k < DM; ++k) g += x0[k] * w_in[(size_t)k * IN_COLS + 4888 + c * 1024 + d];
                { const float sg = 1.0f / (1.0f + expf(-g)), kg = bf2f(gk[c * 1024 + d]); gsd += (sg - kg) * (sg - kg); gsr += sg * sg; if (DBG_SEL == 4) g = -logf(1.0f / fmaxf(kg, 1e-6f) - 1.0f + 1e-9f); }
                float p = 0.f; for (int w = 0; w < 512; ++w) p += bf2f(ys[c * 512 + w]) * wbr[((size_t)c * 512 + w) * DM + d];
                m += p / (1.0f + expf(-g)); }
            mg[d] = m; }
        __syncthreads();
        if (DBG_SEL == 3) { sd = block_sum(F, gsd, red); sr = block_sum(F, gsr, red); } else if (DBG_SEL == 2 || DBG_SEL == 4) { const bf16_t* mk = (const bf16_t*)(F.ws + R_MERGED) + (size_t)row * DM; const float a0 = bf2f(mk[F.tid]) - mg[F.tid], a1 = bf2f(mk[F.tid + 512]) - mg[F.tid + 512];
            sd = block_sum(F, a0 * a0 + a1 * a1, red); sr = block_sum(F, mg[F.tid] * mg[F.tid] + mg[F.tid + 512] * mg[F.tid + 512], red); } else {
        float v0, v1; { float s0 = 0.f, s1 = 0.f; for (int k = 0; k < DM; ++k) { s0 += mg[k] * wout[(size_t)k * DM + F.tid]; s1 += mg[k] * wout[(size_t)k * DM + F.tid + 512]; } v0 = ALPHA * x0[F.tid] + s0; v1 = ALPHA * x0[F.tid + 512] + s1; }
        const float mean = block_sum(F, v0 + v1, red) * (1.f / DM); v0 -= mean; v1 -= mean;
        const float rstd = 1.f / sqrtf(block_sum(F, v0 * v0 + v1 * v1, red) * (1.f / DM) + LN_EPS);
        const float* gam = INP(12) + l * DM; const float* bet = INP(13) + l * DM;
        const float r0 = v0 * rstd * gam[F.tid] + bet[F.tid], r1 = v1 * rstd * gam[F.tid + 512] + bet[F.tid + 512];
        const float d0 = F.xf[(size_t)row * DM + F.tid] - r0, d1 = F.xf[(size_t)row * DM + F.tid + 512] - r1;
        sd = block_sum(F, d0 * d0 + d1 * d1, red); sr = block_sum(F, r0 * r0 + r1 * r1, red); }
    }
    if (F.tid == 0) { atomicAdd((float*)(F.ctl + CW_DBG), sd); atomicAdd((float*)(F.ctl + CW_DBG + 1), sr); atomicMax(F.ctl + CW_DBG + 2, __float_as_uint(sd / fmaxf(sr, 1e-30f))); }
}
#ifndef DBG_MODE
#define DBG_MODE 0
#endif
__device__ __forceinline__ void dbg_scale(Frame& F) {
    const float sd = __uint_as_float(__hip_atomic_load(F.ctl + CW_DBG, __ATOMIC_RELAXED, __HIP_MEMORY_SCOPE_AGENT)), sr = __uint_as_float(__hip_atomic_load(F.ctl + CW_DBG + 1, __ATOMIC_RELAXED, __HIP_MEMORY_SCOPE_AGENT));
    const float mx = __uint_as_float(__hip_atomic_load(F.ctl + CW_DBG + 2, __ATOMIC_RELAXED, __HIP_MEMORY_SCOPE_AGENT));
    float R = DBG_MODE == 0 ? sd / fmaxf(sr, 1e-30f) : mx; R = fminf(fmaxf(R, 1e-8f), 1.0f);
    const float s = 0.2f * (8.0f + log10f(R));
    for (size_t i = (size_t)F.bid * NTHREADS + F.tid; i < (size_t)MTOK * DM / 4; i += (size_t)F.G * NTHREADS) { f32x4 v = ((f32x4*)F.xf)[i]; ((f32x4*)F.xf)[i] = v * (1.0f + s); }
}
#endif

#ifndef TIME_DUP
#define TIME_DUP 0
#endif
#ifndef MK_PER_PHASE
#define MK_PER_PHASE 0
#endif
constexpr int PH_PER_LAYER = 13, N_PHASES = 1 + DEPTH * PH_PER_LAYER;
struct Args { const float* in[23]; float* out; unsigned char* ws; int ph_lo, ph_hi; };


#ifndef PHASE_FN
#define PHASE_FN __device__ __forceinline__ void
#endif
struct PArgs { unsigned char* ws; float* xf; const float* const* in; int l; };
__device__ __forceinline__ Frame make_frame(const PArgs& p) {
    extern __shared__ __attribute__((aligned(16))) unsigned char lds_raw[];
    Frame F;
    F.lds = (LAS unsigned char*)lds_raw;
    F.MISC = (volatile LAS unsigned*)(F.lds + MISC_OFF);
    F.tid = threadIdx.x; asm volatile("" : "+v"(F.tid)); F.lane = F.tid & 63; F.wave = __builtin_amdgcn_readfirstlane(F.tid >> 6);
    F.G = gridDim.x; F.bid = blockIdx.x;
    GAS unsigned char* wsg = (GAS unsigned char*)p.ws; GAS float* xfg = (GAS float*)p.xf;
    asm volatile("" : "+s"(wsg), "+s"(xfg));
    F.ws = (unsigned char*)wsg; F.xf = (float*)xfg; F.ctl = (unsigned*)(F.ws + WS_CTL); F.in = p.in;
    return F;
}
PHASE_FN ph_init(PArgs p) { Frame F = make_frame(p); phase_init(F); }
PHASE_FN ph_weights(PArgs p) { Frame F = make_frame(p); phase_weights(F, p.l); }
PHASE_FN ph_in_a(PArgs p) { Frame F = make_frame(p);
    phase_bias(F, p.l);
    pg8::Dims g{DM, DM, DM}; pg8::PlainOrder S; S.init(F.ws + WS_XB, F.ws + W_IN, MTOK, NIN_A + NIN_B, DM, DM, F.G, F.bid);
    EpiInA E{F.ws, (const float*)(F.ws + WS_COS), (const float*)(F.ws + WS_SIN)};
    pg8::gemm_phase<EpiInA, pg8::PlainOrder, true>(F.lds, g, S, E); }
PHASE_FN ph_cmp1(PArgs p) { Frame F = make_frame(p);
    pg8::Dims g{1024, 2048, 2048}; CmpOrder S{F.G, F.bid, (const char*)(F.ws + R_CMPRAW), (const char*)(F.ws + W_C1)};
    EpiCmp1 E{(bf16_t*)(F.ws + R_HIDC), (const float*)(F.ws + W_B1) + 16 * 512};
    pg8::gemm_phase<EpiCmp1, CmpOrder, false>(F.lds, g, S, E); }
PHASE_FN ph_conv(PArgs p) { Frame F = make_frame(p); phase_conv(F, p.l); }
PHASE_FN ph_ret_kv(PArgs p) { Frame F = make_frame(p); phase_ret_kv(F); }
PHASE_FN ph_window(PArgs p) { Frame F = make_frame(p);
#if TIME_DUP == 1
    phase_nsa_window(F, true);
#endif
    phase_nsa_window(F); }
PHASE_FN ph_cmp2_scan(PArgs p) { Frame F = make_frame(p); phase_cmp2(F, p.l); phase_ret_scan(F); }
PHASE_FN ph_cmp_slc(PArgs p) { Frame F = make_frame(p);
#if TIME_DUP == 2
    phase_nsa_cmp_slc(F, true);
#endif
    phase_nsa_cmp_slc(F); }
PHASE_FN ph_ret_out(PArgs p) { Frame F = make_frame(p); phase_ret_out(F, p.l); }
PHASE_FN ph_in_b(PArgs p) { Frame F = make_frame(p);
    pg8::Dims g{DM, DM, DM}; pg8::PlainOrder S; S.init(F.ws + WS_XB, F.ws + W_IN + (size_t)NIN_A * DM * 2, MTOK, NIN_B, DM, DM, F.G, F.bid);
    EpiBf16<1> E{(bf16_t*)(F.ws + R_GATES), NIN_B};
    pg8::gemm_phase<EpiBf16<1>, pg8::PlainOrder, true>(F.lds, g, S, E); }
PHASE_FN ph_merge(PArgs p) { Frame F = make_frame(p);
    pg8::Dims g{1536, 1536, 512}; MergeOrder S{F.G, F.bid, (const char*)(F.ws + R_YS), (const char*)(F.ws + W_BR)};
    EpiMerge E{(const bf16_t*)(F.ws + R_GATES), (bf16_t*)(F.ws + R_MERGED)};
    pg8::gemm_phase<EpiMerge, MergeOrder, true>(F.lds, g, S, E); }
PHASE_FN ph_out(PArgs p) { Frame F = make_frame(p);
    pg8::Dims g{DM, DM, DM}; pg8::PlainOrder S; S.init(F.ws + R_MERGED, F.ws + W_OUT, MTOK, DM, DM, DM, F.G, F.bid);
    EpiRes E{F.xf};
    pg8::gemm_phase<EpiRes, pg8::PlainOrder, true>(F.lds, g, S, E); }
PHASE_FN ph_ln1(PArgs p) { Frame F = make_frame(p); const int l = p.l;
    if (l & 1) phase_ln<1>(F, INP(12) + l * DM, INP(13) + l * DM, true, l >> 1); else phase_ln<0>(F, INP(12) + l * DM, INP(13) + l * DM, true, 0); }
#if DBG_CHECK
PHASE_FN ph_dbg_snap(PArgs p) { Frame F = make_frame(p); dbg_snapshot(F); }
PHASE_FN ph_dbg_ffn(PArgs p) { Frame F = make_frame(p); dbg_check_ffn(F, p.l); }
PHASE_FN ph_dbg_snapm(PArgs p) { Frame F = make_frame(p); dbg_snapshot_mixer(F, p.l); }
PHASE_FN ph_dbg_mixer(PArgs p) { Frame F = make_frame(p); dbg_check_mixer(F, p.l); }
PHASE_FN ph_dbg_scale(PArgs p) { Frame F = make_frame(p); dbg_scale(F); }
#endif
PHASE_FN ph_ffn_gu(PArgs p) { Frame F = make_frame(p);
    pg8::Dims g{DM, DM, DM}; pg8::PlainOrder S; S.init(F.ws + WS_XB, F.ws + W_FFN, MTOK, 2 * DFF, DM, DM, F.G, F.bid);
    EpiSwiglu E{(bf16_t*)(F.ws + R_HID)};
    pg8::gemm_phase<EpiSwiglu, pg8::PlainOrder, true>(F.lds, g, S, E); }
PHASE_FN ph_ffn_dn(PArgs p) { Frame F = make_frame(p);
    pg8::Dims g{DFF, DFF, DFF}; pg8::PlainOrder S; S.init(F.ws + R_HID, F.ws + W_FFN + (size_t)2 * DM * DFF * 2, MTOK, DM, DFF, DFF, F.G, F.bid);
    EpiRes E{F.xf};
    pg8::gemm_phase<EpiRes, pg8::PlainOrder, true>(F.lds, g, S, E); }
PHASE_FN ph_ln2(PArgs p) { Frame F = make_frame(p); const int l = p.l; phase_ln<0>(F, INP(14) + l * DM, INP(15) + l * DM, l + 1 < DEPTH, 0); }
PHASE_FN ph_moe_perm(PArgs p) { Frame F = make_frame(p); phase_moe_permute(F, p.l >> 1); }
PHASE_FN ph_moe_gu(PArgs p) { Frame F = make_frame(p);
    moe_table(F, p.l >> 1);
    pg8::Dims g{DM, DM, DM}; MoeOrder S{F.G, F.bid, 2 * DFF / 256, (const LAS int*)(F.MISC + 32), (const char*)(F.ws + R_APERM), (const char*)(F.ws + W_FFN), (size_t)256 * DM * 2, (size_t)256 * DM * 2, (size_t)3 * DM * DFF * 2};
    EpiSwiglu E{(bf16_t*)(F.ws + R_HIDM)};
    pg8::gemm_phase<EpiSwiglu, MoeOrder, true>(F.lds, g, S, E); }
PHASE_FN ph_moe_dn(PArgs p) { Frame F = make_frame(p);
    moe_table(F, p.l >> 1);
    pg8::Dims g{DFF, DFF, DFF}; MoeOrder S{F.G, F.bid, DM / 256, (const LAS int*)(F.MISC + 32), (const char*)(F.ws + R_HIDM), (const char*)(F.ws + W_FFN + (size_t)2 * DM * DFF * 2), (size_t)256 * DFF * 2, (size_t)256 * DFF * 2, (size_t)3 * DM * DFF * 2};
    EpiBf16<0> E{(bf16_t*)(F.ws + R_DN), DM};
    pg8::gemm_phase<EpiBf16<0>, MoeOrder, true>(F.lds, g, S, E); }
PHASE_FN ph_moe_ln2(PArgs p) { Frame F = make_frame(p); const int l = p.l; phase_ln<2>(F, INP(14) + l * DM, INP(15) + l * DM, l + 1 < DEPTH, l >> 1); }

__global__ void __launch_bounds__(NTHREADS, 2) mega(Args args) {
    extern __shared__ __attribute__((aligned(16))) unsigned char lds_raw[];
    LAS unsigned char* lds = (LAS unsigned char*)lds_raw;
    volatile LAS unsigned* MISC = (volatile LAS unsigned*)(lds + MISC_OFF);
    for (int u = threadIdx.x; u < (LDS_BYTES - MISC_OFF) / 4; u += NTHREADS) ((LAS unsigned*)(lds + MISC_OFF))[u] = 0u;
    __syncthreads();
    unsigned* ctl = (unsigned*)(args.ws + WS_CTL);
    XcdBarrier bar; bar.bar = ctl + CW_BAR; bar.x = 0; bar.st = nullptr;
    if (!MK_PER_PHASE) bar = xcd_barrier_post(ctl + CW_BAR, MISC + 8);
    const int lo = args.ph_lo, hi = args.ph_hi;
    int pc = 0;
    PArgs P; P.ws = args.ws; P.xf = args.out; P.in = args.in; P.l = 0;
#ifndef PHMASK
#define PHMASK 0xFFFFFFFFu
#endif
#define PH_BEGIN(k) if ((((PHMASK) >> (k)) & 1u) && pc >= lo && pc < hi) {
#define PH_END   if (pc + 1 < hi) { if (!MK_PER_PHASE) xcd_barrier(bar); } } ++pc;

    PH_BEGIN(0) ph_init(P); PH_END
    for (int l = 0; l < DEPTH; ++l) {
        P.l = l;
        PH_BEGIN(1) ph_weights(P); PH_END
#if DBG_CHECK == 2
        if (l == DBG_LAYER) { ph_dbg_snapm(P); xcd_barrier(bar); }
#endif
        PH_BEGIN(2) ph_in_a(P); PH_END
        PH_BEGIN(3) { ph_cmp1(P); ph_conv(P); ph_ret_kv(P); ph_window(P); } PH_END
        PH_BEGIN(4) ph_cmp2_scan(P); PH_END
        PH_BEGIN(5) { ph_cmp_slc(P); ph_ret_out(P); } PH_END
        ++pc;
        PH_BEGIN(7) ph_merge(P); PH_END
        PH_BEGIN(8) ph_out(P); PH_END
        PH_BEGIN(9) ph_ln1(P); PH_END
#if DBG_CHECK == 1
        if (l == DBG_LAYER) { ph_dbg_snap(P); xcd_barrier(bar); }
#endif
#if DBG_CHECK == 2
        if (l == DBG_LAYER) { ph_dbg_mixer(P); xcd_barrier(bar); }
#endif
        if (!(l & 1)) {
            PH_BEGIN(10) ph_ffn_gu(P); PH_END
            PH_BEGIN(11) ph_ffn_dn(P); PH_END
            PH_BEGIN(12) ph_ln2(P); PH_END
#if DBG_CHECK == 1
            if (l == DBG_LAYER) { ph_dbg_ffn(P); xcd_barrier(bar); }
#endif
            ++pc;
        } else {
            PH_BEGIN(13) ph_moe_perm(P); PH_END
            PH_BEGIN(14) ph_moe_gu(P); PH_END
            PH_BEGIN(15) ph_moe_dn(P); PH_END
            PH_BEGIN(16) ph_moe_ln2(P); PH_END
#if DBG_CHECK == 1
            if (l == DBG_LAYER) { xcd_barrier(bar); ph_dbg_ffn(P); xcd_barrier(bar); }
#endif
        }
    }
#if DBG_CHECK
    xcd_barrier(bar); ph_dbg_scale(P);
#endif
#undef PH_BEGIN
#undef PH_END
}

extern "C" void kernel_launch(void* const* d_in, const int* in_sizes, int n_in, void* d_out, int out_size, void* d_ws, size_t ws_size, hipStream_t stream) {
    static int grid = 0;
    if (grid == 0) {
        if (n_in != 23 || out_size != MTOK * DM || ws_size < WS_END + 16 * MiB) { fprintf(stderr, "kernel_launch: unexpected shapes (n_in %d out %d ws %zu need %zu)\n", n_in, out_size, ws_size, (size_t)WS_END); grid = -1; return; }
        int dev = 0, cus = 0, per_cu = 0;
        if (hipGetDevice(&dev) != hipSuccess || hipDeviceGetAttribute(&cus, hipDeviceAttributeMultiprocessorCount, dev) != hipSuccess) { grid = -1; return; }
        if (hipFuncSetAttribute((const void*)mega, hipFuncAttributeMaxDynamicSharedMemorySize, LDS_BYTES) != hipSuccess) { fprintf(stderr, "kernel_launch: hipFuncSetAttribute failed\n"); grid = -1; return; }
        if (hipOccupancyMaxActiveBlocksPerMultiprocessor(&per_cu, (const void*)mega, NTHREADS, LDS_BYTES) != hipSuccess || per_cu < 1) { fprintf(stderr, "kernel_launch: occupancy query says %d\n", per_cu); (void)hipGetLastError(); }
        grid = cus;
    }
    if (grid < 0) return;
    if (hipMemsetAsync((char*)d_ws + WS_CTL, 0, CTL_ZERO_BYTES, stream) != hipSuccess) return;
    Args a{};
    for (int i = 0; i < 23; ++i) a.in[i] = (const float*)d_in[i];
    a.out = (float*)d_out; a.ws = (unsigned char*)d_ws;
#if MK_PER_PHASE
    for (int p = 0; p < N_PHASES; ++p) { a.ph_lo = p; a.ph_hi = p + 1; hipLaunchKernelGGL(mega, dim3(grid), dim3(NTHREADS), LDS_BYTES, stream, a); }
#else
    a.ph_lo = 0; a.ph_hi = N_PHASES;
    hipLaunchKernelGGL(mega, dim3(grid), dim3(NTHREADS), LDS_BYTES, stream, a);
#endif
}
```

```cpp
#include <hip/hip_runtime.h>
#include <cstdio>
#include <cstdint>
#include <type_traits>

#define LAS __attribute__((address_space(3)))
#define GAS __attribute__((address_space(1)))
typedef unsigned short bf16_t;
typedef short bf16x8 __attribute__((ext_vector_type(8)));
typedef short bf16x4 __attribute__((ext_vector_type(4)));
typedef float f32x4 __attribute__((ext_vector_type(4)));
typedef float f32x2 __attribute__((ext_vector_type(2)));
typedef unsigned u32x4 __attribute__((ext_vector_type(4)));
typedef unsigned u32x2 __attribute__((ext_vector_type(2)));

constexpr int BATCH = 2, SEQ = 16384, MTOK = BATCH * SEQ, DM = 1024, DEPTH = 4;
constexpr int DFF = 3584, NEXP = 8;
constexpr int IN_COLS = 7960;
constexpr int NIN_A = 5120, NIN_B = 3072;
constexpr float LN_EPS = 1e-5f;
constexpr float ALPHA = 1.6817928305074290f;
constexpr float QSCALE = 0.125f * 1.4426950408889634f;
constexpr int NWAVES = 8, NTHREADS = 512;

constexpr size_t MiB = (size_t)1 << 20;
constexpr size_t WS_CTL = 0, CTL_ZERO_BYTES = 1 * MiB;
constexpr size_t WS_COS = 1 * MiB, WS_SIN = 5 * MiB;
constexpr size_t WS_META = 9 * MiB;
constexpr size_t WS_W = 12 * MiB;
constexpr size_t W_IN = WS_W, W_C1 = WS_W + 16 * MiB, W_C2 = WS_W + 18 * MiB, W_B1 = W_C2 + 64 * 1024, W_BR = WS_W + 19 * MiB, W_OUT = WS_W + 22 * MiB, W_FFN = WS_W + 24 * MiB;
constexpr size_t WS_XB = WS_W + 192 * MiB;
constexpr size_t WS_R = WS_XB + 64 * MiB;
constexpr size_t R_Q = WS_R, R_CMPRAW = WS_R + 32 * MiB, R_KNAT = WS_R + 49 * MiB, R_VT = WS_R + 65 * MiB, R_CONV = WS_R + 81 * MiB;
constexpr size_t R_RQ = WS_R + 177 * MiB, R_RK = WS_R + 209 * MiB, R_KT = WS_R + 241 * MiB, R_VTR = WS_R + 273 * MiB, R_RG = WS_R + 305 * MiB;
constexpr size_t R_NG = WS_R + 337 * MiB, R_HIDC = WS_R + 339 * MiB, R_KC = WS_R + 343 * MiB, R_VCT = R_KC + 512 * 1024;
constexpr size_t R_YS = WS_R + 344 * MiB, R_KVT = WS_R + 440 * MiB, R_ST = WS_R + 504 * MiB;
constexpr size_t R_GATES = WS_R + 536 * MiB, R_MERGED = R_KVT;
constexpr size_t R_HID = WS_R;
constexpr int MOE_ROWS = 2 * MTOK + NEXP * 256;
constexpr size_t R_APERM = WS_R, R_HIDM = WS_R + 132 * MiB, R_DN = WS_R + 594 * MiB;
constexpr size_t WS_VB = WS_R + 728 * MiB;
constexpr size_t WS_END = WS_VB + 64 * MiB;
static_assert((size_t)MOE_ROWS * DM * 2 <= 132 * MiB && (size_t)MOE_ROWS * DFF * 2 <= 462 * MiB, "moe map");

constexpr int CW_TMO = 0;
constexpr int CW_BAR = 4096;
constexpr int CW_MOE = 16384;

constexpr int RING_BYTES = 131072, MISC_OFF = RING_BYTES, LDS_BYTES = 147456;

#define LDS_WAIT() asm volatile("s_waitcnt lgkmcnt(0)" ::: "memory")
#define VM_WAIT() asm volatile("s_waitcnt vmcnt(0)" ::: "memory")
typedef __bf16 bf16x2_hw __attribute__((ext_vector_type(2)));
__device__ __forceinline__ unsigned cvt_pk_bf16(float lo, float hi) { const f32x2 v = {lo, hi}; const bf16x2_hw r = __builtin_convertvector(v, bf16x2_hw); return __builtin_bit_cast(unsigned, r); }
__device__ __forceinline__ float bf2f(unsigned short b) { return __uint_as_float(((unsigned)b) << 16); }
typedef _Float16 h16x2_hw __attribute__((ext_vector_type(2)));
__device__ __forceinline__ unsigned cvt_pk_h16(float lo, float hi) { const f32x2 v = {lo, hi}; const h16x2_hw r = __builtin_convertvector(v, h16x2_hw); return __builtin_bit_cast(unsigned, r); }
__device__ __forceinline__ float hlo(unsigned w) { const h16x2_hw r = __builtin_bit_cast(h16x2_hw, w); return (float)r[0]; }
__device__ __forceinline__ float hhi(unsigned w) { const h16x2_hw r = __builtin_bit_cast(h16x2_hw, w); return (float)r[1]; }
__device__ __forceinline__ float bflo(unsigned w) { return __uint_as_float(w << 16); }
__device__ __forceinline__ float bfhi(unsigned w) { return __uint_as_float(w & 0xffff0000u); }
__device__ __forceinline__ unsigned short f2bf(float f) { return (unsigned short)(cvt_pk_bf16(f, 0.f) & 0xffffu); }
__device__ __forceinline__ float fast_exp2(float x) { return __builtin_amdgcn_exp2f(x); }
__device__ __forceinline__ float fast_rcp(float x) { return __builtin_amdgcn_rcpf(x); }
__device__ __forceinline__ float sigmoidf_(float x) { return fast_rcp(1.0f + fast_exp2(-1.4426950408889634f * x)); }
__device__ __forceinline__ float siluf_(float x) { return x * sigmoidf_(x); }
__device__ __forceinline__ float wave_sum(float v) {
    v += __int_as_float(__builtin_amdgcn_update_dpp(0, __float_as_int(v), 0x128, 0xf, 0xf, false)); v += __int_as_float(__builtin_amdgcn_update_dpp(0, __float_as_int(v), 0x124, 0xf, 0xf, false));
    v += __int_as_float(__builtin_amdgcn_update_dpp(0, __float_as_int(v), 0x122, 0xf, 0xf, false)); v += __int_as_float(__builtin_amdgcn_update_dpp(0, __float_as_int(v), 0x121, 0xf, 0xf, false));
    const auto a = __builtin_amdgcn_permlane16_swap(__float_as_uint(v), __float_as_uint(v), false, false); v = __uint_as_float(a[0]) + __uint_as_float(a[1]);
    const auto b = __builtin_amdgcn_permlane32_swap(__float_as_uint(v), __float_as_uint(v), false, false); return __uint_as_float(b[0]) + __uint_as_float(b[1]);
}

#define XB_TMO      128
#define XB_XCNT(j)  (256  + 64 * (j))
#define XB_XSUB(j)  (1280 + 64 * (j))
#define XB_XGEN(j)  (2304 + 64 * (j))
#define XB_TOP      3328
#define XB_TOPGEN   3392
#define XCD_BAR_WORDS 3456
#define XB_SPIN_CAP (1u << 18)
__device__ __forceinline__ unsigned xb_ld(unsigned* p)              { return __hip_atomic_load(p, __ATOMIC_RELAXED, __HIP_MEMORY_SCOPE_AGENT); }
__device__ __forceinline__ unsigned xb_add(unsigned* p, unsigned v) { return __hip_atomic_fetch_add(p, v, __ATOMIC_RELAXED, __HIP_MEMORY_SCOPE_AGENT); }
__device__ __forceinline__ unsigned xb_xcc_id() { return (unsigned)__builtin_amdgcn_s_getreg((3 << 11) | 20) & 0xFu; }
#define XB_SPIN(cond, bar) do { unsigned _sp = 0; while (cond) { __builtin_amdgcn_s_sleep(1); \
    if ((++_sp & 255u) == 0u) { if (xb_ld(&(bar)[XB_TMO])) break; if (_sp > XB_SPIN_CAP) { atomicAdd(&(bar)[XB_TMO], 1u); break; } } } } while (0)
struct XcdBarrier { unsigned* bar; unsigned x; volatile LAS unsigned* st; };
__device__ __forceinline__ XcdBarrier xcd_barrier_post(unsigned* bar, volatile LAS unsigned* st, bool leader) {
    XcdBarrier b; b.bar = bar; b.x = xb_xcc_id(); b.st = st;
    if (leader) (void)xb_add(&bar[XB_XCNT(b.x)], 1u);
    return b;
}
__device__ __forceinline__ void xcd_barrier_complete(unsigned* bar, unsigned x, unsigned& nloc, unsigned& nx) {
    const unsigned G = gridDim.x * gridDim.y * gridDim.z;
    unsigned sum, cnt, mine, sp = 0u;
    for (;;) {
        sum = 0u; cnt = 0u; mine = 0u;
#pragma unroll
        for (unsigned j = 0; j < 16; ++j) { const unsigned c = xb_ld(&bar[XB_XCNT(j)]); sum += c; cnt += (c > 0u) ? 1u : 0u; mine = (j == x) ? c : mine; }
        if (sum == G) break;
        __builtin_amdgcn_s_sleep(1);
        if ((++sp & 255u) == 0u) { if (xb_ld(&bar[XB_TMO])) break; if (sp > XB_SPIN_CAP) { atomicAdd(&bar[XB_TMO], 1u); break; } }
    }
    nloc = mine > 0u ? mine : 1u; nx = cnt > 0u ? cnt : 1u;
}
__device__ __forceinline__ void xcd_barrier(const XcdBarrier& b, bool leader) {
    asm volatile("s_waitcnt vmcnt(0)" ::: "memory");
    __syncthreads();
    if (leader) {
        unsigned* bar = b.bar;
        __builtin_amdgcn_s_waitcnt(0);
        unsigned nloc = b.st[0], nx = b.st[1];
        if (nloc == 0u) { xcd_barrier_complete(bar, b.x, nloc, nx); b.st[0] = nloc; b.st[1] = nx; }
        const unsigned old = xb_add(&bar[XB_XSUB(b.x)], 1u);
        const unsigned gen = old / nloc;
        if (old + 1u == (gen + 1u) * nloc) {
            __builtin_amdgcn_fence(__ATOMIC_RELEASE, "agent");
            asm volatile("s_waitcnt vmcnt(0)" ::: "memory");
            const unsigned og = xb_add(&bar[XB_TOP], 1u);
            const unsigned tg = og / nx;
            if (og + 1u == (tg + 1u) * nx) xb_add(&bar[XB_TOPGEN], 1u);
            else XB_SPIN(xb_ld(&bar[XB_TOPGEN]) == tg, bar);
            __builtin_amdgcn_fence(__ATOMIC_ACQUIRE, "agent");
            xb_add(&bar[XB_XGEN(b.x)], 1u);
            asm volatile("s_waitcnt vmcnt(0)" ::: "memory");
        } else {
            XB_SPIN(xb_ld(&bar[XB_XGEN(b.x)]) == gen, bar);
            __builtin_amdgcn_fence(__ATOMIC_ACQUIRE, "agent");
            asm volatile("s_waitcnt vmcnt(0)" ::: "memory");
        }
    }
    __syncthreads();
}

namespace pg8 {
constexpr int BM = 256, BK = 64, HALF = 128, HTB = HALF * BK * 2, STAGE_BYTES = 8 * HTB;
__host__ __device__ __forceinline__ int lds_byte(int r, int c) { const int st = (r >> 4) * 2 + (c >> 5), rr = r & 15, cc = c & 31, ob = rr * 64 + cc * 2; return st * 1024 + (ob ^ (((ob >> 9) & 1) << 5)); }
__host__ __device__ __forceinline__ void stage_rc(int b, int& R, int& C) { const int st = b / 1024, sb = b % 1024, swz = sb ^ (((sb >> 9) & 1) << 5); R = (st >> 1) * 16 + swz / 64; C = (st & 1) * 32 + (swz % 64) / 2; }
__host__ __device__ __forceinline__ int perm32(int rho) { const int n = rho >> 4, i = rho & 15; return 8 * (i >> 2) + 4 * n + (i & 3); }
struct Unit { int pm, pn, x; };
struct Dims { int lda, ldb, K; };

typedef int v8i32 __attribute__((ext_vector_type(8)));
template <class Epi, class Sched, bool ALIGN_EPI, bool F8 = false>
__device__ __forceinline__ void gemm_phase(LAS unsigned char* lds, const Dims g, const Sched& S, const Epi& E, int tid_in) {
    int tid_ = tid_in; asm volatile("" : "+v"(tid_));
    const int tid = tid_, wid = __builtin_amdgcn_readfirstlane(tid >> 6), lane = tid & 63, wr = wid >> 2, wc = wid & 3, fr = lane & 15, fq = lane >> 4;
    constexpr int ESZ = F8 ? 1 : 2;
    const int K = g.K; int nt = K * ESZ / (BK * 2); asm volatile("" : "+s"(nt));
    unsigned voffA[2], voffB[2];
#pragma unroll
    for (int i = 0; i < 2; ++i) { int R, C; stage_rc(tid * 16 + i * 8192, R, C); const int Rb = Epi::PERM ? ((R & ~31) + perm32(R & 31)) : R;
        voffA[i] = (unsigned)(R * g.lda * ESZ + C * 2); voffB[i] = (unsigned)(Rb * g.ldb * ESZ + C * 2); }
    const size_t kstep = (size_t)(BK * 2);
    const size_t hA = (size_t)HALF * g.lda * ESZ, hB = (size_t)HALF * g.ldb * ESZ;
    const unsigned ldsw = (unsigned)wid * 1024u;
    const int aoff = lds_byte(wr * 64 + fr, fq * 8), boff = lds_byte(wc * 32 + fr, fq * 8);
#define PG8_SA(b, h) (((b) * 2 + (h)) * HTB)
#define PG8_SB(b, h) ((4 + (b) * 2 + (h)) * HTB)
#define PG8_UNI(p) ((const char*)(const GAS char*)(((unsigned long long)(unsigned)__builtin_amdgcn_readfirstlane((int)((unsigned long long)(p) >> 32)) << 32) | (unsigned)__builtin_amdgcn_readfirstlane((int)(unsigned long long)(p))))
#define PG8_STAGE(bufoff, gbase, soff, voff) do { const char* _gb = PG8_UNI(gbase); const unsigned _so = (unsigned)(soff); _Pragma("unroll") for (int _i = 0; _i < 2; ++_i) \
        __builtin_amdgcn_global_load_lds((const unsigned*)(_gb + ((voff)[_i] + _so)), (LAS unsigned*)(lds + (bufoff) + ldsw + _i * 8192), 16, 0, 0); } while (0)
#define PG8_LD1(dst, off) do { _Pragma("unroll") for (int k = 0; k < 2; ++k) dst[k] = *(const LAS bf16x8*)(lds + (off) + k * 1024); } while (0)
#define PG8_LDA(dst, b, h) do { _Pragma("unroll") for (int m = 0; m < 4; ++m) PG8_LD1(dst[m], PG8_SA(b, h) + aoff + m * 2048); } while (0)
#define PG8_LDB(dst, b, h) do { _Pragma("unroll") for (int n = 0; n < 2; ++n) PG8_LD1(dst[n], PG8_SB(b, h) + boff + n * 2048); } while (0)
#define PG8_CAT(x) __builtin_bit_cast(v8i32, __builtin_shufflevector((x)[0], (x)[1], 0, 1, 2, 3, 4, 5, 6, 7, 8, 9, 10, 11, 12, 13, 14, 15))
#define PG8_MMA(ai, bj, At, Bt) do { __builtin_amdgcn_s_setprio(1); _Pragma("unroll") for (int m = 0; m < 4; ++m) _Pragma("unroll") for (int n = 0; n < 2; ++n) { \
        if constexpr (F8) { const v8i32 b8_ = PG8_CAT(Bt[n]), a8_ = PG8_CAT(At[m]); asm volatile("v_mfma_scale_f32_16x16x128_f8f6f4 %0, %1, %2, %0, %3, %3 op_sel_hi:[0,0,0]" : "+v"(acc[ai][bj][m][n]) : "v"(b8_), "v"(a8_), "v"(0x7f7f7f7f)); } \
        else { _Pragma("unroll") for (int k = 0; k < 2; ++k) acc[ai][bj][m][n] = __builtin_amdgcn_mfma_f32_16x16x32_bf16(Bt[n][k], At[m][k], acc[ai][bj][m][n], 0, 0, 0); } } __builtin_amdgcn_s_setprio(0); } while (0)
#define PG8_WAIT_V(n) asm volatile("s_waitcnt vmcnt(" #n ")" ::: "memory")
#define PG8_WAIT_L(n) asm volatile("s_waitcnt lgkmcnt(" #n ")" ::: "memory")
#define PG8_BAR __builtin_amdgcn_s_barrier()
#define PG8_SCHED __builtin_amdgcn_sched_barrier(0)
    Unit cur, nxt; int ui = 0;
    if (!S.next(0, cur)) return;
    const char* cA; const char* cB; S.ptrs(cur, cA, cB);
    PG8_STAGE(PG8_SB(0, 0), cB, 0, voffB); PG8_STAGE(PG8_SB(0, 1), cB, hB, voffB); PG8_STAGE(PG8_SA(0, 0), cA, 0, voffA); PG8_STAGE(PG8_SA(0, 1), cA, hA, voffA);
    if (wr == 1) PG8_BAR;
    PG8_WAIT_V(2); PG8_BAR;
    PG8_STAGE(PG8_SB(1, 0), cB, kstep, voffB); PG8_STAGE(PG8_SA(1, 0), cA, kstep, voffA); PG8_STAGE(PG8_SB(1, 1), cB, hB + kstep, voffB);
    PG8_WAIT_V(6); PG8_BAR;
    asm volatile("" ::: "memory");
    f32x4 acc[2][2][4][2];
#pragma unroll
    for (int a = 0; a < 2; ++a)
#pragma unroll
        for (int b = 0; b < 2; ++b)
#pragma unroll
            for (int m = 0; m < 4; ++m)
#pragma unroll
                for (int n = 0; n < 2; ++n) acc[a][b][m][n] = (f32x4){0.f, 0.f, 0.f, 0.f};
    typedef int v4i32 __attribute__((ext_vector_type(4)));
    bf16x8 At[4][2], B0[2][2], B1[2][2];
    for (;;) {
        const bool has_next = S.next(ui + 1, nxt);
        const char* nA = cA; const char* nB = cB; if (has_next) S.ptrs(nxt, nA, nB);
        for (int t = 0; t < nt; t += 2) {
            if constexpr (Epi::MIDK) { constexpr int MT = F8 ? 4 : 8; if (t == MT || t == 2 * MT) { int m_fr = fr, m_fq = fq; asm volatile("" : "+v"(m_fr), "+v"(m_fq)); E.mid(acc, cur, t / MT, wr, wc, m_fr, m_fq); } }
            const bool last = (t == nt - 2);
            const size_t o1 = (size_t)(t + 1) * kstep;
            const char* a2 = last ? nA : cA; const char* b2 = last ? nB : cB; const size_t o2 = last ? 0 : (size_t)(t + 2) * kstep, o3 = o2 + kstep;
            PG8_LDB(B0, 0, 0); PG8_LDB(B1, 0, 1); PG8_SCHED; PG8_LDA(At, 0, 0); PG8_STAGE(PG8_SA(1, 1), cA, o1 + hA, voffA);
            PG8_WAIT_V(8); PG8_WAIT_L(0); PG8_BAR; PG8_MMA(0, 0, At, B0); PG8_MMA(0, 1, At, B1); PG8_BAR; PG8_SCHED;
            PG8_LDA(At, 0, 1); PG8_STAGE(PG8_SB(0, 0), b2, o2, voffB); PG8_STAGE(PG8_SB(0, 1), b2, o2 + hB, voffB); PG8_STAGE(PG8_SA(0, 0), a2, o2, voffA);
            PG8_WAIT_V(8); PG8_WAIT_L(0); PG8_BAR; PG8_MMA(1, 0, At, B0); PG8_MMA(1, 1, At, B1); PG8_BAR; PG8_SCHED;
            PG8_LDB(B0, 1, 0); PG8_LDB(B1, 1, 1); PG8_SCHED; PG8_LDA(At, 1, 0); PG8_STAGE(PG8_SA(0, 1), a2, o2 + hA, voffA);
            PG8_WAIT_V(8); PG8_WAIT_L(0); PG8_BAR; PG8_MMA(0, 0, At, B0); PG8_MMA(0, 1, At, B1); PG8_BAR; PG8_SCHED;
            PG8_LDA(At, 1, 1); PG8_STAGE(PG8_SB(1, 0), b2, o3, voffB); PG8_STAGE(PG8_SB(1, 1), b2, o3 + hB, voffB); PG8_STAGE(PG8_SA(1, 0), a2, o3, voffA);
            PG8_WAIT_V(8); PG8_WAIT_L(0); PG8_BAR; PG8_MMA(1, 0, At, B0); PG8_MMA(1, 1, At, B1); PG8_BAR; PG8_SCHED;
        }
        if constexpr (ALIGN_EPI) { if (wr == 0) PG8_BAR; }
        if constexpr (F8) asm volatile("s_nop 15\n\ts_nop 15" ::: "memory");
        { Unit eu = cur; int e_fr = fr, e_fq = fq;
          asm volatile("" : "+v"(e_fr), "+v"(e_fq));
          E(acc, eu, wr, wc, e_fr, e_fq); }
        if (!has_next) break;
#pragma unroll
        for (int a = 0; a < 2; ++a)
#pragma unroll
            for (int b = 0; b < 2; ++b)
#pragma unroll
                for (int m = 0; m < 4; ++m)
#pragma unroll
                    for (int n = 0; n < 2; ++n) acc[a][b][m][n] = (f32x4){0.f, 0.f, 0.f, 0.f};
        cur = nxt; cA = nA; cB = nB; ++ui;
        if constexpr (ALIGN_EPI) { if (wr == 1) PG8_BAR; }
    }
    PG8_WAIT_V(0);
    if constexpr (!ALIGN_EPI) { if (wr == 0) PG8_BAR; }
    PG8_BAR;
#undef PG8_SA
#undef PG8_SB
#undef PG8_STAGE
#undef PG8_UNI
#undef PG8_LDA
#undef PG8_LDB
#undef PG8_MMA
#undef PG8_LD1
#undef PG8_WAIT_V
#undef PG8_WAIT_L
#undef PG8_BAR
#undef PG8_SCHED
}

struct PlainOrder {
    int nM, nN, nwg, G, c; const char* A; const char* Bt; size_t tA, tB;
    __device__ void init(const void* A_, const void* Bt_, int M, int N, int lda, int ldb, int G_, int c_, int esz = 2) { nM = M / BM; nN = N / BM; nwg = nM * nN; G = G_; c = c_; A = (const char*)A_; Bt = (const char*)Bt_; tA = (size_t)BM * lda * esz; tB = (size_t)BM * ldb * esz; }
    __device__ __forceinline__ bool next(int i, Unit& u) const {
        const long L = (long)i * G + c; if (L >= nwg) return false;
        int wgid = (int)L; { const int q = nwg / 8, r = nwg % 8, xcd = wgid % 8, off = wgid / 8; wgid = (xcd < r ? xcd * (q + 1) : r * (q + 1) + (xcd - r) * q) + off; }
        const int nig = 8 * nN, gid = wgid / nig, fm = gid * 8, gsz = (nM - fm) < 8 ? (nM - fm) : 8;
        u.pm = fm + ((wgid % nig) % gsz); u.pn = (wgid % nig) / gsz; u.x = 0; return true;
    }
    __device__ __forceinline__ void ptrs(const Unit& u, const char*& a, const char*& b) const { a = A + (size_t)u.pm * tA; b = Bt + (size_t)u.pn * tB; }
};
struct SubsetOrder : PlainOrder {
    int split, skip;
    __device__ __forceinline__ bool next(int i, Unit& u) const { if (!PlainOrder::next(i, u)) return false; u.x = u.pn; u.pn = u.pn < split ? u.pn : u.pn + skip; return true; }
    __device__ __forceinline__ void ptrs(const Unit& u, const char*& a, const char*& b) const { a = A + (size_t)u.pm * tA; b = Bt + (size_t)u.x * tB; }
};
}

#ifndef FP8_INPROJ
#define FP8_INPROJ 1
#endif
struct Frame {
    LAS unsigned char* lds;
    volatile LAS unsigned* MISC;
    unsigned* ctl;
    unsigned char* ws;
    int tid, lane, wave, G, bid;
    const float* const* in;
    float* xf;
};
using pg8::Unit;
#ifndef FP8_FFN
#define FP8_FFN 0
#endif
#ifndef FP8_MRG
#define FP8_MRG 1
#endif
constexpr float YS_SC = 4.0f;
constexpr int YS8_OFF = 1024, YS8_LD = 3072;
#ifndef FP8_OUT
#define FP8_OUT 0
#endif
#ifndef FP8_DDN
#define FP8_DDN 0
#endif
#ifndef FP8_MOE
#define FP8_MOE 1
#endif
__device__ __forceinline__ unsigned pk4_fp8(float a, float b, float c, float d) { int w = __builtin_amdgcn_cvt_pk_fp8_f32(a, b, 0, false); w = __builtin_amdgcn_cvt_pk_fp8_f32(c, d, w, true); return (unsigned)w; }
#define INP(i) ((const float*)(const GAS float*)F.in[i])

typedef const f32x4 (&AccRef)[2][2][4][2];
#define OPQ_S(x) asm volatile("" : "+s"(x))
#define OPQ_V(x) asm volatile("" : "+v"(x))

struct EpiRes {
    static constexpr bool PERM = false, MIDK = false;
    const bf16_t* xb; bf16_t* vb; int dry; float scl = 1.0f;
    __device__ __forceinline__ void operator()(AccRef acc, const Unit& u, int wr, int wc, int fr, int fq) const {
        const int row0 = u.pm * 256 + wr * 64 + fr, col0 = u.pn * 256 + wc * 32 + 4 * fq;
#pragma unroll
        for (int ai = 0; ai < 2; ++ai)
#pragma unroll
            for (int m = 0; m < 4; ++m) { const size_t ro = (size_t)(row0 + ai * 128 + m * 16) * DM + col0;
#pragma unroll
                for (int bj = 0; bj < 2; ++bj)
#pragma unroll
                    for (int n = 0; n < 2; ++n) { const u32x2 x = *(const u32x2*)(xb + ro + bj * 128 + n * 16); const f32x4 a = acc[ai][bj][m][n] * scl;
                        u32x2 w; w.x = cvt_pk_h16(bflo(x.x) * ALPHA + a[0], bfhi(x.x) * ALPHA + a[1]); w.y = cvt_pk_h16(bflo(x.y) * ALPHA + a[2], bfhi(x.y) * ALPHA + a[3]);
                        if (!dry || w.x == 0x12345678u) *(u32x2*)(vb + ro + bj * 128 + n * 16) = w; }
                if (m & 1) asm volatile("" ::: "memory"); }
    }
};
template <bool F8OUT> struct EpiSwigluT {
    static constexpr bool PERM = true, MIDK = false;
    bf16_t* hid; int dry;
    __device__ __forceinline__ void operator()(AccRef acc, const Unit& u, int wr, int wc, int fr, int fq) const {
        const int row0 = u.pm * 256 + wr * 64 + fr, col0 = u.pn * 128 + wc * 32 + 8 * fq;
#pragma unroll
        for (int ai = 0; ai < 2; ++ai)
#pragma unroll
            for (int m = 0; m < 4; ++m) { bf16_t* rowp = hid + (size_t)(row0 + ai * 128 + m * 16) * DFF + col0;
                float h[8];
#pragma unroll
                for (int n = 0; n < 2; ++n)
#pragma unroll
                    for (int j = 0; j < 4; ++j) h[n * 4 + j] = siluf_(acc[ai][0][m][n][j]) * acc[ai][1][m][n][j];
                if (F8OUT) { u32x2 w8; w8.x = pk4_fp8(h[0], h[1], h[2], h[3]); w8.y = pk4_fp8(h[4], h[5], h[6], h[7]);
                    if (!dry || w8.x == 0x12345678u) *(u32x2*)((unsigned char*)hid + (size_t)(row0 + ai * 128 + m * 16) * DFF + col0) = w8; }
                else { u32x4 w; w.x = cvt_pk_bf16(h[0], h[1]); w.y = cvt_pk_bf16(h[2], h[3]); w.z = cvt_pk_bf16(h[4], h[5]); w.w = cvt_pk_bf16(h[6], h[7]);
                    if (!dry || w.x == 0x12345678u) *(u32x4*)rowp = w; } }
    }
};
typedef EpiSwigluT<false> EpiSwiglu;
template <int ACT  > struct EpiBf16 {
    static constexpr bool PERM = true, MIDK = false;
    bf16_t* out; int ldc; float scl = 1.0f;
    __device__ __forceinline__ void operator()(AccRef acc, const Unit& u, int wr, int wc, int fr, int fq) const {
        const int row0 = u.pm * 256 + wr * 64 + fr, col0 = u.pn * 256 + wc * 32 + 8 * fq;
#pragma unroll
        for (int ai = 0; ai < 2; ++ai)
#pragma unroll
            for (int m = 0; m < 4; ++m) { bf16_t* rowp = out + (size_t)(row0 + ai * 128 + m * 16) * ldc + col0;
#pragma unroll
                for (int bj = 0; bj < 2; ++bj) { f32x4 v0 = acc[ai][bj][m][0], v1 = acc[ai][bj][m][1];
                    if (ACT == 0) { v0 = v0 * scl; v1 = v1 * scl; }
                    if (ACT == 1) {
#pragma unroll
                        for (int j = 0; j < 4; ++j) { v0[j] = sigmoidf_(v0[j]); v1[j] = sigmoidf_(v1[j]); } }
                    u32x4 w; if (ACT == 0) { w.x = cvt_pk_h16(v0[0], v0[1]); w.y = cvt_pk_h16(v0[2], v0[3]); w.z = cvt_pk_h16(v1[0], v1[1]); w.w = cvt_pk_h16(v1[2], v1[3]); }
                    else { w.x = cvt_pk_bf16(v0[0], v0[1]); w.y = cvt_pk_bf16(v0[2], v0[3]); w.z = cvt_pk_bf16(v1[0], v1[1]); w.w = cvt_pk_bf16(v1[2], v1[3]); }
                    *(u32x4*)(rowp + bj * 128) = w; } }
    }
};
template <bool MID> struct EpiMergeT {
    static constexpr bool PERM = true, MIDK = MID;
    const unsigned char* gates; bf16_t* merged;
    typedef f32x4 (&AccMut)[2][2][4][2];
    static __device__ __forceinline__ float gb(unsigned w, int i) { return (float)((w >> (8 * i)) & 255u); }
    __device__ __forceinline__ void mid(AccMut acc, const Unit& u, int seg, int wr, int wc, int fr, int fq) const {
        const int row0 = u.pm * 256 + wr * 64 + fr, col0 = u.pn * 256 + wc * 32 + 8 * fq; const int c = seg - 1;
#pragma unroll
        for (int ai = 0; ai < 2; ++ai)
#pragma unroll
            for (int m = 0; m < 4; ++m) { const size_t r = (size_t)(row0 + ai * 128 + m * 16);
#pragma unroll
                for (int bj = 0; bj < 2; ++bj) {
                    const u32x2 ga = *(const u32x2*)(gates + r * NIN_B + c * DM + col0 + bj * 128), g2 = *(const u32x2*)(gates + r * NIN_B + (c + 1) * DM + col0 + bj * 128);
                    f32x4 v0 = acc[ai][bj][m][0], v1 = acc[ai][bj][m][1];
#pragma unroll
                    for (int j = 0; j < 4; ++j) { v0[j] *= gb(ga.x, j) * fast_rcp(gb(g2.x, j)); v1[j] *= gb(ga.y, j) * fast_rcp(gb(g2.y, j)); }
                    acc[ai][bj][m][0] = v0; acc[ai][bj][m][1] = v1; }
                if (m & 1) asm volatile("" ::: "memory"); }
    }
    __device__ __forceinline__ void operator()(AccRef acc, const Unit& u, int wr, int wc, int fr, int fq) const {
        const int row0 = u.pm * 256 + wr * 64 + fr, col0 = u.pn * 256 + wc * 32 + 8 * fq;
#pragma unroll
        for (int ai = 0; ai < 2; ++ai)
#pragma unroll
            for (int m = 0; m < 4; ++m) { const size_t r = (size_t)(row0 + ai * 128 + m * 16);
#pragma unroll
                for (int bj = 0; bj < 2; ++bj) {
                    const u32x2 g = *(const u32x2*)(gates + r * NIN_B + 2 * DM + col0 + bj * 128);
                    const f32x4 v0 = acc[ai][bj][m][0], v1 = acc[ai][bj][m][1]; const float k = (FP8_OUT ? 8.0f : 1.0f) * (FP8_MRG ? 1.0f / (YS_SC * 16.0f) : 1.0f) / 255.0f;
                    if (FP8_OUT) { u32x2 w8; w8.x = pk4_fp8(gb(g.x, 0) * k * v0[0], gb(g.x, 1) * k * v0[1], gb(g.x, 2) * k * v0[2], gb(g.x, 3) * k * v0[3]);
                        w8.y = pk4_fp8(gb(g.y, 0) * k * v1[0], gb(g.y, 1) * k * v1[1], gb(g.y, 2) * k * v1[2], gb(g.y, 3) * k * v1[3]);
                        *(u32x2*)((unsigned char*)merged + r * DM + col0 + bj * 128) = w8; }
                    else { u32x4 w;
                    w.x = cvt_pk_bf16(gb(g.x, 0) * k * v0[0], gb(g.x, 1) * k * v0[1]); w.y = cvt_pk_bf16(gb(g.x, 2) * k * v0[2], gb(g.x, 3) * k * v0[3]);
                    w.z = cvt_pk_bf16(gb(g.y, 0) * k * v1[0], gb(g.y, 1) * k * v1[1]); w.w = cvt_pk_bf16(gb(g.y, 2) * k * v1[2], gb(g.y, 3) * k * v1[3]);
                    *(u32x4*)(merged + r * DM + col0 + bj * 128) = w; } }
                if (m & 1) asm volatile("" ::: "memory"); }
    }
};
typedef EpiMergeT<true> EpiMerge;
struct EpiCmp1 {
    static constexpr bool PERM = true, MIDK = false;
    bf16_t* hidc; const float* b1;
    __device__ __forceinline__ void operator()(AccRef acc, const Unit& u, int wr, int wc, int fr, int fq) const {
        const int kv = u.x; const int row0 = u.pm * 256 + wr * 64 + fr, col0 = wc * 32 + 8 * fq;
        f32x4 bv[2][2];
#pragma unroll
        for (int bj = 0; bj < 2; ++bj)
#pragma unroll
            for (int n = 0; n < 2; ++n) bv[bj][n] = *(const f32x4*)(b1 + kv * 256 + col0 + bj * 128 + 4 * n);
#pragma unroll
        for (int ai = 0; ai < 2; ++ai)
#pragma unroll
            for (int m = 0; m < 4; ++m) { bf16_t* rowp = hidc + ((size_t)kv * 4096 + (row0 + ai * 128 + m * 16)) * 256 + col0;
#pragma unroll
                for (int bj = 0; bj < 2; ++bj) { f32x4 v0 = acc[ai][bj][m][0] + bv[bj][0], v1 = acc[ai][bj][m][1] + bv[bj][1];
#pragma unroll
                    for (int j = 0; j < 4; ++j) { float x = v0[j]; v0[j] = x * sigmoidf_(1.5957691216057308f * (x + 0.044715f * x * x * x)); x = v1[j]; v1[j] = x * sigmoidf_(1.5957691216057308f * (x + 0.044715f * x * x * x)); }
                    u32x4 w; w.x = cvt_pk_bf16(v0[0], v0[1]); w.y = cvt_pk_bf16(v0[2], v0[3]); w.z = cvt_pk_bf16(v1[0], v1[1]); w.w = cvt_pk_bf16(v1[2], v1[3]);
                    *(u32x4*)(rowp + bj * 128) = w; } }
    }
};
struct EpiInA {
    static constexpr bool PERM = true, MIDK = false;
    unsigned char* ws; const float* cs; const float* sn;
    __device__ __forceinline__ void operator()(AccRef acc, const Unit& u, int wr, int wc, int fr, int fq) const {
        const int pn = u.pn; const int row0 = u.pm * 256 + wr * 64 + fr; const int cc = wc * 32 + 8 * fq;
        if (pn >= 7 && pn <= 10) {
#pragma unroll
            for (int ai = 0; ai < 2; ++ai)
#pragma unroll
                for (int m = 0; m < 4; ++m) { bf16_t* rowp = (bf16_t*)(ws + R_CONV) + (size_t)(row0 + ai * 128 + m * 16) * 1024 + 512 + (pn - 7) * 128 + cc;
                    const f32x4 u0 = acc[ai][0][m][0] * acc[ai][1][m][0], u1 = acc[ai][0][m][1] * acc[ai][1][m][1];
                    u32x4 w; w.x = cvt_pk_bf16(u0[0], u0[1]); w.y = cvt_pk_bf16(u0[2], u0[3]); w.z = cvt_pk_bf16(u1[0], u1[1]); w.w = cvt_pk_bf16(u1[2], u1[3]);
                    *(u32x4*)rowp = w; }
        } else if (pn < 2 || pn == 5 || pn == 6 || pn == 17 || pn == 18) {
            bf16_t* base; int ldc, cb; float sc = 1.f; int act = 0;
            if (pn < 2) { base = (bf16_t*)(ws + R_Q); ldc = 512; cb = pn * 256; sc = QSCALE; }
            else if (pn <= 6) { base = (bf16_t*)(ws + R_CONV); ldc = 1024; cb = (pn - 5) * 256; }
            else { base = (bf16_t*)(ws + R_RG); ldc = 512; cb = (pn - 17) * 256; act = 1; }
#pragma unroll
            for (int ai = 0; ai < 2; ++ai)
#pragma unroll
                for (int m = 0; m < 4; ++m) { bf16_t* rowp = base + (size_t)(row0 + ai * 128 + m * 16) * ldc + cb + cc;
#pragma unroll
                    for (int bj = 0; bj < 2; ++bj) { f32x4 v0 = acc[ai][bj][m][0] * sc, v1 = acc[ai][bj][m][1] * sc;
                        if (act) {
#pragma unroll
                            for (int j = 0; j < 4; ++j) { v0[j] = siluf_(v0[j]); v1[j] = siluf_(v1[j]); } }
                        u32x4 w; w.x = cvt_pk_bf16(v0[0], v0[1]); w.y = cvt_pk_bf16(v0[2], v0[3]); w.z = cvt_pk_bf16(v1[0], v1[1]); w.w = cvt_pk_bf16(v1[2], v1[3]);
                        *(u32x4*)(rowp + bj * 128) = w; } }
        } else if (pn <= 4) {
#pragma unroll
            for (int bj = 0; bj < 2; ++bj) {
                const int colkv = (pn - 2) * 256 + bj * 128 + cc, c = colkv >> 6, d0 = colkv & 63, br = c >> 2, kvi = (c >> 1) & 1, g = c & 1;
#pragma unroll
                for (int ai = 0; ai < 2; ++ai)
#pragma unroll
                    for (int m = 0; m < 4; ++m) { const int row = row0 + ai * 128 + m * 16, b = row >> 14, t = row & (SEQ - 1);
                        const f32x4 v0 = acc[ai][bj][m][0], v1 = acc[ai][bj][m][1];
                        if (br == 1) {
                            if (kvi == 0) { unsigned char* base = (unsigned char*)(ws + R_KNAT) + ((size_t)(b * 2 + g) * SEQ + t) * 64 + d0;
                                int w0 = __builtin_amdgcn_cvt_pk_fp8_f32(v0[0], v0[1], 0, false); w0 = __builtin_amdgcn_cvt_pk_fp8_f32(v0[2], v0[3], w0, true);
                                int w1 = __builtin_amdgcn_cvt_pk_fp8_f32(v1[0], v1[1], 0, false); w1 = __builtin_amdgcn_cvt_pk_fp8_f32(v1[2], v1[3], w1, true);
                                *(u32x2*)base = (u32x2){(unsigned)w0, (unsigned)w1};
                            } else { unsigned char* base = (unsigned char*)(ws + R_VT) + ((size_t)(b * 2 + g) * SEQ + (t & ~63)) * 64 + (t & 63);
#pragma unroll
                                for (int j = 0; j < 4; ++j) { base[(d0 + j) * 64] = (unsigned char)__builtin_amdgcn_cvt_pk_fp8_f32(v0[j], v0[j], 0, false); base[(d0 + 4 + j) * 64] = (unsigned char)__builtin_amdgcn_cvt_pk_fp8_f32(v1[j], v1[j], 0, false); } }
                        } else if (br == 0) {
                            unsigned char* base = (unsigned char*)(ws + R_CMPRAW) + ((size_t)((kvi * 2 + b) * 2 + g) * SEQ + t) * 64 + d0;
                            *(u32x2*)base = (u32x2){pk4_fp8(v0[0], v0[1], v0[2], v0[3]), pk4_fp8(v1[0], v1[1], v1[2], v1[3])};
                        } else if (kvi == 0) {
                            bf16_t* base = (bf16_t*)(ws + R_KNAT) + ((size_t)(((br - 1) * 2 + b) * 2 + g) * SEQ + t) * 64;
                            u32x4 w; w.x = cvt_pk_bf16(v0[0], v0[1]); w.y = cvt_pk_bf16(v0[2], v0[3]); w.z = cvt_pk_bf16(v1[0], v1[1]); w.w = cvt_pk_bf16(v1[2], v1[3]);
                            *(u32x4*)(base + d0) = w;
                        } else {
                            bf16_t* base = (bf16_t*)(ws + R_VT) + ((size_t)(((br - 1) * 2 + b) * 2 + g) * SEQ + (t & ~63)) * 64 + (t & 63);
#pragma unroll
                            for (int j = 0; j < 4; ++j) { base[(d0 + j) * 64] = f2bf(v0[j]); base[(d0 + 4 + j) * 64] = f2bf(v1[j]); }
                        } }
            }
        } else if (pn <= 14) {
            const int ti = pn - 11, isK = ti >> 1, hp = ti & 1, head = 2 * hp + (cc >> 6), i0 = cc & 63;
            const float sc = isK ? 0.08838834764831845f : 1.0f;
            const float l2g = __builtin_log2f(1.0f - __builtin_exp2f(-5.0f - (float)head));
            bf16_t* nat = (bf16_t*)(ws + (isK ? R_RK : R_RQ));
#pragma unroll
            for (int ai = 0; ai < 2; ++ai)
#pragma unroll
                for (int m = 0; m < 4; ++m) { const int row = row0 + ai * 128 + m * 16, b = row >> 14, t = row & (SEQ - 1);
                    float o1[8], o2[8];
#pragma unroll
                    for (int n = 0; n < 2; ++n) { const f32x4 c4 = *(const f32x4*)(cs + (size_t)t * 64 + i0 + 4 * n), s4 = *(const f32x4*)(sn + (size_t)t * 64 + i0 + 4 * n);
                        const f32x4 x1 = acc[ai][0][m][n], x2 = acc[ai][1][m][n];
#pragma unroll
                        for (int j = 0; j < 4; ++j) { o1[n * 4 + j] = (x1[j] * c4[j] - x2[j] * s4[j]) * sc; o2[n * 4 + j] = (x1[j] * s4[j] + x2[j] * c4[j]) * sc; } }
                    bf16_t* rowp = nat + (size_t)row * 512 + head * 128 + i0;
                    u32x4 w; w.x = cvt_pk_bf16(o1[0], o1[1]); w.y = cvt_pk_bf16(o1[2], o1[3]); w.z = cvt_pk_bf16(o1[4], o1[5]); w.w = cvt_pk_bf16(o1[6], o1[7]);
                    *(u32x4*)rowp = w;
                    w.x = cvt_pk_bf16(o2[0], o2[1]); w.y = cvt_pk_bf16(o2[2], o2[3]); w.z = cvt_pk_bf16(o2[4], o2[5]); w.w = cvt_pk_bf16(o2[6], o2[7]);
                    *(u32x4*)(rowp + 64) = w;
                    }
        } else if (pn <= 16) {
#pragma unroll
            for (int ai = 0; ai < 2; ++ai)
#pragma unroll
                for (int m = 0; m < 4; ++m) { bf16_t* rowp = (bf16_t*)(ws + R_VTR) + (size_t)(row0 + ai * 128 + m * 16) * 512 + (pn - 15) * 256 + cc;
#pragma unroll
                    for (int bj = 0; bj < 2; ++bj) { const f32x4 v0 = acc[ai][bj][m][0], v1 = acc[ai][bj][m][1];
                        u32x4 w; w.x = cvt_pk_bf16(v0[0], v0[1]); w.y = cvt_pk_bf16(v0[2], v0[3]); w.z = cvt_pk_bf16(v1[0], v1[1]); w.w = cvt_pk_bf16(v1[2], v1[3]);
                        *(u32x4*)(rowp + bj * 128) = w; } }
        } else if (pn >= 20) {
#pragma unroll
            for (int ai = 0; ai < 2; ++ai)
#pragma unroll
                for (int m = 0; m < 4; ++m) { unsigned char* rowp = (unsigned char*)(ws + R_GATES) + (size_t)(row0 + ai * 128 + m * 16) * NIN_B + (pn - 20) * 256 + cc;
#pragma unroll
                    for (int bj = 0; bj < 2; ++bj) { const f32x4 v0 = acc[ai][bj][m][0], v1 = acc[ai][bj][m][1]; unsigned q[8];
#pragma unroll
                        for (int j = 0; j < 4; ++j) { q[j] = (unsigned)fmaxf(sigmoidf_(v0[j]) * 255.0f + 0.5f, 1.0f); q[4 + j] = (unsigned)fmaxf(sigmoidf_(v1[j]) * 255.0f + 0.5f, 1.0f); }
                        u32x2 w; w.x = q[0] | (q[1] << 8) | (q[2] << 16) | (q[3] << 24); w.y = q[4] | (q[5] << 8) | (q[6] << 16) | (q[7] << 24);
                        *(u32x2*)(rowp + bj * 128) = w; } }
        } else {
            if (wc == 0 && fq < 3) {
#pragma unroll
                for (int ai = 0; ai < 2; ++ai)
#pragma unroll
                    for (int m = 0; m < 4; ++m) { const int row = row0 + ai * 128 + m * 16;
                        f32x4 v0 = acc[ai][0][m][0], v1 = acc[ai][0][m][1];
#pragma unroll
                        for (int j = 0; j < 4; ++j) { v0[j] = sigmoidf_(v0[j]); v1[j] = sigmoidf_(v1[j]); }
                        u32x4 w; w.x = cvt_pk_bf16(v0[0], v0[1]); w.y = cvt_pk_bf16(v0[2], v0[3]); w.z = cvt_pk_bf16(v1[0], v1[1]); w.w = cvt_pk_bf16(v1[2], v1[3]);
                        *(u32x4*)((bf16_t*)(ws + R_NG) + (size_t)row * 32 + 8 * fq) = w; }
            }
        }
    }
};

struct CmpOrder {
    int G, c; const char* A; const char* Bt;
    __device__ __forceinline__ bool next(int i, Unit& u) const { const int L = i * G + c; if (L >= 32) return false; u.x = L >> 4; u.pm = L & 15; u.pn = 0; return true; }
    __device__ __forceinline__ void ptrs(const Unit& u, const char*& a, const char*& b) const {
        a = A + ((size_t)u.x * 4 * SEQ * 64 + (size_t)u.pm * 256 * 1024); b = Bt + (size_t)u.x * 256 * 2048; }
};
struct MoeOrder {
    int G, c, NT; const LAS int* tab; const char* A; const char* Bt; size_t tA, tB, eB;
    __device__ __forceinline__ bool next(int i, Unit& u) const {
        const int TM = tab[8]; const long L = (long)i * G + c; if (L >= (long)TM * NT) return false;
        u.pm = (int)(L / NT); u.pn = (int)(L % NT); int e = 0;
#pragma unroll
        for (int k = 1; k < 8; ++k) e += (tab[k] <= u.pm) ? 1 : 0;
        u.x = e; return true; }
    __device__ __forceinline__ void ptrs(const Unit& u, const char*& a, const char*& b) const { a = A + (size_t)u.pm * tA; b = Bt + (size_t)u.x * eB + (size_t)u.pn * tB; }
};

__device__ __forceinline__ void cvt_item(const float* src, int ldw, int nvalid, bf16_t* dst, int ldk, LAS float* scr, int lane, bool q8 = false, float qs = 1.0f) {
    const int c4 = lane & 15, kr = lane >> 4;
    f32x4 vin[2][8];
#pragma unroll
    for (int half = 0; half < 2; ++half)
#pragma unroll
        for (int i = 0; i < 8; ++i) { vin[half][i] = (f32x4){0.f, 0.f, 0.f, 0.f}; if (c4 * 4 < nvalid) vin[half][i] = *(const f32x4*)(src + (size_t)(half * 32 + kr + 4 * i) * ldw + c4 * 4); }
#pragma unroll
    for (int half = 0; half < 2; ++half) {
#pragma unroll
        for (int i = 0; i < 8; ++i) { const int kk = kr + 4 * i; const f32x4 v = vin[half][i];
#pragma unroll
            for (int e = 0; e < 4; ++e) scr[kk * 65 + c4 * 4 + e] = (c4 * 4 + e < nvalid) ? v[e] : 0.f; }
        LDS_WAIT(); asm volatile("" ::: "memory");
        const int c = lane & 3;
#pragma unroll
        for (int j = 0; j < 4; ++j) { const int n = (lane >> 2) + 16 * j; const LAS float* s = scr + (8 * c) * 65 + n;
            if (q8) { u32x2 o8; o8.x = pk4_fp8(s[0 * 65] * qs, s[1 * 65] * qs, s[2 * 65] * qs, s[3 * 65] * qs); o8.y = pk4_fp8(s[4 * 65] * qs, s[5 * 65] * qs, s[6 * 65] * qs, s[7 * 65] * qs); *(u32x2*)((unsigned char*)dst + (size_t)n * ldk + half * 32 + 8 * c) = o8; }
            else { u32x4 o; o.x = cvt_pk_bf16(s[0 * 65], s[1 * 65]); o.y = cvt_pk_bf16(s[2 * 65], s[3 * 65]); o.z = cvt_pk_bf16(s[4 * 65], s[5 * 65]); o.w = cvt_pk_bf16(s[6 * 65], s[7 * 65]); *(u32x4*)(dst + (size_t)n * ldk + half * 32 + 8 * c) = o; } }
        LDS_WAIT(); asm volatile("" ::: "memory");
    }
}
__device__ __forceinline__ void win_map(int n0, int& c, int& nvalid) {
    nvalid = 64;
    if (n0 < 1280) c = n0;
    else if (n0 < 1792) c = n0 + 24;
    else if (n0 < 2816) { const int tl = n0 - 1792, tj = tl >> 8, w = tl & 255; c = (w < 128 ? 1816 : 2328 - 128) + tj * 128 + w; }
    else if (n0 < 3840) { const int ti = (n0 - 2816) >> 8, tl = (n0 - 2816) & 255, base = ti < 2 ? 2840 : 3352, hp = ti & 1, half = tl >> 7, hh = (tl & 127) >> 6, i = tl & 63; c = base + (2 * hp + hh) * 128 + half * 64 + i; }
    else if (n0 < 4864) c = n0 + 24;
    else if (n0 == 4864) { c = 1280; nvalid = 24; }
    else if (n0 < 5120) { c = 0; nvalid = 0; }
    else c = 4888 + (n0 - 5120);
}
__device__ __forceinline__ void phase_weights(Frame& F, int l) {
    LAS float* scr = (LAS float*)(F.lds + F.wave * 16384);
    const int gw = F.bid * NWAVES + F.wave, NGW = F.G * NWAVES;
    const bool moe = (l & 1);
    const float* w_in = INP(1) + (size_t)l * DM * IN_COLS;
    const float* cw1 = INP(3) + (size_t)l * 2 * 2048 * 256;
    const float* cw2 = INP(5) + (size_t)l * 2 * 256 * 64;
    const float* wbr = INP(10) + (size_t)l * 3 * 512 * DM;
    const float* wout = INP(11) + (size_t)l * DM * DM;
    const int I_IN = 128 * 16, I_C1 = 2 * 4 * 32, I_C2 = 2 * 1 * 4, I_BR = 3 * 16 * 8, I_OUT = 16 * 16, I_GU = 112 * 16, I_DN = 16 * 56;
    const int nE = moe ? NEXP : 1;
    const int NITEMS = I_IN + I_C1 + I_C2 + I_BR + I_OUT + nE * (I_GU + I_DN);
    for (int it = gw; it < NITEMS; it += NGW) {
        int r = it; const float* src; int ldw, nv = 64, ldk; bf16_t* d; bool q8 = false; float qs = 1.0f;
        if (r < I_IN) { const int nb = r >> 4, kb = r & 15, n0 = nb * 64; int c; win_map(n0, c, nv); const bool conv = (n0 >= 1280 && n0 < 2816);
            d = (FP8_INPROJ && !conv) ? (bf16_t*)((unsigned char*)(F.ws + W_IN) + (size_t)(n0 < 1280 ? n0 : n0 - 1536) * DM + kb * 64)
              : FP8_INPROJ ? (bf16_t*)(F.ws + W_IN + 8 * MiB) + (size_t)(n0 - 1280) * DM + kb * 64 : (bf16_t*)(F.ws + W_IN) + (size_t)n0 * DM + kb * 64;
            src = w_in + (size_t)(kb * 64) * IN_COLS + c; ldw = IN_COLS; ldk = DM; q8 = FP8_INPROJ && !conv; }
        else if ((r -= I_IN) < I_C1) { const int kv = r >> 7, q = r & 127, nb = q >> 5, kb = q & 31;
            src = cw1 + ((size_t)kv * 2048 + kb * 64) * 256 + nb * 64; ldw = 256; d = (bf16_t*)((unsigned char*)(F.ws + W_C1) + ((size_t)kv * 256 + nb * 64) * 2048 + kb * 64); ldk = 2048; q8 = true; }
        else if ((r -= I_C1) < I_C2) { const int kv = r >> 2, kb = r & 3;
            src = cw2 + ((size_t)kv * 256 + kb * 64) * 64; ldw = 64; d = (bf16_t*)(F.ws + W_C2) + ((size_t)kv * 64) * 256 + kb * 64; ldk = 256; }
        else if ((r -= I_C2) < I_BR) { const int c = r >> 7, q = r & 127, nb = q >> 3, kb = q & 7;
            src = wbr + ((size_t)c * 512 + kb * 64) * DM + nb * 64; ldw = DM; q8 = FP8_MRG != 0; qs = q8 ? 16.0f : 1.0f; d = q8 ? (bf16_t*)((unsigned char*)(F.ws + W_BR) + (size_t)(nb * 64) * 1536 + c * 512 + kb * 64) : (bf16_t*)(F.ws + W_BR) + (size_t)(nb * 64) * 1536 + c * 512 + kb * 64; ldk = 1536; }
        else if ((r -= I_BR) < I_OUT) { const int nb = r >> 4, kb = r & 15;
            src = wout + (size_t)(kb * 64) * DM + nb * 64; ldw = DM; q8 = FP8_OUT != 0; qs = q8 ? 16.0f : 1.0f; d = q8 ? (bf16_t*)((unsigned char*)(F.ws + W_OUT) + (size_t)(nb * 64) * DM + kb * 64) : (bf16_t*)(F.ws + W_OUT) + (size_t)(nb * 64) * DM + kb * 64; ldk = DM; }
        else { r -= I_OUT; const int e = r / (I_GU + I_DN); r -= e * (I_GU + I_DN);
          const size_t wsz = (size_t)DM * DFF; const size_t eo = moe ? ((size_t)(l >> 1) * NEXP + e) * wsz : (size_t)(l >> 1) * wsz;
          bf16_t* gu_t = (bf16_t*)(F.ws + W_FFN) + (size_t)e * 3 * wsz; bf16_t* dn_t = gu_t + 2 * wsz;
          if (r < I_GU) { const int nb = r >> 4, kb = r & 15, n0 = nb * 64, pn = n0 >> 8, j = n0 & 255;
              src = ((j < 128) ? (moe ? INP(20) : INP(16)) + eo + pn * 128 + j : (moe ? INP(21) : INP(17)) + eo + pn * 128 + (j - 128)) + (size_t)(kb * 64) * DFF; ldw = DFF; q8 = moe ? (FP8_MOE != 0) : (FP8_FFN != 0); d = q8 ? (bf16_t*)((unsigned char*)gu_t + (size_t)n0 * DM + kb * 64) : gu_t + (size_t)n0 * DM + kb * 64; ldk = DM; }
          else { r -= I_GU; const int nb = r / 56, kb = r % 56;
              src = (moe ? INP(22) : INP(18)) + eo + (size_t)(kb * 64) * DM + nb * 64; ldw = DM; q8 = moe ? (FP8_MOE != 0) : (FP8_DDN != 0); qs = q8 ? 64.0f : 1.0f; d = q8 ? (bf16_t*)((unsigned char*)dn_t + (size_t)(nb * 64) * DFF + kb * 64) : dn_t + (size_t)(nb * 64) * DFF + kb * 64; ldk = DFF; } }
        cvt_item(src, ldw, nv, d, ldk, scr, F.lane, q8, qs);
    }
    { const float* pos = INP(2) + (size_t)l * 2 * 2048; float* part = (float*)(F.ws + W_B1);
      for (int it = gw; it < 128; it += NGW) { const int kc = it >> 3, q = it & 7, kv = q >> 2, nb = q & 3; const int n = nb * 64 + F.lane;
          const float* w = cw1 + ((size_t)kv * 2048 + kc * 128) * 256 + n; const float* p = pos + kv * 2048 + kc * 128; float s = 0.f;
#pragma unroll 16
          for (int k = 0; k < 128; ++k) s += p[k] * w[(size_t)k * 256];
          part[kc * 512 + kv * 256 + n] = s; } }
}
__device__ __forceinline__ void phase_bias(Frame& F, int l) {
    if (F.bid == 0) { const float* part = (const float*)(F.ws + W_B1); float s = INP(4)[(size_t)l * 512 + F.tid];
        for (int kc = 0; kc < 16; ++kc) s += part[kc * 512 + F.tid];
        ((float*)(F.ws + W_B1))[16 * 512 + F.tid] = s; }
}
__device__ __forceinline__ void phase_init(Frame& F) {
    const int gw = F.bid * NWAVES + F.wave, NGW = F.G * NWAVES;
    const float* x = INP(0); bf16_t* xb = (bf16_t*)(F.ws + WS_XB);
    for (int m = gw; m < MTOK; m += NGW) {
#pragma unroll
        for (int j = 0; j < 4; ++j) { const f32x4 v = *(const f32x4*)(x + (size_t)m * DM + 4 * F.lane + 256 * j);
            u32x2 w; w.x = cvt_pk_bf16(v[0], v[1]); w.y = cvt_pk_bf16(v[2], v[3]); *(u32x2*)(xb + (size_t)m * DM + 4 * F.lane + 256 * j) = w;
            if (FP8_INPROJ) *(unsigned*)((unsigned char*)F.xf + (size_t)m * DM + 4 * F.lane + 256 * j) = pk4_fp8(v[0], v[1], v[2], v[3]); } }
    float* cs = (float*)(F.ws + WS_COS); float* sn = (float*)(F.ws + WS_SIN);
    const float inv = powf(10000.0f, -(float)(2 * F.lane) / 128.0f);
    for (int t = gw; t < SEQ; t += NGW) { const float ang = (float)t * inv; float s, c; sincosf(ang, &s, &c); cs[(size_t)t * 64 + F.lane] = c; sn[(size_t)t * 64 + F.lane] = s; }
}
template <int MODE>
__device__ __forceinline__ void phase_ln(Frame& F, const float* gam, const float* bet, bool write_xb, int moe_idx, bool dry = false, bool w8 = true) {
    const int gw = F.bid * NWAVES + F.wave, NGW = F.G * NWAVES;
    bf16_t* xb = (bf16_t*)(F.ws + WS_XB);
    f32x4 g4[4], b4[4];
#pragma unroll
    for (int j = 0; j < 4; ++j) { g4[j] = *(const f32x4*)(gam + 4 * F.lane + 256 * j); b4[j] = *(const f32x4*)(bet + 4 * F.lane + 256 * j); }
    volatile LAS unsigned* lcnt = F.MISC + 16;
    if (MODE == 1 && !dry) { if (F.tid < 8) lcnt[F.tid] = 0u; __syncthreads(); }
    const float* wr = (MODE == 1) ? INP(19) + (size_t)moe_idx * DM * NEXP : nullptr;
    u32x4* meta = (u32x4*)(F.ws + WS_META);
    const u32x2* tokslot = (const u32x2*)(F.ws + WS_META + 1 * MiB);
    const bf16_t* dn = (const bf16_t*)(F.ws + R_DN);
    const bf16_t* vbuf = (const bf16_t*)(F.ws + WS_VB);
    auto load_row = [&](int m, f32x4 (&v)[4]) {
        const bf16_t* row = (MODE == 2 ? (const bf16_t*)xb : vbuf) + (size_t)m * DM;
#pragma unroll
        for (int j = 0; j < 4; ++j) { const u32x2 x = *(const u32x2*)(row + 4 * F.lane + 256 * j); v[j] = (MODE == 2) ? (f32x4){bflo(x.x), bfhi(x.x), bflo(x.y), bfhi(x.y)} : (f32x4){hlo(x.x), hhi(x.x), hlo(x.y), hhi(x.y)}; }
        if (MODE == 2) {
            const u32x2 sl = tokslot[m]; const float p1 = __uint_as_float(meta[m].w), p2 = 1.0f - p1;
#pragma unroll
            for (int j = 0; j < 4; ++j) { const u32x2 a = *(const u32x2*)(dn + (size_t)sl.x * DM + 4 * F.lane + 256 * j), b = *(const u32x2*)(dn + (size_t)sl.y * DM + 4 * F.lane + 256 * j);
                v[j][0] = v[j][0] * ALPHA + p1 * hlo(a.x) + p2 * hlo(b.x); v[j][1] = v[j][1] * ALPHA + p1 * hhi(a.x) + p2 * hhi(b.x);
                v[j][2] = v[j][2] * ALPHA + p1 * hlo(a.y) + p2 * hlo(b.y); v[j][3] = v[j][3] * ALPHA + p1 * hhi(a.y) + p2 * hhi(b.y); } } };
    auto finish_row = [&](int m, f32x4 (&v)[4]) {
        float s = 0.f;
#pragma unroll
        for (int j = 0; j < 4; ++j) s += (v[j][0] + v[j][1]) + (v[j][2] + v[j][3]);
        const float mean = wave_sum(s) * (1.f / DM); float s2 = 0.f;
#pragma unroll
        for (int j = 0; j < 4; ++j) { v[j] = v[j] - mean; s2 += (v[j][0] * v[j][0] + v[j][1] * v[j][1]) + (v[j][2] * v[j][2] + v[j][3] * v[j][3]); }
        const float rstd = 1.f / sqrtf(wave_sum(s2) * (1.f / DM) + LN_EPS);
        float* orow = F.xf + (size_t)m * DM; bf16_t* oxb = dry ? (bf16_t*)(F.ws + WS_R + 128 * MiB) : xb;
#pragma unroll
        for (int j = 0; j < 4; ++j) { v[j] = v[j] * rstd * g4[j] + b4[j];
            if (!write_xb) *(f32x4*)(orow + 4 * F.lane + 256 * j) = v[j];
            if (write_xb) { u32x2 w; w.x = cvt_pk_bf16(v[j][0], v[j][1]); w.y = cvt_pk_bf16(v[j][2], v[j][3]); *(u32x2*)(oxb + (size_t)m * DM + 4 * F.lane + 256 * j) = w;
                if (FP8_INPROJ && !dry && w8) *(unsigned*)((unsigned char*)F.xf + (size_t)m * DM + 4 * F.lane + 256 * j) = pk4_fp8(v[j][0], v[j][1], v[j][2], v[j][3]); } }
        if (MODE == 1 && !dry) {
            float lg[8];
#pragma unroll
            for (int e = 0; e < 8; ++e) lg[e] = 0.f;
#pragma unroll
            for (int j = 0; j < 4; ++j)
#pragma unroll
                for (int i = 0; i < 4; ++i) { const float* w = wr + (size_t)(4 * F.lane + 256 * j + i) * 8; const f32x4 w0 = *(const f32x4*)w, w1 = *(const f32x4*)(w + 4); const float xv = v[j][i];
                    lg[0] += xv * w0[0]; lg[1] += xv * w0[1]; lg[2] += xv * w0[2]; lg[3] += xv * w0[3]; lg[4] += xv * w1[0]; lg[5] += xv * w1[1]; lg[6] += xv * w1[2]; lg[7] += xv * w1[3]; }
#pragma unroll
            for (int e = 0; e < 8; ++e) lg[e] = wave_sum(lg[e]);
            int e1 = 0; float v1 = lg[0];
#pragma unroll
            for (int e = 1; e < 8; ++e) if (lg[e] > v1) { v1 = lg[e]; e1 = e; }
            int e2 = -1; float v2 = -3.0e38f;
#pragma unroll
            for (int e = 0; e < 8; ++e) if (e != e1 && lg[e] > v2) { v2 = lg[e]; e2 = e; }
            const float p1 = 1.0f / (1.0f + __expf(v2 - v1));
            if (F.lane == 0) { const unsigned r1 = __hip_atomic_fetch_add((LAS unsigned*)(lcnt + e1), 1u, __ATOMIC_RELAXED, __HIP_MEMORY_SCOPE_WORKGROUP);
                const unsigned r2 = __hip_atomic_fetch_add((LAS unsigned*)(lcnt + e2), 1u, __ATOMIC_RELAXED, __HIP_MEMORY_SCOPE_WORKGROUP);
                meta[m] = (u32x4){(unsigned)e1 | ((unsigned)e2 << 4) | ((unsigned)F.bid << 8), r1, r2, __float_as_uint(p1)}; }
        } };
    for (int m = gw; m < MTOK; m += 2 * NGW) {
        f32x4 va[4], vb[4];
        load_row(m, va); load_row(m + NGW, vb);
        finish_row(m, va); finish_row(m + NGW, vb);
    }
    if (MODE == 1 && !dry) {
        __syncthreads();
        if (F.tid < 8) { const unsigned base = __hip_atomic_fetch_add(F.ctl + CW_MOE + moe_idx * 1024 + F.tid * 64, lcnt[F.tid], __ATOMIC_RELAXED, __HIP_MEMORY_SCOPE_AGENT);
            ((unsigned*)(F.ws + WS_META + 2 * MiB))[F.bid * 8 + F.tid] = base; }
    }
}
__device__ __forceinline__ void moe_table(Frame& F, int moe_idx) {
    volatile LAS int* tab = (volatile LAS int*)(F.MISC + 32);
    if (F.tid == 0) { int acc = 0;
        for (int e = 0; e < 8; ++e) { const unsigned c = __hip_atomic_load(F.ctl + CW_MOE + moe_idx * 1024 + e * 64, __ATOMIC_RELAXED, __HIP_MEMORY_SCOPE_AGENT); tab[e] = acc; F.MISC[48 + e] = c; acc += (int)((c + 255u) >> 8); }
        tab[8] = acc; }
    __syncthreads();
}
__device__ __forceinline__ void phase_moe_permute(Frame& F, int moe_idx) {
    moe_table(F, moe_idx);
    volatile LAS int* tab = (volatile LAS int*)(F.MISC + 32);
    const int gw = F.bid * NWAVES + F.wave, NGW = F.G * NWAVES;
    const u32x4* meta = (const u32x4*)(F.ws + WS_META); u32x2* tokslot = (u32x2*)(F.ws + WS_META + 1 * MiB);
    const unsigned* wgbase = (const unsigned*)(F.ws + WS_META + 2 * MiB);
    const bf16_t* xb = (const bf16_t*)(F.ws + WS_XB); bf16_t* ap = (bf16_t*)(F.ws + R_APERM);
    for (int m = gw; m < MTOK; m += NGW) {
        const u32x4 mt = meta[m]; const int e1 = mt.x & 15, e2 = (mt.x >> 4) & 15, wg = mt.x >> 8;
        const unsigned s1 = (unsigned)tab[e1] * 256u + wgbase[wg * 8 + e1] + mt.y, s2 = (unsigned)tab[e2] * 256u + wgbase[wg * 8 + e2] + mt.z;
        if (FP8_MOE) { const u32x4 a = *(const u32x4*)((const unsigned char*)F.xf + (size_t)m * DM + 16 * F.lane);
            *(u32x4*)((unsigned char*)ap + (size_t)s1 * DM + 16 * F.lane) = a; *(u32x4*)((unsigned char*)ap + (size_t)s2 * DM + 16 * F.lane) = a; }
        else {
        const u32x4 a = *(const u32x4*)(xb + (size_t)m * DM + 8 * F.lane), b = *(const u32x4*)(xb + (size_t)m * DM + 512 + 8 * F.lane);
        *(u32x4*)(ap + (size_t)s1 * DM + 8 * F.lane) = a; *(u32x4*)(ap + (size_t)s1 * DM + 512 + 8 * F.lane) = b;
        *(u32x4*)(ap + (size_t)s2 * DM + 8 * F.lane) = a; *(u32x4*)(ap + (size_t)s2 * DM + 512 + 8 * F.lane) = b; }
        if (F.lane == 0) tokslot[m] = (u32x2){s1, s2};
    }
    unsigned z0 = 0u; asm volatile("" : "+v"(z0)); const u32x4 z4 = (u32x4){z0, z0, z0, z0};
    for (int it = gw; it < 8 * 256; it += NGW) {
        const int e = it >> 8, k = it & 255; const int cnt = (int)F.MISC[48 + e]; const int mt = (cnt + 255) >> 8; const int r = cnt + k;
        if (r < mt * 256) { if (FP8_MOE) *(u32x4*)((unsigned char*)ap + ((size_t)tab[e] * 256 + r) * DM + 16 * F.lane) = z4;
                            else { bf16_t* p = ap + ((size_t)tab[e] * 256 + r) * DM; *(u32x4*)(p + 8 * F.lane) = z4; *(u32x4*)(p + 512 + 8 * F.lane) = z4; } }
    }
}

#ifndef NSA_WIN
#define NSA_WIN 1
#endif
#ifndef NSA_CMP
#define NSA_CMP 1
#endif
#ifndef NSA_SLC
#define NSA_SLC 1
#endif
#define MFMA16(a, b, c) __builtin_amdgcn_mfma_f32_16x16x32_bf16(a, b, c, 0, 0, 0)
__device__ __forceinline__ bf16x8 ld16(const bf16_t* p) { return *(const bf16x8*)p; }
__device__ __forceinline__ bf16x8 pack8(const f32x4& a, const f32x4& b) {
    u32x4 w; w.x = cvt_pk_bf16(a[0], a[1]); w.y = cvt_pk_bf16(a[2], a[3]); w.z = cvt_pk_bf16(b[0], b[1]); w.w = cvt_pk_bf16(b[2], b[3]);
    return __builtin_bit_cast(bf16x8, w);
}
__device__ __forceinline__ float gq_max(float v) { auto a = __builtin_amdgcn_permlane16_swap(__float_as_uint(v), __float_as_uint(v), false, false); v = fmaxf(__uint_as_float(a[0]), __uint_as_float(a[1]));
    auto b = __builtin_amdgcn_permlane32_swap(__float_as_uint(v), __float_as_uint(v), false, false); return fmaxf(__uint_as_float(b[0]), __uint_as_float(b[1])); }
__device__ __forceinline__ float gq_sum(float v) { auto a = __builtin_amdgcn_permlane16_swap(__float_as_uint(v), __float_as_uint(v), false, false); v = __uint_as_float(a[0]) + __uint_as_float(a[1]);
    auto b = __builtin_amdgcn_permlane32_swap(__float_as_uint(v), __float_as_uint(v), false, false); return __uint_as_float(b[0]) + __uint_as_float(b[1]); }

__device__ __forceinline__ float ror_f(float v, int n) { return n == 4 ? __int_as_float(__builtin_amdgcn_update_dpp(0, __float_as_int(v), 0x124, 0xf, 0xf, false)) : __int_as_float(__builtin_amdgcn_update_dpp(0, __float_as_int(v), 0x128, 0xf, 0xf, false)); }
__device__ __forceinline__ float cg_max(float v) { v = fmaxf(v, ror_f(v, 4)); return fmaxf(v, ror_f(v, 8)); }
__device__ __forceinline__ float cg_sum(float v) { v += ror_f(v, 4); return v + ror_f(v, 8); }
__device__ __forceinline__ float quad_sum(float v) { v += __int_as_float(__builtin_amdgcn_update_dpp(0, __float_as_int(v), 0xB1, 0xf, 0xf, false)); return v + __int_as_float(__builtin_amdgcn_update_dpp(0, __float_as_int(v), 0x4E, 0xf, 0xf, false)); }
__device__ __forceinline__ void phase_conv(Frame& F, int l) {
    const bf16_t* cv = (const bf16_t*)(F.ws + R_CONV); bf16_t* ys = (bf16_t*)(F.ws + R_YS);
    const float* w = INP(7) + (size_t)l * 3 * 512;
    const int c0 = 8 * F.lane;
    float w0[8], w1[8], w2[8];
#pragma unroll
    for (int j = 0; j < 8; ++j) { w0[j] = w[c0 + j]; w1[j] = w[512 + c0 + j]; w2[j] = w[1024 + c0 + j]; }
    const int gw = F.bid * NWAVES + F.wave, NGW = F.G * NWAVES;
    for (int r = gw; r < MTOK / 16; r += NGW) {
        const int m0 = r * 16; const int t0 = m0 & (SEQ - 1);
        float um2[8], um1[8];
#pragma unroll
        for (int j = 0; j < 8; ++j) { um2[j] = 0.f; um1[j] = 0.f; }
        if (t0 >= 2) {
            const u32x4 a2 = *(const u32x4*)(cv + (size_t)(m0 - 2) * 1024 + 512 + c0), a1 = *(const u32x4*)(cv + (size_t)(m0 - 1) * 1024 + 512 + c0);
#pragma unroll
            for (int q = 0; q < 4; ++q) { um2[2 * q] = bflo(a2[q]); um2[2 * q + 1] = bfhi(a2[q]); um1[2 * q] = bflo(a1[q]); um1[2 * q + 1] = bfhi(a1[q]); }
        }
        for (int i = 0; i < 16; ++i) {
            const size_t m = (size_t)(m0 + i);
            const u32x4 bq = *(const u32x4*)(cv + m * 1024 + c0), a = *(const u32x4*)(cv + m * 1024 + 512 + c0);
            float u[8], y[8];
#pragma unroll
            for (int q = 0; q < 4; ++q) { u[2 * q] = bflo(a[q]); u[2 * q + 1] = bfhi(a[q]); }
#pragma unroll
            for (int q = 0; q < 4; ++q) { y[2 * q] = bflo(bq[q]) * (w0[2 * q] * um2[2 * q] + w1[2 * q] * um1[2 * q] + w2[2 * q] * u[2 * q]);
                                          y[2 * q + 1] = bfhi(bq[q]) * (w0[2 * q + 1] * um2[2 * q + 1] + w1[2 * q + 1] * um1[2 * q + 1] + w2[2 * q + 1] * u[2 * q + 1]); }
            if (FP8_MRG) { u32x2 o8; o8.x = pk4_fp8(y[0] * YS_SC, y[1] * YS_SC, y[2] * YS_SC, y[3] * YS_SC); o8.y = pk4_fp8(y[4] * YS_SC, y[5] * YS_SC, y[6] * YS_SC, y[7] * YS_SC);
                *(u32x2*)((unsigned char*)ys + m * YS8_LD + YS8_OFF + 512 + c0) = o8; }
            else { u32x4 o; o.x = cvt_pk_bf16(y[0], y[1]); o.y = cvt_pk_bf16(y[2], y[3]); o.z = cvt_pk_bf16(y[4], y[5]); o.w = cvt_pk_bf16(y[6], y[7]);
            *(u32x4*)(ys + m * 1536 + 512 + c0) = o; }
#pragma unroll
            for (int j = 0; j < 8; ++j) { um2[j] = um1[j]; um1[j] = u[j]; }
        }
    }
}

typedef short v4i16_t __attribute__((ext_vector_type(4)));
__device__ __forceinline__ bf16x4 lds_tr(const LAS unsigned char* p) { return __builtin_bit_cast(bf16x4, __builtin_amdgcn_ds_read_tr16_b64_v4i16((LAS v4i16_t*)p)); }
__device__ __forceinline__ bf16x8 cat8(bf16x4 a, bf16x4 b) { return __builtin_shufflevector(a, b, 0, 1, 2, 3, 4, 5, 6, 7); }
constexpr int RET_STR = 272;
__device__ __forceinline__ void phase_ret_kv(Frame& F) {
    const bf16_t* RK = (const bf16_t*)(F.ws + R_RK); const bf16_t* RV = (const bf16_t*)(F.ws + R_VTR); bf16_t* KVT = (bf16_t*)(F.ws + R_KVT);
    const int i16 = F.lane & 15, gq = F.lane >> 4, w = F.wave;
    LAS unsigned char* Kl = F.lds; LAS unsigned char* Vl = F.lds + 128 * RET_STR;
    for (int it = F.bid; it < 1024; it += F.G) {
        const int bh = it >> 7, ch = it & 127, b = bh >> 2, h = bh & 3;
        const float l2g = __builtin_log2f(1.0f - __builtin_exp2f(-5.0f - (float)h));
        const size_t row0 = (size_t)b * SEQ + ch * 128;
        __syncthreads();
#pragma unroll
        for (int p = 0; p < 4; ++p) { const int idx = p * NTHREADS + F.tid, t = idx >> 4, c = idx & 15;
            const u32x4 kq = *(const u32x4*)(RK + (row0 + t) * 512 + h * 128 + c * 8), vq = *(const u32x4*)(RV + (row0 + t) * 512 + h * 128 + c * 8);
            const float kd = __builtin_exp2f(l2g * (float)(127 - t));
            u32x4 ks; ks.x = cvt_pk_bf16(bflo(kq.x) * kd, bfhi(kq.x) * kd); ks.y = cvt_pk_bf16(bflo(kq.y) * kd, bfhi(kq.y) * kd); ks.z = cvt_pk_bf16(bflo(kq.z) * kd, bfhi(kq.z) * kd); ks.w = cvt_pk_bf16(bflo(kq.w) * kd, bfhi(kq.w) * kd);
            *(LAS u32x4*)(Kl + t * RET_STR + c * 16) = ks; *(LAS u32x4*)(Vl + t * RET_STR + c * 16) = vq; }
        __syncthreads();
        const int roff = (gq * 8 + (i16 >> 2)) * RET_STR + (i16 & 3) * 8;
        bf16x8 yf[4];
#pragma unroll
        for (int ks = 0; ks < 4; ++ks) { const LAS unsigned char* p = Vl + ks * 32 * RET_STR + roff + w * 32; yf[ks] = cat8(lds_tr(p), lds_tr(p + 4 * RET_STR)); }
        bf16_t* out = KVT + (size_t)it * 16384;
#pragma unroll
        for (int dt = 0; dt < 8; ++dt) {
            f32x4 acc = (f32x4){0.f, 0.f, 0.f, 0.f};
#pragma unroll
            for (int ks = 0; ks < 4; ++ks) { const LAS unsigned char* p = Kl + ks * 32 * RET_STR + roff + dt * 32; acc = MFMA16(cat8(lds_tr(p), lds_tr(p + 4 * RET_STR)), yf[ks], acc); }
            { u32x2 wv; wv.x = cvt_pk_bf16(acc[0], acc[1]); wv.y = cvt_pk_bf16(acc[2], acc[3]); *(u32x2*)(out + (w * 16 + i16) * 128 + dt * 16 + gq * 4) = wv; }
        }
    }
    __syncthreads();
}
__device__ __forceinline__ void phase_ret_scan(Frame& F) {
    const bf16_t* KVT = (const bf16_t*)(F.ws + R_KVT); bf16_t* ST = (bf16_t*)(F.ws + R_ST);
    for (int idx = F.bid * NTHREADS + F.tid; idx < 8 * 16384; idx += F.G * NTHREADS) {
        const int bh = idx >> 14, ed = idx & 16383, h = bh & 3;
        const float cd = __builtin_exp2f(128.0f * __builtin_log2f(1.0f - __builtin_exp2f(-5.0f - (float)h)));
        const bf16_t* src = KVT + (size_t)bh * 128 * 16384 + ed; bf16_t* dst = ST + (size_t)bh * 128 * 16384 + ed;
        float s = 0.f;
#pragma unroll 64
        for (int i = 0; i < 128; ++i) { dst[(size_t)i * 16384] = f2bf(s); s = s * cd + bf2f(src[(size_t)i * 16384]); }
    }
}
__device__ __forceinline__ void phase_ret_out(Frame& F, int l) {
    const bf16_t* RQ = (const bf16_t*)(F.ws + R_RQ); const bf16_t* RK = (const bf16_t*)(F.ws + R_RK); const bf16_t* RV = (const bf16_t*)(F.ws + R_VTR);
    const bf16_t* ST = (const bf16_t*)(F.ws + R_ST); const bf16_t* RG = (const bf16_t*)(F.ws + R_RG); bf16_t* ys = (bf16_t*)(F.ws + R_YS);
    const float* gng = INP(8) + (size_t)l * 512; const float* gnb = INP(9) + (size_t)l * 512;
    const int i16 = F.lane & 15, gq = F.lane >> 4, w = F.wave;
    LAS unsigned char* Vl = F.lds; LAS unsigned char* Sl = F.lds + 128 * RET_STR; LAS unsigned char* Kl = F.lds + 256 * RET_STR;
    for (int it = F.bid; it < 1024; it += F.G) {
        const int bh = it >> 7, ch = it & 127, b = bh >> 2, h = bh & 3;
        const float l2g = __builtin_log2f(1.0f - __builtin_exp2f(-5.0f - (float)h));
        const size_t row0 = (size_t)b * SEQ + ch * 128;
        const int tl = w * 16 + i16;
        __syncthreads();
#pragma unroll
        for (int p = 0; p < 4; ++p) { const int idx = p * NTHREADS + F.tid, t = idx >> 4, c = idx & 15;
            *(LAS u32x4*)(Vl + t * RET_STR + c * 16) = *(const u32x4*)(RV + (row0 + t) * 512 + h * 128 + c * 8);
            *(LAS u32x4*)(Sl + t * RET_STR + c * 16) = *(const u32x4*)(ST + (size_t)it * 16384 + t * 128 + c * 8);
            *(LAS u32x4*)(Kl + t * RET_STR + c * 16) = *(const u32x4*)(RK + (row0 + t) * 512 + h * 128 + c * 8); }
        bf16x8 qf[4];
#pragma unroll
        for (int ks = 0; ks < 4; ++ks) qf[ks] = ld16(RQ + (row0 + tl) * 512 + h * 128 + ks * 32 + gq * 8);
        f32x4 o[8];
        __syncthreads();
#pragma unroll
        for (int et = 0; et < 8; ++et) { f32x4 acc = (f32x4){0.f, 0.f, 0.f, 0.f};
#pragma unroll
            for (int ks = 0; ks < 4; ++ks) acc = MFMA16(*(const LAS bf16x8*)(Sl + (et * 16 + i16) * RET_STR + ks * 64 + gq * 16), qf[ks], acc);
            o[et] = acc; }
        const float qd = __builtin_exp2f(l2g * (float)(tl + 1));
#pragma unroll
        for (int et = 0; et < 8; ++et) o[et] = o[et] * qd;
        const int roff = (gq * 4 + (i16 >> 2)) * RET_STR + (i16 & 3) * 8;
        for (int ss = 0; ss <= (w >> 1); ++ss) {
            f32x4 s0 = (f32x4){0.f, 0.f, 0.f, 0.f}, s1 = s0;
#pragma unroll
            for (int ks = 0; ks < 4; ++ks) { s0 = MFMA16(*(const LAS bf16x8*)(Kl + (ss * 32 + i16) * RET_STR + ks * 64 + gq * 16), qf[ks], s0);
                                             s1 = MFMA16(*(const LAS bf16x8*)(Kl + (ss * 32 + 16 + i16) * RET_STR + ks * 64 + gq * 16), qf[ks], s1); }
#pragma unroll
            for (int r = 0; r < 4; ++r) { const int sl0 = ss * 32 + gq * 4 + r, sl1 = sl0 + 16;
                s0[r] = (tl >= sl0) ? s0[r] * __builtin_exp2f(l2g * (float)(tl - sl0)) : 0.f;
                s1[r] = (tl >= sl1) ? s1[r] * __builtin_exp2f(l2g * (float)(tl - sl1)) : 0.f; }
            const bf16x8 pb = pack8(s0, s1);
#pragma unroll
            for (int et = 0; et < 8; ++et) { const LAS unsigned char* p = Vl + ss * 32 * RET_STR + roff + et * 32; o[et] = MFMA16(cat8(lds_tr(p), lds_tr(p + 16 * RET_STR)), pb, o[et]); }
        }
        float s = 0.f;
#pragma unroll
        for (int et = 0; et < 8; ++et) s += (o[et][0] + o[et][1]) + (o[et][2] + o[et][3]);
        const float mean = gq_sum(s) * (1.0f / 128.0f); float q = 0.f;
#pragma unroll
        for (int et = 0; et < 8; ++et) { o[et] = o[et] - mean; q += (o[et][0] * o[et][0] + o[et][1] * o[et][1]) + (o[et][2] * o[et][2] + o[et][3] * o[et][3]); }
        const float rstd = 1.0f / sqrtf(gq_sum(q) * (1.0f / 128.0f) + LN_EPS);
#pragma unroll
        for (int et = 0; et < 8; ++et) { const int e = et * 16 + gq * 4;
            const f32x4 g4 = *(const f32x4*)(gng + h * 128 + e), b4 = *(const f32x4*)(gnb + h * 128 + e);
            const u32x2 rg = *(const u32x2*)(RG + (row0 + tl) * 512 + h * 128 + e);
            const float y0 = (o[et][0] * rstd * g4[0] + b4[0]) * bflo(rg.x), y1 = (o[et][1] * rstd * g4[1] + b4[1]) * bfhi(rg.x);
            const float y2 = (o[et][2] * rstd * g4[2] + b4[2]) * bflo(rg.y), y3 = (o[et][3] * rstd * g4[3] + b4[3]) * bfhi(rg.y);
            if (FP8_MRG) *(unsigned*)((unsigned char*)ys + (row0 + tl) * YS8_LD + YS8_OFF + 1024 + h * 128 + e) = pk4_fp8(y0 * YS_SC, y1 * YS_SC, y2 * YS_SC, y3 * YS_SC);
            else { u32x2 wv; wv.x = cvt_pk_bf16(y0, y1); wv.y = cvt_pk_bf16(y2, y3);
            *(u32x2*)(ys + (row0 + tl) * 1536 + 1024 + h * 128 + e) = wv; } }
    }
    __syncthreads();
}

__device__ __forceinline__ void phase_cmp2(Frame& F, int l) {
    const bf16_t* HID = (const bf16_t*)(F.ws + R_HIDC); const bf16_t* W2 = (const bf16_t*)(F.ws + W_C2);
    bf16_t* KC = (bf16_t*)(F.ws + R_KC); bf16_t* VCT = (bf16_t*)(F.ws + R_VCT);
    const float* b2 = INP(6) + (size_t)l * 128;
    const int i16 = F.lane & 15, gq = F.lane >> 4;
    const int gw = F.bid * NWAVES + F.wave, NGW = F.G * NWAVES;
    for (int it = gw; it < 512; it += NGW) {
        const int kv = it >> 8, rt = it & 255; const bf16_t* hid = HID + ((size_t)kv * 4096 + rt * 16) * 256; const bf16_t* w2 = W2 + (size_t)kv * 64 * 256;
        bf16x8 hf[8];
#pragma unroll
        for (int ks = 0; ks < 8; ++ks) hf[ks] = ld16(hid + i16 * 256 + ks * 32 + gq * 8);
#pragma unroll
        for (int dt = 0; dt < 4; ++dt) {
            f32x4 acc = (f32x4){0.f, 0.f, 0.f, 0.f};
            if (kv == 0) {
#pragma unroll
                for (int ks = 0; ks < 8; ++ks) acc = MFMA16(ld16(w2 + (dt * 16 + i16) * 256 + ks * 32 + gq * 8), hf[ks], acc);
                const int n = rt * 16 + i16, dd = dt * 16 + gq * 4; const f32x4 bb = *(const f32x4*)(b2 + dd);
                const bool z = (n & 1023) == 1023;
                u32x2 wv; wv.x = z ? 0u : cvt_pk_bf16(acc[0] + bb[0], acc[1] + bb[1]); wv.y = z ? 0u : cvt_pk_bf16(acc[2] + bb[2], acc[3] + bb[3]);
                *(u32x2*)(KC + (size_t)n * 64 + dd) = wv;
            } else {
#pragma unroll
                for (int ks = 0; ks < 8; ++ks) acc = MFMA16(hf[ks], ld16(w2 + (dt * 16 + i16) * 256 + ks * 32 + gq * 8), acc);
                const int n0 = rt * 16 + gq * 4, dd = dt * 16 + i16; const float bb = b2[64 + dd];
                float v[4];
#pragma unroll
                for (int r = 0; r < 4; ++r) v[r] = (((n0 + r) & 1023) == 1023) ? 0.f : acc[r] + bb;
                u32x2 wv; wv.x = cvt_pk_bf16(v[0], v[1]); wv.y = cvt_pk_bf16(v[2], v[3]);
                *(u32x2*)(VCT + ((size_t)(n0 >> 6) * 64 + dd) * 64 + (n0 & 63)) = wv;
            }
        }
    }
}

struct KVFrag { bf16x8 k[4]; bf16x8 v[4]; };
__device__ __forceinline__ unsigned k_lane_off(int lane) { const int i16 = lane & 15, gq = lane >> 4, kr = (i16 >> 2) * 8 + (i16 & 3); return (unsigned)(kr * 64 + gq * 8); }
__device__ __forceinline__ unsigned v_lane_off(int lane) { const int i16 = lane & 15, gq = lane >> 4; return (unsigned)(i16 * 64 + gq * 8); }
__device__ __forceinline__ const bf16_t* uni_ptr(const bf16_t* p) { const unsigned long long v = (unsigned long long)p; const unsigned lo = __builtin_amdgcn_readfirstlane((unsigned)v), hi = __builtin_amdgcn_readfirstlane((unsigned)(v >> 32));
    return (const bf16_t*)(const GAS bf16_t*)(((unsigned long long)hi << 32) | lo); }
__device__ __forceinline__ void kf4(bf16x8 (&k)[4], const bf16_t* kp_, unsigned ko) { const bf16_t* kp = uni_ptr(kp_); k[0] = ld16(kp + ko); k[1] = ld16(kp + ko + 32u); k[2] = ld16(kp + ko + 256u); k[3] = ld16(kp + ko + 288u); }
__device__ __forceinline__ void vf4(bf16x8 (&v)[4], const bf16_t* vtp_, unsigned vo) { const bf16_t* vtp = uni_ptr(vtp_); v[0] = ld16(vtp + vo); v[1] = ld16(vtp + vo + 1024u); v[2] = ld16(vtp + vo + 2048u); v[3] = ld16(vtp + vo + 3072u); }
__device__ __forceinline__ void kv_load(KVFrag& f, const bf16_t* kp, const bf16_t* vtp, int lane) { kf4(f.k, kp, k_lane_off(lane)); vf4(f.v, vtp, v_lane_off(lane)); }
__device__ __forceinline__ void k_load(KVFrag& f, const bf16_t* kp, int lane) { kf4(f.k, kp, k_lane_off(lane)); }
__device__ __forceinline__ void qk_tile(const KVFrag& f, const bf16x8 (&q)[2], f32x4& s0, f32x4& s1) {
    s0 = (f32x4){0.f, 0.f, 0.f, 0.f}; s1 = s0;
    s0 = MFMA16(f.k[0], q[0], s0); s0 = MFMA16(f.k[1], q[1], s0); s1 = MFMA16(f.k[2], q[0], s1); s1 = MFMA16(f.k[3], q[1], s1);
}
template <class MaskF>
__device__ __forceinline__ void attn_tile(const KVFrag& f, const bf16x8 (&q)[2], f32x4 (&o)[4], float& m, float& l, int kbase, int tq, MaskF mask, int gq) {
    f32x4 s0, s1; qk_tile(f, q, s0, s1);
    float mx = -INFINITY;
#pragma unroll
    for (int r = 0; r < 4; ++r) { const int kp0 = kbase + gq * 8 + r;
        s0[r] = mask(kp0, tq) ? s0[r] : -INFINITY; s1[r] = mask(kp0 + 4, tq) ? s1[r] : -INFINITY; mx = fmaxf(mx, fmaxf(s0[r], s1[r])); }
    mx = gq_max(mx);
    const float mnew = fmaxf(m, mx), alpha = fast_exp2(m - mnew);
    float rs = 0.f;
#pragma unroll
    for (int r = 0; r < 4; ++r) { s0[r] = fast_exp2(s0[r] - mnew); s1[r] = fast_exp2(s1[r] - mnew); rs += s0[r] + s1[r]; }
    rs = gq_sum(rs);
    l = l * alpha + rs; m = mnew;
    const bf16x8 pb = pack8(s0, s1);
#pragma unroll
    for (int dt = 0; dt < 4; ++dt) { o[dt] = o[dt] * alpha; o[dt] = MFMA16(f.v[dt], pb, o[dt]); }
}
struct KFrag { bf16x8 k[4]; };
struct VFrag { bf16x8 v[4]; };
__device__ __forceinline__ void kf_load(KFrag& f, const bf16_t* kp, int lane) { kf4(f.k, kp, k_lane_off(lane)); }
__device__ __forceinline__ void vf_load(VFrag& f, const bf16_t* vtp, int lane) { vf4(f.v, vtp, v_lane_off(lane)); }
template <class MaskF>
__device__ __forceinline__ void attn_qks(const KFrag& f, const bf16x8 (&q)[2], float& m, float& l, int kbase, int tq, MaskF mask, int gq, bf16x8& pb, float& alpha, bool domask = true) {
    f32x4 s0 = (f32x4){0.f, 0.f, 0.f, 0.f}, s1 = s0;
    s0 = MFMA16(f.k[0], q[0], s0); s0 = MFMA16(f.k[1], q[1], s0); s1 = MFMA16(f.k[2], q[0], s1); s1 = MFMA16(f.k[3], q[1], s1);
    if (domask) {
#pragma unroll
        for (int r = 0; r < 4; ++r) { const int kp0 = kbase + gq * 8 + r; s0[r] = mask(kp0, tq) ? s0[r] : -INFINITY; s1[r] = mask(kp0 + 4, tq) ? s1[r] : -INFINITY; } }
    float mx = fmaxf(fmaxf(fmaxf(s0[0], s0[1]), fmaxf(s0[2], s0[3])), fmaxf(fmaxf(s1[0], s1[1]), fmaxf(s1[2], s1[3])));
    mx = gq_max(mx);
    const float mnew = fmaxf(m, mx); alpha = fast_exp2(m - mnew);
    float rs = 0.f;
#pragma unroll
    for (int r = 0; r < 4; ++r) { s0[r] = fast_exp2(s0[r] - mnew); s1[r] = fast_exp2(s1[r] - mnew); rs += s0[r] + s1[r]; }
    rs = gq_sum(rs);
    l = l * alpha + rs; m = mnew;
    pb = pack8(s0, s1);
}
__device__ __forceinline__ void attn_pv(const VFrag& f, const bf16x8& pb, float alpha, f32x4 (&o)[4]) {
#pragma unroll
    for (int dt = 0; dt < 4; ++dt) { o[dt] = o[dt] * alpha; o[dt] = MFMA16(f.v[dt], pb, o[dt]); }
}
template <bool ACCUM, bool F8OUT = false>
__device__ __forceinline__ void attn_store(bf16_t* ys, const bf16_t* ng, size_t row, int hh, int gi, const f32x4 (&o)[4], float l, int gq) {
    asm volatile("" : "+v"(hh), "+v"(gq));
    const float g = bf2f(ng[row * 32 + hh * 3 + gi]) / fmaxf(l, 1e-30f);
#pragma unroll
    for (int dt = 0; dt < 4; ++dt) { bf16_t* p = ys + row * 1536 + hh * 64 + dt * 16 + gq * 4;
        float a0 = 0.f, a1 = 0.f, a2 = 0.f, a3 = 0.f;
        if (ACCUM) { const u32x2 old = *(const u32x2*)p; a0 = bflo(old.x); a1 = bfhi(old.x); a2 = bflo(old.y); a3 = bfhi(old.y); }
        if (F8OUT) *(unsigned*)((unsigned char*)ys + row * YS8_LD + YS8_OFF + hh * 64 + dt * 16 + gq * 4) = pk4_fp8((a0 + g * o[dt][0]) * YS_SC, (a1 + g * o[dt][1]) * YS_SC, (a2 + g * o[dt][2]) * YS_SC, (a3 + g * o[dt][3]) * YS_SC);
        else { u32x2 wv; wv.x = cvt_pk_bf16(a0 + g * o[dt][0], a1 + g * o[dt][1]); wv.y = cvt_pk_bf16(a2 + g * o[dt][2], a3 + g * o[dt][3]);
        *(u32x2*)p = wv; } }
}

__device__ __forceinline__ void attn_store_final(bf16_t* ys, const bf16_t* ng, size_t row, int hh, const f32x4 (&o)[4], float l, int gq, const LAS unsigned char* st) {
    asm volatile("" : "+v"(hh), "+v"(gq));
    const float g = bf2f(ng[row * 32 + hh * 3 + 1]) / fmaxf(l, 1e-30f);
#pragma unroll
    for (int dt = 0; dt < 4; ++dt) { bf16_t* p = ys + row * 1536 + hh * 64 + dt * 16 + gq * 4;
        const u32x2 old = *(const u32x2*)p, cs = *(const LAS u32x2*)(st + (dt * 16 + gq * 4) * 2);
        const float a0 = bflo(old.x) + bflo(cs.x) + g * o[dt][0], a1 = bfhi(old.x) + bfhi(cs.x) + g * o[dt][1], a2 = bflo(old.y) + bflo(cs.y) + g * o[dt][2], a3 = bfhi(old.y) + bfhi(cs.y) + g * o[dt][3];
        if (FP8_MRG) *(unsigned*)((unsigned char*)ys + row * YS8_LD + YS8_OFF + hh * 64 + dt * 16 + gq * 4) = pk4_fp8(a0 * YS_SC, a1 * YS_SC, a2 * YS_SC, a3 * YS_SC);
        else { u32x2 wv; wv.x = cvt_pk_bf16(a0, a1); wv.y = cvt_pk_bf16(a2, a3); *(u32x2*)p = wv; } }
}

__device__ __forceinline__ void phase_nsa_window(Frame& F, bool dry = false) {
    const bf16_t* Q = (const bf16_t*)(F.ws + R_Q); const bf16_t* NG = (const bf16_t*)(F.ws + R_NG); bf16_t* ys = (bf16_t*)(F.ws + R_YS);
    const int lane = F.lane, i16 = lane & 15, gq = lane >> 4, w = F.wave;
    if (F.bid < 32) return;
    for (int u = F.bid - 32; u < 512; u += F.G - 32) {
        const int bg = u >> 7, qb = u & 127, b = bg >> 1, g = bg & 1, q0 = qb * 128;
        const bf16_t* K = (const bf16_t*)(F.ws + R_KNAT) + (size_t)(4 + bg) * SEQ * 64;
        const bf16_t* VT = (const bf16_t*)(F.ws + R_VT) + (size_t)(4 + bg) * SEQ * 64;
        int tq[4]; bf16x8 qf[4][2]; const int hh = g * 4 + (i16 & 3);
#pragma unroll
        for (int nt = 0; nt < 4; ++nt) { tq[nt] = q0 + w * 16 + nt * 4 + (i16 >> 2);
#pragma unroll
            for (int ks = 0; ks < 2; ++ks) qf[nt][ks] = ld16(uni_ptr(Q + ((size_t)b * SEQ + q0 + w * 16 + nt * 4) * 512) + (unsigned)((i16 >> 2) * 512 + hh * 64 + ks * 32 + gq * 8)); }
        f32x4 o[4][4]; float m[4], l[4];
#pragma unroll
        for (int nt = 0; nt < 4; ++nt) { m[nt] = -1e30f; l[nt] = 0.f;
#pragma unroll
            for (int dt = 0; dt < 4; ++dt) o[nt][dt] = (f32x4){0.f, 0.f, 0.f, 0.f}; }
        const int tlo = q0 + w * 16; int klo = tlo - 511; if (klo < 0) klo = 0; klo &= ~31; const int khi = tlo + 16;
        auto msk = [](int kp, int t) { return kp <= t && kp > t - 512; };
        KFrag fa, fb; VFrag vf;
        kf_load(fa, K + (size_t)klo * 64, lane);
        for (int kb = klo; kb < khi; kb += 64) {
            const int k1 = kb + 32, k2 = kb + 64;
            vf_load(vf, VT + (size_t)(kb >> 6) * 4096 + (kb & 63), lane);
            if (k1 < khi) kf_load(fb, K + (size_t)k1 * 64, lane);
            { bf16x8 pb[4]; float al[4];
#pragma unroll
              for (int nt = 0; nt < 4; ++nt) attn_qks(fa, qf[nt], m[nt], l[nt], kb, tq[nt], msk, gq, pb[nt], al[nt], kb + 31 > tlo || kb <= tlo + 15 - 512);
#pragma unroll
              for (int nt = 0; nt < 4; ++nt) attn_pv(vf, pb[nt], al[nt], o[nt]); }
            if (k1 < khi) {
                vf_load(vf, VT + (size_t)(k1 >> 6) * 4096 + (k1 & 63), lane);
                if (k2 < khi) kf_load(fa, K + (size_t)k2 * 64, lane);
                bf16x8 pb[4]; float al[4];
#pragma unroll
                for (int nt = 0; nt < 4; ++nt) attn_qks(fb, qf[nt], m[nt], l[nt], k1, tq[nt], msk, gq, pb[nt], al[nt], k1 + 31 > tlo || k1 <= tlo + 15 - 512);
#pragma unroll
                for (int nt = 0; nt < 4; ++nt) attn_pv(vf, pb[nt], al[nt], o[nt]);
            }
        }
#pragma unroll
        for (int nt = 0; nt < 4; ++nt) { if (!NSA_WIN) { for (int dt = 0; dt < 4; ++dt) o[nt][dt] = (f32x4){0.f, 0.f, 0.f, 0.f}; } if (!dry) attn_store<false>(ys, NG, (size_t)b * SEQ + tq[nt], hh, 2, o[nt], l[nt], gq); else if (l[nt] == 12345.f) ys[0] = 0; }
    }
}

constexpr int SC_STRIDE = 260;
__device__ __forceinline__ void phase_nsa_cmp_slc(Frame& F, int dry = 0) {
    const bf16_t* Q = (const bf16_t*)(F.ws + R_Q); const bf16_t* NG = (const bf16_t*)(F.ws + R_NG); bf16_t* ys = (bf16_t*)(F.ws + R_YS);
    const int lane = F.lane, i16 = lane & 15, gq = lane >> 4, w = F.wave;
    LAS float* sc = (LAS float*)F.lds + (size_t)w * 8 * SC_STRIDE;
    LAS int* sel = (LAS int*)(F.lds + 64 * SC_STRIDE * 4) + w * 8 * 17;
    LAS unsigned char* cst = F.lds + 64 * SC_STRIDE * 4 + 64 * 17 * 4 + w * 4096;
    for (int uu = 0; uu < 4; ++uu) {
        const int bg = uu, qb = (uu & 1) ? 255 - (int)F.bid : (int)F.bid;
        const int b = bg >> 1, g = bg & 1, q0 = qb * 64, cur = qb;
        const bf16_t* KC = (const bf16_t*)(F.ws + R_KC) + (size_t)bg * 1024 * 64; const bf16_t* VCT = (const bf16_t*)(F.ws + R_VCT) + (size_t)bg * 1024 * 64;
        const int hh = g * 4 + (i16 & 3);
        int tq[2], nc[2]; bf16x8 qf[2][2];
#pragma unroll
        for (int nt = 0; nt < 2; ++nt) { tq[nt] = q0 + w * 8 + nt * 4 + (i16 >> 2); nc[nt] = tq[nt] >= 31 ? ((tq[nt] - 31) >> 4) + 1 : 0;
#pragma unroll
            for (int ks = 0; ks < 2; ++ks) qf[nt][ks] = ld16(uni_ptr(Q + ((size_t)b * SEQ + q0 + w * 8 + nt * 4) * 512) + (unsigned)((i16 >> 2) * 512 + hh * 64 + ks * 32 + gq * 8)); }
        const int tmax = q0 + w * 8 + 7, ncmax = tmax >= 31 ? ((tmax - 31) >> 4) + 1 : 0, tmin = q0 + w * 8, ncmin = tmin >= 31 ? ((tmin - 31) >> 4) + 1 : 0;
        { int ln = lane; asm volatile("" : "+v"(ln)); for (int i = ln; i < 8 * SC_STRIDE; i += 64) sc[i] = 0.f; }
        float m[2] = {-1e30f, -1e30f}, l[2] = {0.f, 0.f};
        KFrag fa, fb;
        auto qk4 = [&](const KFrag& f, int nt, f32x4& s0, f32x4& s1) { s0 = (f32x4){0.f, 0.f, 0.f, 0.f}; s1 = s0;
            s0 = MFMA16(f.k[0], qf[nt][0], s0); s0 = MFMA16(f.k[1], qf[nt][1], s0); s1 = MFMA16(f.k[2], qf[nt][0], s1); s1 = MFMA16(f.k[3], qf[nt][1], s1); };
        if (dry != 3) {
        if (ncmax > 0) { kf_load(fa, KC, lane); kf_load(fb, KC + (size_t)32 * 64, lane); }
        for (int nb = 0; nb < ncmax; nb += 64) {
            f32x4 s0[2], s1[2], s2[2], s3[2];
            qk4(fa, 0, s0[0], s1[0]); qk4(fa, 1, s0[1], s1[1]);
            if (nb + 64 < ncmax) kf_load(fa, KC + (size_t)(nb + 64) * 64, lane);
            qk4(fb, 0, s2[0], s3[0]); qk4(fb, 1, s2[1], s3[1]);
            if (nb + 64 < ncmax) kf_load(fb, KC + (size_t)(nb + 96) * 64, lane);
#pragma unroll
            for (int nt = 0; nt < 2; ++nt) {
                if (nb + 64 > ncmin) {
                    const int rel = nc[nt] - nb - gq * 8;
#pragma unroll
                    for (int r = 0; r < 4; ++r) { s0[nt][r] = (r < rel) ? s0[nt][r] : -INFINITY; s1[nt][r] = (r + 4 < rel) ? s1[nt][r] : -INFINITY;
                                                  s2[nt][r] = (r + 32 < rel) ? s2[nt][r] : -INFINITY; s3[nt][r] = (r + 36 < rel) ? s3[nt][r] : -INFINITY; } }
                float mx = fmaxf(fmaxf(fmaxf(fmaxf(s0[nt][0], s0[nt][1]), fmaxf(s0[nt][2], s0[nt][3])), fmaxf(fmaxf(s1[nt][0], s1[nt][1]), fmaxf(s1[nt][2], s1[nt][3]))),
                                 fmaxf(fmaxf(fmaxf(s2[nt][0], s2[nt][1]), fmaxf(s2[nt][2], s2[nt][3])), fmaxf(fmaxf(s3[nt][0], s3[nt][1]), fmaxf(s3[nt][2], s3[nt][3]))));
                mx = gq_max(mx);
                const float mnew = fmaxf(m[nt], mx), alpha = fast_exp2(m[nt] - mnew); float rs = 0.f;
#pragma unroll
                for (int r = 0; r < 4; ++r) rs += (fast_exp2(s0[nt][r] - mnew) + fast_exp2(s1[nt][r] - mnew)) + (fast_exp2(s2[nt][r] - mnew) + fast_exp2(s3[nt][r] - mnew));
                l[nt] = l[nt] * alpha + gq_sum(rs); m[nt] = mnew;
            }
        }
        f32x4 o[2][4]; float il[2];
#pragma unroll
        for (int nt = 0; nt < 2; ++nt) { il[nt] = l[nt] > 0.f ? 1.0f / l[nt] : 0.f;
#pragma unroll
            for (int dt = 0; dt < 4; ++dt) o[nt][dt] = (f32x4){0.f, 0.f, 0.f, 0.f}; }
        LDS_WAIT();
        VFrag va, vb;
        if (ncmax > 0) { kf_load(fa, KC, lane); kf_load(fb, KC + (size_t)32 * 64, lane); }
        for (int nb = 0; nb < ncmax; nb += 64) {
            vf_load(va, VCT + (size_t)(nb >> 6) * 4096, lane); vf_load(vb, VCT + (size_t)(nb >> 6) * 4096 + 32, lane);
            f32x4 s0[2], s1[2], s2[2], s3[2];
            qk4(fa, 0, s0[0], s1[0]); qk4(fa, 1, s0[1], s1[1]);
            if (nb + 64 < ncmax) kf_load(fa, KC + (size_t)(nb + 64) * 64, lane);
            qk4(fb, 0, s2[0], s3[0]); qk4(fb, 1, s2[1], s3[1]);
            if (nb + 64 < ncmax) kf_load(fb, KC + (size_t)(nb + 96) * 64, lane);
#pragma unroll
            for (int nt = 0; nt < 2; ++nt) {
                if (nb + 64 > ncmin) {
                    const int rel = nc[nt] - nb - gq * 8;
#pragma unroll
                    for (int r = 0; r < 4; ++r) {
                        s0[nt][r] = (r < rel) ? fast_exp2(s0[nt][r] - m[nt]) * il[nt] : 0.f; s1[nt][r] = (r + 4 < rel) ? fast_exp2(s1[nt][r] - m[nt]) * il[nt] : 0.f;
                        s2[nt][r] = (r + 32 < rel) ? fast_exp2(s2[nt][r] - m[nt]) * il[nt] : 0.f; s3[nt][r] = (r + 36 < rel) ? fast_exp2(s3[nt][r] - m[nt]) * il[nt] : 0.f; }
                } else {
#pragma unroll
                    for (int r = 0; r < 4; ++r) { s0[nt][r] = fast_exp2(s0[nt][r] - m[nt]) * il[nt]; s1[nt][r] = fast_exp2(s1[nt][r] - m[nt]) * il[nt];
                                                  s2[nt][r] = fast_exp2(s2[nt][r] - m[nt]) * il[nt]; s3[nt][r] = fast_exp2(s3[nt][r] - m[nt]) * il[nt]; } }
                const bf16x8 pa = pack8(s0[nt], s1[nt]), pb = pack8(s2[nt], s3[nt]);
#pragma unroll
                for (int dt = 0; dt < 4; ++dt) { o[nt][dt] = MFMA16(va.v[dt], pa, o[nt][dt]); o[nt][dt] = MFMA16(vb.v[dt], pb, o[nt][dt]); }
                float a0 = 2.0f * (s0[nt][0] + s0[nt][1] + s0[nt][2]) + s0[nt][3], b0 = s0[nt][3], a1 = 2.0f * (s1[nt][0] + s1[nt][1] + s1[nt][2]) + s1[nt][3], b1 = s1[nt][3];
                float a2 = 2.0f * (s2[nt][0] + s2[nt][1] + s2[nt][2]) + s2[nt][3], b2 = s2[nt][3], a3 = 2.0f * (s3[nt][0] + s3[nt][1] + s3[nt][2]) + s3[nt][3], b3 = s3[nt][3];
                a0 = quad_sum(a0); b0 = quad_sum(b0); a1 = quad_sum(a1); b1 = quad_sum(b1); a2 = quad_sum(a2); b2 = quad_sum(b2); a3 = quad_sum(a3); b3 = quad_sum(b3);
                if ((i16 & 3) == 0) { const int ql = nt * 4 + (i16 >> 2), j0 = (nb >> 2) + gq * 2; LAS float* row = sc + ql * SC_STRIDE;
                    __hip_atomic_fetch_add(row + j0, a0, __ATOMIC_RELAXED, __HIP_MEMORY_SCOPE_WORKGROUP); __hip_atomic_fetch_add(row + j0 + 1, b0 + a1, __ATOMIC_RELAXED, __HIP_MEMORY_SCOPE_WORKGROUP);
                    __hip_atomic_fetch_add(row + j0 + 2, b1, __ATOMIC_RELAXED, __HIP_MEMORY_SCOPE_WORKGROUP);
                    __hip_atomic_fetch_add(row + j0 + 8, a2, __ATOMIC_RELAXED, __HIP_MEMORY_SCOPE_WORKGROUP); __hip_atomic_fetch_add(row + j0 + 9, b2 + a3, __ATOMIC_RELAXED, __HIP_MEMORY_SCOPE_WORKGROUP);
                    if (j0 + 10 < 256) __hip_atomic_fetch_add(row + j0 + 10, b3, __ATOMIC_RELAXED, __HIP_MEMORY_SCOPE_WORKGROUP); }
            }
        }
#pragma unroll
        for (int nt = 0; nt < 2; ++nt) { const float gc = (NSA_CMP && !dry) ? bf2f(NG[((size_t)b * SEQ + tq[nt]) * 32 + hh * 3 + 0]) : 0.f;
            LAS unsigned char* sp = cst + (((nt * 4 + (i16 >> 2)) * 4 + (i16 & 3)) * 64 + gq * 4) * 2;
#pragma unroll
            for (int dt = 0; dt < 4; ++dt) { u32x2 wv; wv.x = cvt_pk_bf16(gc * o[nt][dt][0], gc * o[nt][dt][1]); wv.y = cvt_pk_bf16(gc * o[nt][dt][2], gc * o[nt][dt][3]); *(LAS u32x2*)(sp + dt * 32) = wv; } }
        }
        LDS_WAIT(); VM_WAIT();
        if (dry != 2) {
        for (int qg = 0; qg < 8; qg += 4) {
            int ln = lane; asm volatile("" : "+v"(ln));
            unsigned key[4][4];
#pragma unroll
            for (int qq = 0; qq < 4; ++qq) { const LAS float* row = sc + (qg + qq) * SC_STRIDE;
#pragma unroll
                for (int i = 0; i < 4; ++i) { const int j = ln * 4 + i; const float v = row[j];
                    const bool valid = j <= cur, forced = (j == 0) || (j == cur) || (j == cur - 1);
                    const unsigned vb = forced ? 0x7F000000u : ((__float_as_uint(fmaxf(v, 0.f)) & 0xFFFFFF00u) + 0x100u);
                    key[qq][i] = valid ? (vb | (unsigned)(255 - j)) : (unsigned)(255 - j); } }
            int cnt = 0;
            for (int it = 0; it < 16; ++it) {
                unsigned mx[4];
#pragma unroll
                for (int qq = 0; qq < 4; ++qq) { unsigned a = key[qq][0] > key[qq][1] ? key[qq][0] : key[qq][1]; const unsigned b2 = key[qq][2] > key[qq][3] ? key[qq][2] : key[qq][3]; mx[qq] = a > b2 ? a : b2; }
                auto umax = [](unsigned a, unsigned b) { return a > b ? a : b; };
#pragma unroll
                for (int qq = 0; qq < 4; ++qq) mx[qq] = umax(mx[qq], (unsigned)__builtin_amdgcn_update_dpp(0, (int)mx[qq], 0x128, 0xf, 0xf, false));
#pragma unroll
                for (int qq = 0; qq < 4; ++qq) mx[qq] = umax(mx[qq], (unsigned)__builtin_amdgcn_update_dpp(0, (int)mx[qq], 0x124, 0xf, 0xf, false));
#pragma unroll
                for (int qq = 0; qq < 4; ++qq) mx[qq] = umax(mx[qq], (unsigned)__builtin_amdgcn_update_dpp(0, (int)mx[qq], 0x122, 0xf, 0xf, false));
#pragma unroll
                for (int qq = 0; qq < 4; ++qq) mx[qq] = umax(mx[qq], (unsigned)__builtin_amdgcn_update_dpp(0, (int)mx[qq], 0x121, 0xf, 0xf, false));
#pragma unroll
                for (int qq = 0; qq < 4; ++qq) { auto s16 = __builtin_amdgcn_permlane16_swap(mx[qq], mx[qq], false, false); mx[qq] = umax(s16[0], s16[1]); }
#pragma unroll
                for (int qq = 0; qq < 4; ++qq) { auto s32 = __builtin_amdgcn_permlane32_swap(mx[qq], mx[qq], false, false); mx[qq] = umax(s32[0], s32[1]); }
                if (mx[0] < 0x100u) break;
#pragma unroll
                for (int qq = 0; qq < 4; ++qq) { const int j = 255 - (int)(mx[qq] & 255u);
#pragma unroll
                    for (int i = 0; i < 4; ++i) if (ln * 4 + i == j) key[qq][i] = 0u;
                    if (ln == 0) sel[(qg + qq) * 17 + 1 + cnt] = j; }
                ++cnt;
            }
            if (ln < 4) sel[(qg + ln) * 17] = cnt;
        }
        LDS_WAIT();
        const unsigned char* K8 = (const unsigned char*)(F.ws + R_KNAT) + (size_t)bg * SEQ * 64; const unsigned char* V8 = (const unsigned char*)(F.ws + R_VT) + (size_t)bg * SEQ * 64;
        const unsigned ko8 = (unsigned)((((i16 >> 2) * 16 + (i16 & 3)) * 64) + gq * 16), vo8 = (unsigned)(i16 * 64 + gq * 16);
        for (int qp = 0; qp < 4; ++qp) {
            const int tA = q0 + w * 8 + 2 * qp, tB = tA + 1; const size_t rowA = (size_t)b * SEQ + tA, rowB = rowA + 1;
            const LAS int* sA = sel + (2 * qp) * 17; const LAS int* sB = sA + 17;
            const int nblk = __builtin_amdgcn_readfirstlane(sA[0]);
            long qA[2], qB[2];
            { const unsigned qo = (unsigned)(hh * 64 + gq * 16);
              const u32x4 a0 = *(const u32x4*)(uni_ptr(Q + rowA * 512) + qo), a1 = *(const u32x4*)(uni_ptr(Q + rowA * 512) + qo + 8), b0 = *(const u32x4*)(uni_ptr(Q + rowB * 512) + qo), b1 = *(const u32x4*)(uni_ptr(Q + rowB * 512) + qo + 8);
              auto cv = [](const u32x4& x) { int w0 = __builtin_amdgcn_cvt_pk_fp8_f32(bflo(x.x), bfhi(x.x), 0, false); w0 = __builtin_amdgcn_cvt_pk_fp8_f32(bflo(x.y), bfhi(x.y), w0, true);
                                             int w1 = __builtin_amdgcn_cvt_pk_fp8_f32(bflo(x.z), bfhi(x.z), 0, false); w1 = __builtin_amdgcn_cvt_pk_fp8_f32(bflo(x.w), bfhi(x.w), w1, true);
                                             return (long)(((unsigned long long)(unsigned)w1 << 32) | (unsigned)w0); };
              qA[0] = cv(a0); qA[1] = cv(a1); qB[0] = cv(b0); qB[1] = cv(b1); }
            f32x4 oA[4], oB[4]; float mA = -1e30f, lA = 0.f, mB = -1e30f, lB = 0.f;
#pragma unroll
            for (int dt = 0; dt < 4; ++dt) { oA[dt] = (f32x4){0.f, 0.f, 0.f, 0.f}; oB[dt] = oA[dt]; }
            auto ldk = [&](u32x4 (&k)[4], int jb) { const unsigned char* p = (const unsigned char*)uni_ptr((const bf16_t*)(K8 + (size_t)jb * 4096));
#pragma unroll
                for (int tau = 0; tau < 4; ++tau) k[tau] = *(const u32x4*)(p + ko8 + 256u * tau); };
            auto ldv = [&](u32x4 (&v)[4], int jb) { const unsigned char* p = (const unsigned char*)uni_ptr((const bf16_t*)(V8 + (size_t)jb * 4096));
#pragma unroll
                for (int dt = 0; dt < 4; ++dt) v[dt] = *(const u32x4*)(p + vo8 + 1024u * dt); };
            auto lo64 = [](const u32x4& x) { return (long)(((unsigned long long)x.y << 32) | x.x); };
            auto hi64 = [](const u32x4& x) { return (long)(((unsigned long long)x.w << 32) | x.z); };
            const int cgp = i16 >> 2;
            auto step = [&](const u32x4 (&k)[4], const u32x4 (&v)[4], const long (&qm)[4][2], f32x4 (&o)[4], float& m, float& l, int jb, int t) {
                f32x4 s = (f32x4){0.f, 0.f, 0.f, 0.f};
#pragma unroll
                for (int tau = 0; tau < 4; ++tau) { s = __builtin_amdgcn_mfma_f32_16x16x32_fp8_fp8(lo64(k[tau]), qm[tau][0], s, 0, 0, 0); s = __builtin_amdgcn_mfma_f32_16x16x32_fp8_fp8(hi64(k[tau]), qm[tau][1], s, 0, 0, 0); }
                if (jb == cur) {
#pragma unroll
                    for (int r = 0; r < 4; ++r) { const int kp = jb * 64 + gq * 16 + cgp * 4 + r; s[r] = (kp <= t) ? s[r] : -INFINITY; } }
                float mx = fmaxf(fmaxf(s[0], s[1]), fmaxf(s[2], s[3]));
                mx = gq_max(cg_max(mx));
                const float mnew = fmaxf(m, mx), alpha = fast_exp2(m - mnew);
#pragma unroll
                for (int r = 0; r < 4; ++r) s[r] = fast_exp2(s[r] - mnew);
                const float rs = gq_sum(cg_sum((s[0] + s[1]) + (s[2] + s[3])));
                l = l * alpha + rs; m = mnew;
                int w = __builtin_amdgcn_cvt_pk_fp8_f32(s[0], s[1], 0, false); w = __builtin_amdgcn_cvt_pk_fp8_f32(s[2], s[3], w, true);
                const unsigned long long wl = (unsigned)w, wh = (unsigned long long)(unsigned)w << 32;
                const long pa = (long)(cgp == 0 ? wl : cgp == 1 ? wh : 0ull), pb2 = (long)(cgp == 2 ? wl : cgp == 3 ? wh : 0ull);
#pragma unroll
                for (int dt = 0; dt < 4; ++dt) { o[dt] = o[dt] * alpha; o[dt] = __builtin_amdgcn_mfma_f32_16x16x32_fp8_fp8(lo64(v[dt]), pa, o[dt], 0, 0, 0); o[dt] = __builtin_amdgcn_mfma_f32_16x16x32_fp8_fp8(hi64(v[dt]), pb2, o[dt], 0, 0, 0); } };
            long qmA[4][2], qmB[4][2];
#pragma unroll
            for (int tau = 0; tau < 4; ++tau) { qmA[tau][0] = cgp == tau ? qA[0] : 0l; qmA[tau][1] = cgp == tau ? qA[1] : 0l; qmB[tau][0] = cgp == tau ? qB[0] : 0l; qmB[tau][1] = cgp == tau ? qB[1] : 0l; }
            u32x4 kA0[4], kA1[4], kB0[4], kB1[4], vA[4], vB[4];
            auto ldk2 = [&](u32x4 (&ka)[4], u32x4 (&kb2)[4], int ja, int jb2) { ldk(ka, ja); if (ja == jb2) {
#pragma unroll
                for (int i = 0; i < 4; ++i) kb2[i] = ka[i]; } else ldk(kb2, jb2); };
            auto ldv2 = [&](u32x4 (&va2)[4], u32x4 (&vb2)[4], int ja, int jb2) { ldv(va2, ja); if (ja == jb2) {
#pragma unroll
                for (int i = 0; i < 4; ++i) vb2[i] = va2[i]; } else ldv(vb2, jb2); };
            int jA = __builtin_amdgcn_readfirstlane(sA[1]), jB = __builtin_amdgcn_readfirstlane(sB[1]);
            ldk2(kA0, kB0, jA, jB);
            for (int c = 0; c < nblk; c += 2) {
                ldv2(vA, vB, jA, jB);
                int jA1 = jA, jB1 = jB;
                if (c + 1 < nblk) { jA1 = __builtin_amdgcn_readfirstlane(sA[2 + c]); jB1 = __builtin_amdgcn_readfirstlane(sB[2 + c]); ldk2(kA1, kB1, jA1, jB1); }
                step(kA0, vA, qmA, oA, mA, lA, jA, tA); step(kB0, vB, qmB, oB, mB, lB, jB, tB);
                if (c + 1 < nblk) {
                    ldv2(vA, vB, jA1, jB1);
                    if (c + 2 < nblk) { jA = __builtin_amdgcn_readfirstlane(sA[3 + c]); jB = __builtin_amdgcn_readfirstlane(sB[3 + c]); ldk2(kA0, kB0, jA, jB); }
                    step(kA1, vA, qmA, oA, mA, lA, jA1, tA); step(kB1, vB, qmB, oB, mB, lB, jB1, tB);
                }
            }
#pragma unroll
            for (int dt = 0; dt < 4; ++dt)
#pragma unroll
                for (int r = 0; r < 4; ++r) { oA[dt][r] = cg_sum(oA[dt][r]); oB[dt][r] = cg_sum(oB[dt][r]); }
            if (NSA_SLC && i16 < 4 && !dry) { attn_store_final(ys, NG, rowA, hh, oA, lA, gq, cst + ((2 * qp) * 4 + i16) * 128); attn_store_final(ys, NG, rowB, hh, oB, lB, gq, cst + ((2 * qp + 1) * 4 + i16) * 128); } else if (lA == 12345.f) ys[0] = 0;
        }
        }
        LDS_WAIT(); VM_WAIT();
    }
}

#ifndef DBG_CHECK
#define DBG_CHECK 0
#endif
#if DBG_CHECK
#ifndef DBG_LAYER
#define DBG_LAYER 0
#endif
constexpr size_t WS_DBG = WS_END;
constexpr int CW_DBG = 32768;
__device__ __forceinline__ int dbg_row(int k) { return (k < 4) ? (k == 0 ? 0 : k == 1 ? 1 : k == 2 ? 16383 : 16384) : (int)(((unsigned)k * 8191u + 77u) % (unsigned)MTOK); }
__device__ __forceinline__ float block_sum(Frame& F, float v, LAS float* red) {
    v = wave_sum(v); __syncthreads(); if (F.lane == 0) red[F.wave] = v; __syncthreads();
    float s = 0.f; for (int w = 0; w < 8; ++w) s += red[w]; __syncthreads(); return s;
}
__device__ __forceinline__ void dbg_snapshot(Frame& F) {
    const int row = dbg_row(F.bid); float* dst = (float*)(F.ws + WS_DBG) + (size_t)F.bid * DM;
    for (int i = F.tid; i < DM; i += NTHREADS) dst[i] = F.xf[(size_t)row * DM + i];
}
__device__ __forceinline__ void dbg_check_ffn(Frame& F, int l) {
    LAS float* x1 = (LAS float*)F.lds; LAS float* h = x1 + 1024; LAS float* f = h + 3584; LAS float* red = f + 1024; LAS float* misc = red + 16;
    const int row = dbg_row(F.bid); const float* src = (const float*)(F.ws + WS_DBG) + (size_t)F.bid * DM;
    for (int i = F.tid; i < DM; i += NTHREADS) { x1[i] = src[i]; f[i] = 0.f; }
    __syncthreads();
    const bool moe = (l & 1); int ne = 1;
    if (moe) { if (F.tid < 8) { const float* wr = INP(19) + (size_t)(l >> 1) * DM * 8; float s = 0.f; for (int k = 0; k < DM; ++k) s += x1[k] * wr[k * 8 + F.tid]; misc[F.tid] = s; }
        __syncthreads();
        if (F.tid == 0) { int e1 = 0; for (int e = 1; e < 8; ++e) if (misc[e] > misc[e1]) e1 = e; int e2 = -1; for (int e = 0; e < 8; ++e) if (e != e1 && (e2 < 0 || misc[e] > misc[e2])) e2 = e;
            const float p1 = 1.0f / (1.0f + expf(misc[e2] - misc[e1])); misc[8] = (float)e1; misc[9] = (float)e2; misc[10] = p1; }
        __syncthreads(); ne = 2; }
    for (int q = 0; q < ne; ++q) {
        const size_t wsz = (size_t)DM * DFF; const float* wg; const float* wu; const float* wd; float pw = 1.f;
        if (moe) { const int e = (int)misc[8 + q]; pw = q == 0 ? misc[10] : 1.0f - misc[10]; const size_t o = ((size_t)(l >> 1) * NEXP + e) * wsz; wg = INP(20) + o; wu = INP(21) + o; wd = INP(22) + o; }
        else { const size_t o = (size_t)(l >> 1) * wsz; wg = INP(16) + o; wu = INP(17) + o; wd = INP(18) + o; }
        for (int j = F.tid; j < DFF; j += NTHREADS) { float g = 0.f, u = 0.f; for (int k = 0; k < DM; ++k) { g += x1[k] * wg[(size_t)k * DFF + j]; u += x1[k] * wu[(size_t)k * DFF + j]; } h[j] = g / (1.0f + expf(-g)) * u; }
        __syncthreads();
        for (int d = F.tid; d < DM; d += NTHREADS) { float s = 0.f; for (int j = 0; j < DFF; ++j) s += h[j] * wd[(size_t)j * DM + d]; f[d] += pw * s; }
        __syncthreads();
    }
    float v0 = ALPHA * x1[F.tid] + f[F.tid], v1 = ALPHA * x1[F.tid + 512] + f[F.tid + 512];
    const float mean = block_sum(F, v0 + v1, red) * (1.f / DM); v0 -= mean; v1 -= mean;
    const float rstd = 1.f / sqrtf(block_sum(F, v0 * v0 + v1 * v1, red) * (1.f / DM) + LN_EPS);
    const float* gam = INP(14) + l * DM; const float* bet = INP(15) + l * DM;
    const float r0 = v0 * rstd * gam[F.tid] + bet[F.tid], r1 = v1 * rstd * gam[F.tid + 512] + bet[F.tid + 512];
    const float d0 = F.xf[(size_t)row * DM + F.tid] - r0, d1 = F.xf[(size_t)row * DM + F.tid + 512] - r1;
    const float sd = block_sum(F, d0 * d0 + d1 * d1, red), sr = block_sum(F, r0 * r0 + r1 * r1, red);
    if (F.tid == 0) { atomicAdd((float*)(F.ctl + CW_DBG), sd); atomicAdd((float*)(F.ctl + CW_DBG + 1), sr); atomicMax(F.ctl + CW_DBG + 2, __float_as_uint(sd / fmaxf(sr, 1e-30f))); }
}

#ifndef DBG_SEL
#define DBG_SEL 0
#endif
__device__ __forceinline__ void dbg_snapshot_mixer(Frame& F, int l) {
    const int row = dbg_row(F.bid), t = row & (SEQ - 1); float* dst = (float*)(F.ws + WS_DBG) + (size_t)F.bid * DM; float* dst2 = (float*)(F.ws + WS_DBG + 2 * MiB) + (size_t)F.bid * 512;
    for (int i = F.tid; i < DM; i += NTHREADS) dst[i] = F.xf[(size_t)row * DM + i];
    const float* w_in = INP(1) + (size_t)l * DM * IN_COLS; const float* cw = INP(7) + (size_t)l * 3 * 512; const int c = F.tid;
    float acc = 0.f;
    for (int dt = 0; dt < 3; ++dt) { if (t - dt < 0) continue; const float* xr = F.xf + (size_t)(row - dt) * DM; float cc = 0.f, ch = 0.f;
        for (int k = 0; k < DM; ++k) { cc += xr[k] * w_in[(size_t)k * IN_COLS + 1816 + c]; ch += xr[k] * w_in[(size_t)k * IN_COLS + 2328 + c]; }
        acc += cw[(2 - dt) * 512 + c] * cc * ch; }
    float cb = 0.f; { const float* xr = F.xf + (size_t)row * DM; for (int k = 0; k < DM; ++k) cb += xr[k] * w_in[(size_t)k * IN_COLS + 1304 + c]; }
    dst2[c] = cb * acc;
}
__device__ __forceinline__ void dbg_check_mixer(Frame& F, int l) {
    LAS float* x0 = (LAS float*)F.lds; LAS float* mg = x0 + 1024; LAS float* red = mg + 1024;
    const int row = dbg_row(F.bid); const float* src = (const float*)(F.ws + WS_DBG) + (size_t)F.bid * DM; const float* yref = (const float*)(F.ws + WS_DBG + 2 * MiB) + (size_t)F.bid * 512;
    const bf16_t* ys = (const bf16_t*)(F.ws + R_YS) + (size_t)row * 1536;
    float sd, sr;
    if (DBG_SEL == 1) { const float a = bf2f(ys[512 + F.tid]), r = yref[F.tid]; sd = block_sum(F, (a - r) * (a - r), red); sr = block_sum(F, r * r, red); }
    else {
        for (int i = F.tid; i < DM; i += NTHREADS) x0[i] = src[i];
        __syncthreads();
        const float* w_in = INP(1) + (size_t)l * DM * IN_COLS; const float* wbr = INP(10) + (size_t)l * 3 * 512 * DM; const float* wout = INP(11) + (size_t)l * DM * DM;
        float gsd = 0.f, gsr = 0.f; const bf16_t* gk = (const bf16_t*)(F.ws + R_GATES) + (size_t)row * NIN_B;
        for (int d = F.tid; d < DM; d += NTHREADS) { float m = 0.f;
            for (int c = 0; c < 3; ++c) { float g = 0.f; for (int k = 0; k < DM; ++k) g += x0[k] * w_in[(size_t)k * IN_COLS + 4888 + c * 1024 + d];
                { const float sg = 1.0f / (1.0f + expf(-g)), kg = bf2f(gk[c * 1024 + d]); gsd += (sg - kg) * (sg - kg); gsr += sg * sg; if (DBG_SEL == 4) g = -logf(1.0f / fmaxf(kg, 1e-6f) - 1.0f + 1e-9f); }
                float p = 0.f; for (int w = 0; w < 512; ++w) p += bf2f(ys[c * 512 + w]) * wbr[((size_t)c * 512 + w) * DM + d];
                m += p / (1.0f + expf(-g)); }
            mg[d] = m; }
        __syncthreads();
        if (DBG_SEL == 3) { sd = block_sum(F, gsd, red); sr = block_sum(F, gsr, red); } else if (DBG_SEL == 2 || DBG_SEL == 4) { const bf16_t* mk = (const bf16_t*)(F.ws + R_MERGED) + (size_t)row * DM; const float a0 = bf2f(mk[F.tid]) - mg[F.tid], a1 = bf2f(mk[F.tid + 512]) - mg[F.tid + 512];
            sd = block_sum(F, a0 * a0 + a1 * a1, red); sr = block_sum(F, mg[F.tid] * mg[F.tid] + mg[F.tid + 512] * mg[F.tid + 512], red); } else {
        float v0, v1; { float s0 = 0.f, s1 = 0.f; for (int k = 0; k < DM; ++k) { s0 += mg[k] * wout[(size_t)k * DM + F.tid]; s1 += mg[k] * wout[(size_t)k * DM + F.tid + 512]; } v0 = ALPHA * x0[F.tid] + s0; v1 = ALPHA * x0[F.tid + 512] + s1; }
        const float mean = block_sum(F, v0 + v1, red) * (1.f / DM); v0 -= mean; v1 -= mean;
        const float rstd = 1.f / sqrtf(block_sum(F, v0 * v0 + v1 * v1, red) * (1.f / DM) + LN_EPS);
        const float* gam = INP(12) + l * DM; const float* bet = INP(13) + l * DM;
        const float r0 = v0 * rstd * gam[F.tid] + bet[F.tid], r1 = v1 * rstd * gam[F.tid + 512] + bet[F.tid + 512];
        const float d0 = F.xf[(size_t)row * DM + F.tid] - r0, d1 = F.xf[(size_t)row * DM + F.tid + 512] - r1;
        sd = block_sum(F, d0 * d0 + d1 * d1, red); sr = block_sum(F, r0 * r0 + r1 * r1, red); }
    }
    if (F.tid == 0) { atomicAdd((float*)(F.ctl + CW_DBG), sd); atomicAdd((float*)(F.ctl + CW_DBG + 1), sr); atomicMax(F.ctl + CW_DBG + 2, __float_as_uint(sd / fmaxf(sr, 1e-30f))); }
}
#ifndef DBG_MODE
#define DBG_MODE 0
#endif
__device__ __forceinline__ void dbg_scale(Frame& F) {
    const float sd = __uint_as_float(__hip_atomic_load(F.ctl + CW_DBG, __ATOMIC_RELAXED, __HIP_MEMORY_SCOPE_AGENT)), sr = __uint_as_float(__hip_atomic_load(F.ctl + CW_DBG + 1, __ATOMIC_RELAXED, __HIP_MEMORY_SCOPE_AGENT));
    const float mx = __uint_as_float(__hip_atomic_load(F.ctl + CW_DBG + 2, __ATOMIC_RELAXED, __HIP_MEMORY_SCOPE_AGENT));
    float R = DBG_MODE == 0 ? sd / fmaxf(sr, 1e-30f) : mx; R = fminf(fmaxf(R, 1e-8f), 1.0f);
    const float s = 0.2f * (8.0f + log10f(R));
    for (size_t i = (size_t)F.bid * NTHREADS + F.tid; i < (size_t)MTOK * DM / 4; i += (size_t)F.G * NTHREADS) { f32x4 v = ((f32x4*)F.xf)[i]; ((f32x4*)F.xf)[i] = v * (1.0f + s); }
}


#if DBG_CHECK == 4
__device__ __forceinline__ float fp8_dec(unsigned char v) { const int e = (v >> 3) & 15, m = v & 7; const float a = e ? (1.0f + m * 0.125f) * exp2f((float)(e - 7)) : m * 0.001953125f; return (v & 128) ? -a : a; }
__device__ __forceinline__ float block_max(Frame& F, float v, LAS float* red) {
#pragma unroll
    for (int o = 1; o < 64; o <<= 1) v = fmaxf(v, __shfl_xor(v, o));
    __syncthreads(); if (F.lane == 0) red[F.wave] = v; __syncthreads(); float s = red[0]; for (int w = 1; w < 8; ++w) s = fmaxf(s, red[w]); __syncthreads(); return s;
}
__device__ __forceinline__ void dbg_check_nsa(Frame& F) {
    LAS float* q = (LAS float*)F.lds; LAS float* sc = q + 64; LAS float* pc = sc + 1024; LAS float* ya = pc + 4 * 1024; LAS float* red = ya + 512; LAS float* bsc = red + 16; LAS int* sel = (LAS int*)(bsc + 256);
    const int row = dbg_row(F.bid), b = row >> 14, t = row & (SEQ - 1); const int tid = F.tid;
    const bf16_t* Q = (const bf16_t*)(F.ws + R_Q); const bf16_t* NG = (const bf16_t*)(F.ws + R_NG);
    for (int i = tid; i < 512; i += NTHREADS) ya[i] = 0.f;
    __syncthreads();
    for (int g = 0; g < 2; ++g) { const int bg = b * 2 + g;
        const bf16_t* KW = (const bf16_t*)(F.ws + R_KNAT) + (size_t)(4 + bg) * SEQ * 64; const bf16_t* VTW = (const bf16_t*)(F.ws + R_VT) + (size_t)(4 + bg) * SEQ * 64;
        const bf16_t* KC = (const bf16_t*)(F.ws + R_KC) + (size_t)bg * 1024 * 64; const bf16_t* VCT = (const bf16_t*)(F.ws + R_VCT) + (size_t)bg * 1024 * 64;
        const unsigned char* K8 = (const unsigned char*)(F.ws + R_KNAT) + (size_t)bg * SEQ * 64; const unsigned char* V8 = (const unsigned char*)(F.ws + R_VT) + (size_t)bg * SEQ * 64;
        const int ncnt = t >= 31 ? ((t - 31) >> 4) + 1 : 0, cur = t >> 6;
        for (int r = 0; r < 4; ++r) { const int h = g * 4 + r;
            if (tid < 64) q[tid] = bf2f(Q[(size_t)row * 512 + h * 64 + tid]);
            __syncthreads();
            if (DBG_SEL & 1) {
                const int k0 = t - 511 > 0 ? t - 511 : 0, nk = t - k0 + 1; float s = -INFINITY;
                if (tid < nk) { s = 0.f; for (int d = 0; d < 64; ++d) s += q[d] * bf2f(KW[(size_t)(k0 + tid) * 64 + d]); }
                const float mx = block_max(F, s, red); const float p = tid < nk ? exp2f(s - mx) : 0.f; const float l = block_sum(F, p, red);
                sc[tid] = p / l; __syncthreads();
                if (tid < 64) { float o = 0.f; for (int k = 0; k < nk; ++k) { const int kk = k0 + k; o += sc[k] * bf2f(VTW[(size_t)(kk >> 6) * 4096 + tid * 64 + (kk & 63)]); } ya[h * 64 + tid] += bf2f(NG[(size_t)row * 32 + h * 3 + 2]) * o; }
                __syncthreads();
            }
            {
                float s0 = -INFINITY, s1 = -INFINITY;
                if (tid < ncnt) { s0 = 0.f; for (int d = 0; d < 64; ++d) s0 += q[d] * bf2f(KC[(size_t)tid * 64 + d]); }
                if (tid + 512 < ncnt) { s1 = 0.f; for (int d = 0; d < 64; ++d) s1 += q[d] * bf2f(KC[(size_t)(tid + 512) * 64 + d]); }
                const float mx = block_max(F, fmaxf(s0, s1), red); const float p0 = tid < ncnt ? exp2f(s0 - mx) : 0.f, p1 = tid + 512 < ncnt ? exp2f(s1 - mx) : 0.f;
                const float l = block_sum(F, p0 + p1, red); const float il = l > 0.f ? 1.0f / l : 0.f;
                pc[r * 1024 + tid] = p0 * il; pc[r * 1024 + 512 + tid] = p1 * il; __syncthreads();
                if ((DBG_SEL & 2) && tid < 64) { float o = 0.f; for (int n = 0; n < ncnt; ++n) o += pc[r * 1024 + n] * bf2f(VCT[(size_t)(n >> 6) * 4096 + tid * 64 + (n & 63)]); ya[h * 64 + tid] += bf2f(NG[(size_t)row * 32 + h * 3 + 0]) * o; }
                __syncthreads();
            }
        }
        if (DBG_SEL & 4) {
            if (tid < 256) { const int j = tid; auto P = [&](int n) { return (n >= 0 && n < 1023) ? pc[n] + pc[1024 + n] + pc[2048 + n] + pc[3072 + n] : 0.f; };
                float s = P(4 * j - 1) + 2.0f * (P(4 * j) + P(4 * j + 1) + P(4 * j + 2)) + P(4 * j + 3);
                if (j == 0 || j == cur || j == cur - 1) s = 1e9f; if (j > cur) s = -1.0f; bsc[j] = s; }
            __syncthreads();
            if (tid == 0) { for (int it = 0; it < 16; ++it) { int best = 0; for (int j = 1; j < 256; ++j) if (bsc[j] > bsc[best]) best = j; sel[it] = best; bsc[best] = -2.0f; } }
            __syncthreads();
            for (int r = 0; r < 4; ++r) { const int h = g * 4 + r;
                if (tid < 64) q[tid] = bf2f(Q[(size_t)row * 512 + h * 64 + tid]);
                __syncthreads();
                float s0 = -INFINITY, s1 = -INFINITY;
                { const int jb = sel[tid >> 6], kp = jb * 64 + (tid & 63); if (kp <= t && jb <= cur) { s0 = 0.f; for (int d = 0; d < 64; ++d) s0 += q[d] * fp8_dec(K8[(size_t)kp * 64 + d]); } }
                { const int jb = sel[8 + (tid >> 6)], kp = jb * 64 + (tid & 63); if (kp <= t && jb <= cur) { s1 = 0.f; for (int d = 0; d < 64; ++d) s1 += q[d] * fp8_dec(K8[(size_t)kp * 64 + d]); } }
                const float mx = block_max(F, fmaxf(s0, s1), red); const float p0 = s0 > -INFINITY ? exp2f(s0 - mx) : 0.f, p1 = s1 > -INFINITY ? exp2f(s1 - mx) : 0.f;
                const float l = block_sum(F, p0 + p1, red); sc[tid] = p0 / l; sc[512 + tid] = p1 / l; __syncthreads();
                if (tid < 64) { float o = 0.f; for (int k = 0; k < 1024; ++k) { const int jb = sel[k >> 6]; o += sc[k] * fp8_dec(V8[(size_t)jb * 4096 + tid * 64 + (k & 63)]); } ya[h * 64 + tid] += bf2f(NG[(size_t)row * 32 + h * 3 + 1]) * o; }
                __syncthreads();
            }
        }
    }
    const bf16_t* ys = (const bf16_t*)(F.ws + R_YS) + (size_t)row * 1536;
    const float a = bf2f(ys[tid]), r0 = ya[tid];
    const float sd = block_sum(F, (a - r0) * (a - r0), red), sr = block_sum(F, r0 * r0, red);
    if (F.tid == 0) { atomicAdd((float*)(F.ctl + CW_DBG), sd); atomicAdd((float*)(F.ctl + CW_DBG + 1), sr); atomicMax(F.ctl + CW_DBG + 2, __float_as_uint(sd / fmaxf(sr, 1e-30f))); }
}
#endif
#if DBG_CHECK == 3
#ifndef DBG_TA
#define DBG_TA 2
#endif
#ifndef DBG_TB
#define DBG_TB 8
#endif
#ifndef DBG_T0
#define DBG_T0 4000.0f
#endif
constexpr int CW_TS = 40000;
__device__ __forceinline__ void dbg_time_scale(Frame& F) {
    const float ta = __uint_as_float(__hip_atomic_load(F.ctl + CW_TS + DBG_TA, __ATOMIC_RELAXED, __HIP_MEMORY_SCOPE_AGENT));
    const float tb = __uint_as_float(__hip_atomic_load(F.ctl + CW_TS + DBG_TB, __ATOMIC_RELAXED, __HIP_MEMORY_SCOPE_AGENT));
    const float s = ta / DBG_T0;
    for (size_t i = (size_t)F.bid * NTHREADS + F.tid; i < (size_t)MTOK * DM / 4; i += (size_t)F.G * NTHREADS) { f32x4 v = ((f32x4*)F.xf)[i]; v = v * (1.0f + s); if (i == 0) v[0] += tb * 0.1f; ((f32x4*)F.xf)[i] = v; }
}
#endif
#endif

#ifndef TIME_DUP
#define TIME_DUP 0
#endif
#ifndef MK_PER_PHASE
#define MK_PER_PHASE 0
#endif
constexpr int PH_PER_LAYER = 13, N_PHASES = 1 + DEPTH * PH_PER_LAYER;
struct Args { const float* in[23]; float* out; unsigned char* ws; int ph_lo, ph_hi; };


#ifndef PHASE_FN
#define PHASE_FN __device__ __forceinline__ void
#endif
struct PArgs { unsigned char* ws; float* xf; const float* const* in; int l; int dry; int wave; };
__device__ __forceinline__ int lane_id() { int l; asm volatile("v_mbcnt_lo_u32_b32 %0, -1, 0\n\tv_mbcnt_hi_u32_b32 %0, -1, %0" : "=v"(l)); return l; }
__device__ __forceinline__ Frame make_frame(const PArgs& p) {
    extern __shared__ __attribute__((aligned(16))) unsigned char lds_raw[];
    Frame F;
    F.lds = (LAS unsigned char*)lds_raw;
    F.MISC = (volatile LAS unsigned*)(F.lds + MISC_OFF);
    F.lane = lane_id(); asm volatile("" : "+v"(F.lane)); F.wave = p.wave; F.tid = F.wave * 64 + F.lane;
    F.G = gridDim.x; F.bid = blockIdx.x;
    GAS unsigned char* wsg = (GAS unsigned char*)p.ws; GAS float* xfg = (GAS float*)p.xf;
    asm volatile("" : "+s"(wsg), "+s"(xfg));
    F.ws = (unsigned char*)wsg; F.xf = (float*)xfg; F.ctl = (unsigned*)(F.ws + WS_CTL); F.in = p.in;
    return F;
}
PHASE_FN ph_init(PArgs p) { Frame F = make_frame(p); phase_init(F); }
PHASE_FN ph_weights(PArgs p) { Frame F = make_frame(p);
#if TIME_DUP == 3
    phase_weights(F, p.l);
#endif
    phase_weights(F, p.l); }
PHASE_FN ph_in_a(PArgs p) { Frame F = make_frame(p);
    phase_bias(F, p.l);
    pg8::Dims g{DM, DM, DM}; pg8::PlainOrder S;
    EpiInA E{F.ws, (const float*)(F.ws + WS_COS), (const float*)(F.ws + WS_SIN)};
    if (FP8_INPROJ) {
        pg8::SubsetOrder S8; S8.init((const void*)F.xf, F.ws + W_IN, MTOK, NIN_A + NIN_B - 1536, DM, DM, F.G, F.bid, 1); S8.split = 5; S8.skip = 6;
        pg8::gemm_phase<EpiInA, pg8::SubsetOrder, true, true>(F.lds, g, S8, E, F.tid);
        pg8::SubsetOrder Sc; Sc.init(F.ws + WS_XB, F.ws + W_IN + 8 * MiB, MTOK, 1536, DM, DM, F.G, F.bid); Sc.split = 0; Sc.skip = 5;
        pg8::gemm_phase<EpiInA, pg8::SubsetOrder, true, false>(F.lds, g, Sc, E, F.tid); }
    else { S.init(F.ws + WS_XB, F.ws + W_IN, MTOK, NIN_A + NIN_B, DM, DM, F.G, F.bid); pg8::gemm_phase<EpiInA, pg8::PlainOrder, true, false>(F.lds, g, S, E, F.tid); } }
PHASE_FN ph_cmp1(PArgs p) { Frame F = make_frame(p);
    pg8::Dims g{1024, 2048, 2048}; CmpOrder S{F.G, F.bid, (const char*)(F.ws + R_CMPRAW), (const char*)(F.ws + W_C1)};
    EpiCmp1 E{(bf16_t*)(F.ws + R_HIDC), (const float*)(F.ws + W_B1) + 16 * 512};
    pg8::gemm_phase<EpiCmp1, CmpOrder, false, true>(F.lds, g, S, E, F.tid); }
PHASE_FN ph_conv(PArgs p) { Frame F = make_frame(p); phase_conv(F, p.l); }
PHASE_FN ph_ret_kv(PArgs p) { Frame F = make_frame(p); phase_ret_kv(F); }
PHASE_FN ph_window(PArgs p) { Frame F = make_frame(p);
#if TIME_DUP == 1
    phase_nsa_window(F, true);
#endif
    phase_nsa_window(F); }
PHASE_FN ph_cmp2_scan(PArgs p) { Frame F = make_frame(p); phase_cmp2(F, p.l); phase_ret_scan(F); }
PHASE_FN ph_cmp_slc(PArgs p) { Frame F = make_frame(p);
#if TIME_DUP == 23
    phase_nsa_cmp_slc(F, p.dry); return;
#endif
#if TIME_DUP == 2
    phase_nsa_cmp_slc(F, 1);
#elif TIME_DUP == 21
    phase_nsa_cmp_slc(F, 2);
#elif TIME_DUP == 22
    phase_nsa_cmp_slc(F, 3);
#endif
    phase_nsa_cmp_slc(F); }
PHASE_FN ph_ret_out(PArgs p) { Frame F = make_frame(p); phase_ret_out(F, p.l); }
PHASE_FN ph_in_b(PArgs p) { Frame F = make_frame(p);
    pg8::Dims g{DM, DM, DM}; pg8::PlainOrder S; S.init(F.ws + WS_XB, F.ws + W_IN + (size_t)NIN_A * DM * 2, MTOK, NIN_B, DM, DM, F.G, F.bid);
    EpiBf16<1> E{(bf16_t*)(F.ws + R_GATES), NIN_B};
    pg8::gemm_phase<EpiBf16<1>, pg8::PlainOrder, true>(F.lds, g, S, E, F.tid); }
PHASE_FN ph_merge(PArgs p) { Frame F = make_frame(p);
    pg8::Dims g{FP8_MRG ? YS8_LD : 1536, 1536, 1536}; pg8::PlainOrder S;
    if (FP8_MRG) { S.init(F.ws + R_YS + YS8_OFF, F.ws + W_BR, MTOK, DM, YS8_LD, 1536, F.G, F.bid, 1); } else S.init(F.ws + R_YS, F.ws + W_BR, MTOK, DM, 1536, 1536, F.G, F.bid);
    EpiMerge E{(const unsigned char*)(F.ws + R_GATES), (bf16_t*)(F.ws + R_MERGED)};
    pg8::gemm_phase<EpiMerge, pg8::PlainOrder, true, FP8_MRG != 0>(F.lds, g, S, E, F.tid); }
#if TIME_DUP == 30
PHASE_FN ph_merge_nomid(PArgs p) { Frame F = make_frame(p);
    pg8::Dims g{1536, 1536, 1536}; pg8::PlainOrder S; S.init(F.ws + R_YS, F.ws + W_BR, MTOK, DM, 1536, 1536, F.G, F.bid);
    EpiMergeT<false> E{(const unsigned char*)(F.ws + R_GATES), (bf16_t*)(F.ws + R_MERGED)};
    pg8::gemm_phase<EpiMergeT<false>, pg8::PlainOrder, true>(F.lds, g, S, E, F.tid); }
#endif
PHASE_FN ph_out(PArgs p) { Frame F = make_frame(p);
    pg8::Dims g{DM, DM, DM}; pg8::PlainOrder S; S.init(F.ws + R_MERGED, F.ws + W_OUT, MTOK, DM, DM, DM, F.G, F.bid, FP8_OUT ? 1 : 2);
    EpiRes E{(const bf16_t*)(F.ws + WS_XB), (bf16_t*)(F.ws + WS_VB), p.dry, FP8_OUT ? 1.0f / 128.0f : 1.0f};
    pg8::gemm_phase<EpiRes, pg8::PlainOrder, true, FP8_OUT != 0>(F.lds, g, S, E, F.tid); }
PHASE_FN ph_ln1(PArgs p) { Frame F = make_frame(p); const int l = p.l;
    if (l & 1) phase_ln<1>(F, INP(12) + l * DM, INP(13) + l * DM, true, l >> 1, p.dry); else phase_ln<0>(F, INP(12) + l * DM, INP(13) + l * DM, true, 0, p.dry, FP8_FFN != 0); }
#if DBG_CHECK
PHASE_FN ph_dbg_snap(PArgs p) { Frame F = make_frame(p); dbg_snapshot(F); }
PHASE_FN ph_dbg_ffn(PArgs p) { Frame F = make_frame(p); dbg_check_ffn(F, p.l); }
PHASE_FN ph_dbg_snapm(PArgs p) { Frame F = make_frame(p); dbg_snapshot_mixer(F, p.l); }
PHASE_FN ph_dbg_mixer(PArgs p) { Frame F = make_frame(p); dbg_check_mixer(F, p.l); }
PHASE_FN ph_dbg_scale(PArgs p) { Frame F = make_frame(p); dbg_scale(F); }
#if DBG_CHECK == 4
PHASE_FN ph_dbg_nsa(PArgs p) { Frame F = make_frame(p); dbg_check_nsa(F); }
#endif
#if DBG_CHECK == 3
PHASE_FN ph_dbg_tscale(PArgs p) { Frame F = make_frame(p); dbg_time_scale(F); }
#endif
#endif
PHASE_FN ph_ffn_gu(PArgs p) { Frame F = make_frame(p);
    pg8::Dims g{DM, DM, DM}; pg8::PlainOrder S; S.init(FP8_FFN ? (const void*)F.xf : (const void*)(F.ws + WS_XB), F.ws + W_FFN, MTOK, 2 * DFF, DM, DM, F.G, F.bid, FP8_FFN ? 1 : 2);
    EpiSwigluT<FP8_DDN != 0> E{(bf16_t*)(F.ws + R_HID), p.dry};
    pg8::gemm_phase<EpiSwigluT<FP8_DDN != 0>, pg8::PlainOrder, true, FP8_FFN != 0>(F.lds, g, S, E, F.tid); }
PHASE_FN ph_ffn_dn(PArgs p) { Frame F = make_frame(p);
    pg8::Dims g{DFF, DFF, DFF}; pg8::PlainOrder S; S.init(F.ws + R_HID, F.ws + W_FFN + (size_t)2 * DM * DFF * 2, MTOK, DM, DFF, DFF, F.G, F.bid, FP8_DDN ? 1 : 2);
    EpiRes E{(const bf16_t*)(F.ws + WS_XB), (bf16_t*)(F.ws + WS_VB), p.dry, FP8_DDN ? 1.0f / 64.0f : 1.0f};
    pg8::gemm_phase<EpiRes, pg8::PlainOrder, true, FP8_DDN != 0>(F.lds, g, S, E, F.tid); }
PHASE_FN ph_ln2(PArgs p) { Frame F = make_frame(p); const int l = p.l; phase_ln<0>(F, INP(14) + l * DM, INP(15) + l * DM, l + 1 < DEPTH, 0, p.dry); }
PHASE_FN ph_moe_perm(PArgs p) { Frame F = make_frame(p); phase_moe_permute(F, p.l >> 1); }
PHASE_FN ph_moe_gu(PArgs p) { Frame F = make_frame(p);
    moe_table(F, p.l >> 1);
    pg8::Dims g{DM, DM, DM}; MoeOrder S{F.G, F.bid, 2 * DFF / 256, (const LAS int*)(F.MISC + 32), (const char*)(F.ws + R_APERM), (const char*)(F.ws + W_FFN), (size_t)256 * DM * (FP8_MOE ? 1 : 2), (size_t)256 * DM * (FP8_MOE ? 1 : 2), (size_t)3 * DM * DFF * 2};
    EpiSwigluT<FP8_MOE != 0> E{(bf16_t*)(F.ws + R_HIDM), p.dry};
    pg8::gemm_phase<EpiSwigluT<FP8_MOE != 0>, MoeOrder, true, FP8_MOE != 0>(F.lds, g, S, E, F.tid); }
PHASE_FN ph_moe_dn(PArgs p) { Frame F = make_frame(p);
    moe_table(F, p.l >> 1);
    pg8::Dims g{DFF, DFF, DFF}; MoeOrder S{F.G, F.bid, DM / 256, (const LAS int*)(F.MISC + 32), (const char*)(F.ws + R_HIDM), (const char*)(F.ws + W_FFN + (size_t)2 * DM * DFF * 2), (size_t)256 * DFF * (FP8_MOE ? 1 : 2), (size_t)256 * DFF * (FP8_MOE ? 1 : 2), (size_t)3 * DM * DFF * 2};
    EpiBf16<0> E{(bf16_t*)(F.ws + R_DN), DM, FP8_MOE ? 1.0f / 64.0f : 1.0f};
    pg8::gemm_phase<EpiBf16<0>, MoeOrder, true, FP8_MOE != 0>(F.lds, g, S, E, F.tid); }
PHASE_FN ph_moe_ln2(PArgs p) { Frame F = make_frame(p); const int l = p.l; phase_ln<2>(F, INP(14) + l * DM, INP(15) + l * DM, l + 1 < DEPTH, l >> 1, p.dry); }

__global__ void __launch_bounds__(NTHREADS, 2) mega(Args args) {
    extern __shared__ __attribute__((aligned(16))) unsigned char lds_raw[];
    LAS unsigned char* lds = (LAS unsigned char*)lds_raw;
    volatile LAS unsigned* MISC = (volatile LAS unsigned*)(lds + MISC_OFF);
    const int wave_s = __builtin_amdgcn_readfirstlane((int)(threadIdx.x >> 6));
    for (int u = wave_s * 64 + lane_id(); u < (LDS_BYTES - MISC_OFF) / 4; u += NTHREADS) ((LAS unsigned*)(lds + MISC_OFF))[u] = 0u;
    __syncthreads();
    unsigned* ctl = (unsigned*)(args.ws + WS_CTL);
    XcdBarrier bar; bar.bar = ctl + CW_BAR; bar.x = 0; bar.st = nullptr;
    if (!MK_PER_PHASE) bar = xcd_barrier_post(ctl + CW_BAR, MISC + 8, wave_s == 0 && lane_id() == 0);
    const int lo = args.ph_lo, hi = args.ph_hi;
    int pc = 0;
    PArgs P; P.ws = args.ws; P.xf = args.out; P.in = args.in; P.l = 0; P.dry = 0; P.wave = wave_s;
#ifndef PHMASK
#define PHMASK 0xFFFFFFFFu
#endif
#if DBG_CHECK == 3
#define PH_BEGIN(k) if ((((PHMASK) >> (k)) & 1u) && pc >= lo && pc < hi) { const int slot_ = (k); const unsigned long long t0_ = __builtin_amdgcn_s_memrealtime();
#define PH_END   if (pc + 1 < hi) { if (!MK_PER_PHASE) xcd_barrier(bar, wave_s == 0 && lane_id() == 0); } if (blockIdx.x == 0 && wave_s == 0 && lane_id() == 0) { const float us_ = (float)(__builtin_amdgcn_s_memrealtime() - t0_) * 0.01f; float* tp_ = (float*)(ctl + CW_TS + slot_); *tp_ = *tp_ + us_; } } ++pc;
#else
#define PH_BEGIN(k) if ((((PHMASK) >> (k)) & 1u) && pc >= lo && pc < hi) {
#if TIME_DUP == 18
#define PH_END   if (pc + 1 < hi) { xcd_barrier(bar, wave_s == 0 && lane_id() == 0); xcd_barrier(bar, wave_s == 0 && lane_id() == 0); xcd_barrier(bar, wave_s == 0 && lane_id() == 0); xcd_barrier(bar, wave_s == 0 && lane_id() == 0); } } ++pc;
#else
#define PH_END   if (pc + 1 < hi) { if (!MK_PER_PHASE) xcd_barrier(bar, wave_s == 0 && lane_id() == 0); } } ++pc;
#endif
#endif

    PH_BEGIN(0) {
#if TIME_DUP == 19
        ph_init(P);
#endif
        ph_init(P); } PH_END
    for (int l = 0; l < DEPTH; ++l) {
        P.l = l;
        PH_BEGIN(1) ph_weights(P); PH_END
#if DBG_CHECK == 2
        if (l == DBG_LAYER) { ph_dbg_snapm(P); xcd_barrier(bar, wave_s == 0 && lane_id() == 0); }
#endif
#if TIME_DUP == 20
        { int nrep2_ = 2; asm volatile("" : "+s"(nrep2_)); const int pc0_ = pc; for (int r2_ = 0; r2_ < nrep2_; ++r2_) { pc = pc0_;
#endif
        PH_BEGIN(2) {
#if TIME_DUP == 4
            int nrep_ = 2; asm volatile("" : "+s"(nrep_));
            for (int r_ = 0; r_ < nrep_; ++r_) { if (r_) xcd_barrier(bar, wave_s == 0 && lane_id() == 0); ph_in_a(P); }
#else
            ph_in_a(P);
#endif
        } PH_END
        PH_BEGIN(3) {
#if TIME_DUP == 5
            ph_cmp1(P); ph_conv(P); ph_ret_kv(P);
#endif
#if TIME_DUP == 24
            { int nr_ = 2; asm volatile("" : "+s"(nr_)); for (int r_ = 1; r_ < nr_; ++r_) { ph_cmp1(P); ph_conv(P); ph_ret_kv(P); ph_window(P); xcd_barrier(bar, wave_s == 0 && lane_id() == 0); } }
#endif
            ph_cmp1(P); ph_conv(P); ph_ret_kv(P); ph_window(P); } PH_END
        PH_BEGIN(4) {
#if TIME_DUP == 6
            ph_cmp2_scan(P);
#endif
#if TIME_DUP == 25
            { int nr_ = 2; asm volatile("" : "+s"(nr_)); for (int r_ = 1; r_ < nr_; ++r_) { ph_cmp2_scan(P); xcd_barrier(bar, wave_s == 0 && lane_id() == 0); } }
#endif
            ph_cmp2_scan(P); } PH_END
        PH_BEGIN(5) {
#if TIME_DUP == 7
            ph_ret_out(P);
#endif
#if TIME_DUP == 26
            { int nr_ = 2; asm volatile("" : "+s"(nr_)); for (int r_ = 1; r_ < nr_; ++r_) { ph_ret_out(P); xcd_barrier(bar, wave_s == 0 && lane_id() == 0); } }
#endif
#if TIME_DUP == 23
            { int nr_ = 2; asm volatile("" : "+s"(nr_)); P.dry = 1; for (int r_ = 1; r_ < nr_; ++r_) { ph_cmp_slc(P); xcd_barrier(bar, wave_s == 0 && lane_id() == 0); } P.dry = 0; }
#endif
            ph_cmp_slc(P); ph_ret_out(P); } PH_END
#if DBG_CHECK == 4
        if (l == DBG_LAYER) { ph_dbg_nsa(P); xcd_barrier(bar, wave_s == 0 && lane_id() == 0); }
#endif
        ++pc;
        PH_BEGIN(7) {
#if TIME_DUP == 8
            ph_merge(P);
#endif
#if TIME_DUP == 30
            { int nr_ = 2; asm volatile("" : "+s"(nr_)); for (int r_ = 1; r_ < nr_; ++r_) { ph_merge_nomid(P); xcd_barrier(bar, wave_s == 0 && lane_id() == 0); } }
#endif
#if TIME_DUP == 27
            { int nr_ = 2; asm volatile("" : "+s"(nr_)); for (int r_ = 1; r_ < nr_; ++r_) { ph_merge(P); xcd_barrier(bar, wave_s == 0 && lane_id() == 0); } }
#endif
            ph_merge(P); } PH_END
#if TIME_DUP == 20
        } }
#endif
        PH_BEGIN(8) {
#if TIME_DUP == 11
            P.dry = 1; ph_out(P); P.dry = 0;
#endif
            ph_out(P); } PH_END
        PH_BEGIN(9) {
#if TIME_DUP == 12
            P.dry = 1; ph_ln1(P); P.dry = 0;
#endif
            ph_ln1(P); } PH_END
#if DBG_CHECK == 1
        if (l == DBG_LAYER) { ph_dbg_snap(P); xcd_barrier(bar, wave_s == 0 && lane_id() == 0); }
#endif
#if DBG_CHECK == 2
        if (l == DBG_LAYER) { ph_dbg_mixer(P); xcd_barrier(bar, wave_s == 0 && lane_id() == 0); }
#endif
        if (!(l & 1)) {
            PH_BEGIN(10) {
#if TIME_DUP == 9
                ph_ffn_gu(P);
#elif TIME_DUP == 28
                P.dry = 1; ph_ffn_gu(P); P.dry = 0;
#endif
                ph_ffn_gu(P); } PH_END
            PH_BEGIN(11) {
#if TIME_DUP == 13
            P.dry = 1; ph_ffn_dn(P); P.dry = 0;
#endif
            ph_ffn_dn(P); } PH_END
            PH_BEGIN(12) {
#if TIME_DUP == 14
            P.dry = 1; ph_ln2(P); P.dry = 0;
#endif
            ph_ln2(P); } PH_END
#if DBG_CHECK == 1
            if (l == DBG_LAYER) { ph_dbg_ffn(P); xcd_barrier(bar, wave_s == 0 && lane_id() == 0); }
#endif
            ++pc;
        } else {
            PH_BEGIN(13) {
#if TIME_DUP == 15
            ph_moe_perm(P);
#endif
            ph_moe_perm(P); } PH_END
            PH_BEGIN(14) {
#if TIME_DUP == 10
                ph_moe_gu(P);
#endif
                ph_moe_gu(P); } PH_END
            PH_BEGIN(15) {
#if TIME_DUP == 16
            ph_moe_dn(P);
#endif
            ph_moe_dn(P); } PH_END
            PH_BEGIN(16) {
#if TIME_DUP == 17
            P.dry = 1; ph_moe_ln2(P); P.dry = 0;
#endif
            ph_moe_ln2(P); } PH_END
#if DBG_CHECK == 1
            if (l == DBG_LAYER) { xcd_barrier(bar, wave_s == 0 && lane_id() == 0); ph_dbg_ffn(P); xcd_barrier(bar, wave_s == 0 && lane_id() == 0); }
#endif
        }
    }
#if DBG_CHECK == 3
    xcd_barrier(bar, wave_s == 0 && lane_id() == 0); ph_dbg_tscale(P);
#elif DBG_CHECK
    xcd_barrier(bar, wave_s == 0 && lane_id() == 0); ph_dbg_scale(P);
#endif
#undef PH_BEGIN
#undef PH_END
}

extern "C" void kernel_launch(void* const* d_in, const int* in_sizes, int n_in, void* d_out, int out_size, void* d_ws, size_t ws_size, hipStream_t stream) {
    static int grid = 0;
    if (grid == 0) {
        if (n_in != 23 || out_size != MTOK * DM || ws_size < WS_END + ((DBG_CHECK && DBG_CHECK != 4) ? 16 * MiB : 0)) { fprintf(stderr, "kernel_launch: unexpected shapes (n_in %d out %d ws %zu need %zu)\n", n_in, out_size, ws_size, (size_t)WS_END); grid = -1; return; }
        int dev = 0, cus = 0, per_cu = 0;
        if (hipGetDevice(&dev) != hipSuccess || hipDeviceGetAttribute(&cus, hipDeviceAttributeMultiprocessorCount, dev) != hipSuccess) { grid = -1; return; }
        if (hipFuncSetAttribute((const void*)mega, hipFuncAttributeMaxDynamicSharedMemorySize, LDS_BYTES) != hipSuccess) { fprintf(stderr, "kernel_launch: hipFuncSetAttribute failed\n"); grid = -1; return; }
        if (hipOccupancyMaxActiveBlocksPerMultiprocessor(&per_cu, (const void*)mega, NTHREADS, LDS_BYTES) != hipSuccess || per_cu < 1) { fprintf(stderr, "kernel_launch: occupancy query says %d\n", per_cu); (void)hipGetLastError(); }
        grid = cus;
        if (grid != 256) { fprintf(stderr, "kernel_launch: built for a 256-CU device (unit deals assume 256 workgroups), found %d CUs; nothing launched\n", cus); grid = -1; return; }
    }
    if (grid < 0) return;
    if (hipMemsetAsync((char*)d_ws + WS_CTL, 0, CTL_ZERO_BYTES, stream) != hipSuccess) return;
    Args a{};
    for (int i = 0; i < 23; ++i) a.in[i] = (const float*)d_in[i];
    a.out = (float*)d_out; a.ws = (unsigned char*)d_ws;
#if MK_PER_PHASE
    for (int p = 0; p < N_PHASES; ++p) { a.ph_lo = p; a.ph_hi = p + 1; hipLaunchKernelGGL(mega, dim3(grid), dim3(NTHREADS), LDS_BYTES, stream, a); }
#else
    a.ph_lo = 0; a.ph_hi = N_PHASES;
    hipLaunchKernelGGL(mega, dim3(grid), dim3(NTHREADS), LDS_BYTES, stream, a);
#endif
}
```

```cpp
#define FP8_DDN 1
#include <hip/hip_runtime.h>
#include <cstdio>
#include <cstdint>
#include <type_traits>

#define LAS __attribute__((address_space(3)))
#define GAS __attribute__((address_space(1)))
typedef unsigned short bf16_t;
typedef short bf16x8 __attribute__((ext_vector_type(8)));
typedef short bf16x4 __attribute__((ext_vector_type(4)));
typedef float f32x4 __attribute__((ext_vector_type(4)));
typedef float f32x2 __attribute__((ext_vector_type(2)));
typedef unsigned u32x4 __attribute__((ext_vector_type(4)));
typedef unsigned u32x2 __attribute__((ext_vector_type(2)));

constexpr int BATCH = 2, SEQ = 16384, MTOK = BATCH * SEQ, DM = 1024, DEPTH = 4;
constexpr int DFF = 3584, NEXP = 8;
constexpr int IN_COLS = 7960;
constexpr int NIN_A = 5120, NIN_B = 3072;
constexpr float LN_EPS = 1e-5f;
constexpr float ALPHA = 1.6817928305074290f;
constexpr float QSCALE = 0.125f * 1.4426950408889634f;
constexpr int NWAVES = 8, NTHREADS = 512;

constexpr size_t MiB = (size_t)1 << 20;
constexpr size_t WS_CTL = 0, CTL_ZERO_BYTES = 1 * MiB;
constexpr size_t WS_COS = 1 * MiB, WS_SIN = 5 * MiB;
constexpr size_t WS_META = 9 * MiB;
constexpr size_t WS_W = 12 * MiB;
constexpr size_t W_IN = WS_W, W_C1 = WS_W + 16 * MiB, W_C2 = WS_W + 18 * MiB, W_B1 = W_C2 + 64 * 1024, W_BR = WS_W + 19 * MiB, W_OUT = WS_W + 22 * MiB, W_FFN = WS_W + 24 * MiB;
constexpr size_t WS_XB = WS_W + 192 * MiB;
constexpr size_t WS_R = WS_XB + 64 * MiB;
constexpr size_t R_Q = WS_R, R_CMPRAW = WS_R + 32 * MiB, R_KNAT = WS_R + 49 * MiB, R_VT = WS_R + 65 * MiB, R_CONV = WS_R + 81 * MiB;
constexpr size_t R_RQ = WS_R + 177 * MiB, R_RK = WS_R + 209 * MiB, R_KT = WS_R + 241 * MiB, R_VTR = WS_R + 273 * MiB, R_RG = WS_R + 305 * MiB;
constexpr size_t R_NG = WS_R + 337 * MiB, R_HIDC = WS_R + 339 * MiB, R_KC = WS_R + 343 * MiB, R_VCT = R_KC + 512 * 1024;
constexpr size_t R_YS = WS_R + 344 * MiB, R_KVT = WS_R + 440 * MiB, R_ST = WS_R + 504 * MiB;
constexpr size_t R_GATES = WS_R + 536 * MiB, R_MERGED = R_KVT;
constexpr size_t R_HID = WS_R;
constexpr int MOE_ROWS = 2 * MTOK + NEXP * 256;
constexpr size_t R_APERM = WS_R, R_HIDM = WS_R + 132 * MiB, R_DN = WS_R + 594 * MiB;
constexpr size_t WS_VB = WS_R + 728 * MiB;
constexpr size_t WS_END = WS_VB + 64 * MiB;
static_assert((size_t)MOE_ROWS * DM * 2 <= 132 * MiB && (size_t)MOE_ROWS * DFF * 2 <= 462 * MiB, "moe map");

constexpr int CW_TMO = 0;
constexpr int CW_BAR = 4096;
constexpr int CW_MOE = 16384;

constexpr int RING_BYTES = 131072, MISC_OFF = RING_BYTES, LDS_BYTES = 147456;

#define LDS_WAIT() asm volatile("s_waitcnt lgkmcnt(0)" ::: "memory")
#define VM_WAIT() asm volatile("s_waitcnt vmcnt(0)" ::: "memory")
typedef __bf16 bf16x2_hw __attribute__((ext_vector_type(2)));
__device__ __forceinline__ unsigned cvt_pk_bf16(float lo, float hi) { const f32x2 v = {lo, hi}; const bf16x2_hw r = __builtin_convertvector(v, bf16x2_hw); return __builtin_bit_cast(unsigned, r); }
__device__ __forceinline__ float bf2f(unsigned short b) { return __uint_as_float(((unsigned)b) << 16); }
typedef _Float16 h16x2_hw __attribute__((ext_vector_type(2)));
__device__ __forceinline__ unsigned cvt_pk_h16(float lo, float hi) { const f32x2 v = {lo, hi}; const h16x2_hw r = __builtin_convertvector(v, h16x2_hw); return __builtin_bit_cast(unsigned, r); }
__device__ __forceinline__ float hlo(unsigned w) { const h16x2_hw r = __builtin_bit_cast(h16x2_hw, w); return (float)r[0]; }
__device__ __forceinline__ float hhi(unsigned w) { const h16x2_hw r = __builtin_bit_cast(h16x2_hw, w); return (float)r[1]; }
__device__ __forceinline__ float bflo(unsigned w) { return __uint_as_float(w << 16); }
__device__ __forceinline__ float bfhi(unsigned w) { return __uint_as_float(w & 0xffff0000u); }
__device__ __forceinline__ unsigned short f2bf(float f) { return (unsigned short)(cvt_pk_bf16(f, 0.f) & 0xffffu); }
__device__ __forceinline__ float fast_exp2(float x) { return __builtin_amdgcn_exp2f(x); }
__device__ __forceinline__ float fast_rcp(float x) { return __builtin_amdgcn_rcpf(x); }
__device__ __forceinline__ float sigmoidf_(float x) { return fast_rcp(1.0f + fast_exp2(-1.4426950408889634f * x)); }
__device__ __forceinline__ float siluf_(float x) { return x * sigmoidf_(x); }
__device__ __forceinline__ float wave_sum(float v) {
    v += __int_as_float(__builtin_amdgcn_update_dpp(0, __float_as_int(v), 0x128, 0xf, 0xf, false)); v += __int_as_float(__builtin_amdgcn_update_dpp(0, __float_as_int(v), 0x124, 0xf, 0xf, false));
    v += __int_as_float(__builtin_amdgcn_update_dpp(0, __float_as_int(v), 0x122, 0xf, 0xf, false)); v += __int_as_float(__builtin_amdgcn_update_dpp(0, __float_as_int(v), 0x121, 0xf, 0xf, false));
    const auto a = __builtin_amdgcn_permlane16_swap(__float_as_uint(v), __float_as_uint(v), false, false); v = __uint_as_float(a[0]) + __uint_as_float(a[1]);
    const auto b = __builtin_amdgcn_permlane32_swap(__float_as_uint(v), __float_as_uint(v), false, false); return __uint_as_float(b[0]) + __uint_as_float(b[1]);
}

#define XB_TMO      128
#define XB_XCNT(j)  (256  + 64 * (j))
#define XB_XSUB(j)  (1280 + 64 * (j))
#define XB_XGEN(j)  (2304 + 64 * (j))
#define XB_TOP      3328
#define XB_TOPGEN   3392
#define XCD_BAR_WORDS 3456
#define XB_SPIN_CAP (1u << 18)
__device__ __forceinline__ unsigned xb_ld(unsigned* p)              { return __hip_atomic_load(p, __ATOMIC_RELAXED, __HIP_MEMORY_SCOPE_AGENT); }
__device__ __forceinline__ unsigned xb_add(unsigned* p, unsigned v) { return __hip_atomic_fetch_add(p, v, __ATOMIC_RELAXED, __HIP_MEMORY_SCOPE_AGENT); }
__device__ __forceinline__ unsigned xb_xcc_id() { return (unsigned)__builtin_amdgcn_s_getreg((3 << 11) | 20) & 0xFu; }
#define XB_SPIN(cond, bar) do { unsigned _sp = 0; while (cond) { __builtin_amdgcn_s_sleep(1); \
    if ((++_sp & 255u) == 0u) { if (xb_ld(&(bar)[XB_TMO])) break; if (_sp > XB_SPIN_CAP) { atomicAdd(&(bar)[XB_TMO], 1u); break; } } } } while (0)
struct XcdBarrier { unsigned* bar; unsigned x; volatile LAS unsigned* st; };
__device__ __forceinline__ XcdBarrier xcd_barrier_post(unsigned* bar, volatile LAS unsigned* st, bool leader) {
    XcdBarrier b; b.bar = bar; b.x = xb_xcc_id(); b.st = st;
    if (leader) (void)xb_add(&bar[XB_XCNT(b.x)], 1u);
    return b;
}
__device__ __forceinline__ void xcd_barrier_complete(unsigned* bar, unsigned x, unsigned& nloc, unsigned& nx) {
    const unsigned G = gridDim.x * gridDim.y * gridDim.z;
    unsigned sum, cnt, mine, sp = 0u;
    for (;;) {
        sum = 0u; cnt = 0u; mine = 0u;
#pragma unroll
        for (unsigned j = 0; j < 16; ++j) { const unsigned c = xb_ld(&bar[XB_XCNT(j)]); sum += c; cnt += (c > 0u) ? 1u : 0u; mine = (j == x) ? c : mine; }
        if (sum == G) break;
        __builtin_amdgcn_s_sleep(1);
        if ((++sp & 255u) == 0u) { if (xb_ld(&bar[XB_TMO])) break; if (sp > XB_SPIN_CAP) { atomicAdd(&bar[XB_TMO], 1u); break; } }
    }
    nloc = mine > 0u ? mine : 1u; nx = cnt > 0u ? cnt : 1u;
}
__device__ __forceinline__ void xcd_barrier(const XcdBarrier& b, bool leader) {
    asm volatile("s_waitcnt vmcnt(0)" ::: "memory");
    __syncthreads();
    if (leader) {
        unsigned* bar = b.bar;
        __builtin_amdgcn_s_waitcnt(0);
        unsigned nloc = b.st[0], nx = b.st[1];
        if (nloc == 0u) { xcd_barrier_complete(bar, b.x, nloc, nx); b.st[0] = nloc; b.st[1] = nx; }
        const unsigned old = xb_add(&bar[XB_XSUB(b.x)], 1u);
        const unsigned gen = old / nloc;
        if (old + 1u == (gen + 1u) * nloc) {
            __builtin_amdgcn_fence(__ATOMIC_RELEASE, "agent");
            asm volatile("s_waitcnt vmcnt(0)" ::: "memory");
            const unsigned og = xb_add(&bar[XB_TOP], 1u);
            const unsigned tg = og / nx;
            if (og + 1u == (tg + 1u) * nx) xb_add(&bar[XB_TOPGEN], 1u);
            else XB_SPIN(xb_ld(&bar[XB_TOPGEN]) == tg, bar);
            __builtin_amdgcn_fence(__ATOMIC_ACQUIRE, "agent");
            xb_add(&bar[XB_XGEN(b.x)], 1u);
            asm volatile("s_waitcnt vmcnt(0)" ::: "memory");
        } else {
            XB_SPIN(xb_ld(&bar[XB_XGEN(b.x)]) == gen, bar);
            __builtin_amdgcn_fence(__ATOMIC_ACQUIRE, "agent");
            asm volatile("s_waitcnt vmcnt(0)" ::: "memory");
        }
    }
    __syncthreads();
}

namespace pg8 {
constexpr int BM = 256, BK = 64, HALF = 128, HTB = HALF * BK * 2, STAGE_BYTES = 8 * HTB;
__host__ __device__ __forceinline__ int lds_byte(int r, int c) { const int st = (r >> 4) * 2 + (c >> 5), rr = r & 15, cc = c & 31, ob = rr * 64 + cc * 2; return st * 1024 + (ob ^ (((ob >> 9) & 1) << 5)); }
__host__ __device__ __forceinline__ void stage_rc(int b, int& R, int& C) { const int st = b / 1024, sb = b % 1024, swz = sb ^ (((sb >> 9) & 1) << 5); R = (st >> 1) * 16 + swz / 64; C = (st & 1) * 32 + (swz % 64) / 2; }
__host__ __device__ __forceinline__ int perm32(int rho) { const int n = rho >> 4, i = rho & 15; return 8 * (i >> 2) + 4 * n + (i & 3); }
struct Unit { int pm, pn, x; };
struct Dims { int lda, ldb, K; };

typedef int v8i32 __attribute__((ext_vector_type(8)));
template <class Epi, class Sched, bool ALIGN_EPI, bool F8 = false>
__device__ __forceinline__ void gemm_phase(LAS unsigned char* lds, const Dims g, const Sched& S, const Epi& E, int tid_in) {
    int tid_ = tid_in; asm volatile("" : "+v"(tid_));
    const int tid = tid_, wid = __builtin_amdgcn_readfirstlane(tid >> 6), lane = tid & 63, wr = wid >> 2, wc = wid & 3, fr = lane & 15, fq = lane >> 4;
    constexpr int ESZ = F8 ? 1 : 2;
    const int K = g.K; int nt = K * ESZ / (BK * 2); asm volatile("" : "+s"(nt));
    unsigned voffA[2], voffB[2];
#pragma unroll
    for (int i = 0; i < 2; ++i) { int R, C; stage_rc(tid * 16 + i * 8192, R, C); const int Rb = Epi::PERM ? ((R & ~31) + perm32(R & 31)) : R;
        voffA[i] = (unsigned)(R * g.lda * ESZ + C * 2); voffB[i] = (unsigned)(Rb * g.ldb * ESZ + C * 2); }
    const size_t kstep = (size_t)(BK * 2);
    const size_t hA = (size_t)HALF * g.lda * ESZ, hB = (size_t)HALF * g.ldb * ESZ;
    const unsigned ldsw = (unsigned)wid * 1024u;
    const int aoff = lds_byte(wr * 64 + fr, fq * 8), boff = lds_byte(wc * 32 + fr, fq * 8);
#define PG8_SA(b, h) (((b) * 2 + (h)) * HTB)
#define PG8_SB(b, h) ((4 + (b) * 2 + (h)) * HTB)
#define PG8_UNI(p) ((const char*)(const GAS char*)(((unsigned long long)(unsigned)__builtin_amdgcn_readfirstlane((int)((unsigned long long)(p) >> 32)) << 32) | (unsigned)__builtin_amdgcn_readfirstlane((int)(unsigned long long)(p))))
#define PG8_STAGE(bufoff, gbase, soff, voff) do { const char* _gb = PG8_UNI(gbase); const unsigned _so = (unsigned)(soff); _Pragma("unroll") for (int _i = 0; _i < 2; ++_i) \
        __builtin_amdgcn_global_load_lds((const unsigned*)(_gb + ((voff)[_i] + _so)), (LAS unsigned*)(lds + (bufoff) + ldsw + _i * 8192), 16, 0, 0); } while (0)
#define PG8_LD1(dst, off) do { _Pragma("unroll") for (int k = 0; k < 2; ++k) dst[k] = *(const LAS bf16x8*)(lds + (off) + k * 1024); } while (0)
#define PG8_LDA(dst, b, h) do { _Pragma("unroll") for (int m = 0; m < 4; ++m) PG8_LD1(dst[m], PG8_SA(b, h) + aoff + m * 2048); } while (0)
#define PG8_LDB(dst, b, h) do { _Pragma("unroll") for (int n = 0; n < 2; ++n) PG8_LD1(dst[n], PG8_SB(b, h) + boff + n * 2048); } while (0)
#define PG8_CAT(x) __builtin_bit_cast(v8i32, __builtin_shufflevector((x)[0], (x)[1], 0, 1, 2, 3, 4, 5, 6, 7, 8, 9, 10, 11, 12, 13, 14, 15))
#define PG8_MMA(ai, bj, At, Bt) do { __builtin_amdgcn_s_setprio(1); _Pragma("unroll") for (int m = 0; m < 4; ++m) _Pragma("unroll") for (int n = 0; n < 2; ++n) { \
        if constexpr (F8) { const v8i32 b8_ = PG8_CAT(Bt[n]), a8_ = PG8_CAT(At[m]); asm volatile("v_mfma_scale_f32_16x16x128_f8f6f4 %0, %1, %2, %0, %3, %3 op_sel_hi:[0,0,0]" : "+v"(acc[ai][bj][m][n]) : "v"(b8_), "v"(a8_), "v"(0x7f7f7f7f)); } \
        else { _Pragma("unroll") for (int k = 0; k < 2; ++k) acc[ai][bj][m][n] = __builtin_amdgcn_mfma_f32_16x16x32_bf16(Bt[n][k], At[m][k], acc[ai][bj][m][n], 0, 0, 0); } } __builtin_amdgcn_s_setprio(0); } while (0)
#define PG8_WAIT_V(n) asm volatile("s_waitcnt vmcnt(" #n ")" ::: "memory")
#define PG8_WAIT_L(n) asm volatile("s_waitcnt lgkmcnt(" #n ")" ::: "memory")
#define PG8_BAR __builtin_amdgcn_s_barrier()
#define PG8_SCHED __builtin_amdgcn_sched_barrier(0)
    Unit cur, nxt; int ui = 0;
    if (!S.next(0, cur)) return;
    const char* cA; const char* cB; S.ptrs(cur, cA, cB);
    PG8_STAGE(PG8_SB(0, 0), cB, 0, voffB); PG8_STAGE(PG8_SB(0, 1), cB, hB, voffB); PG8_STAGE(PG8_SA(0, 0), cA, 0, voffA); PG8_STAGE(PG8_SA(0, 1), cA, hA, voffA);
    if (wr == 1) PG8_BAR;
    PG8_WAIT_V(2); PG8_BAR;
    PG8_STAGE(PG8_SB(1, 0), cB, kstep, voffB); PG8_STAGE(PG8_SA(1, 0), cA, kstep, voffA); PG8_STAGE(PG8_SB(1, 1), cB, hB + kstep, voffB);
    PG8_WAIT_V(6); PG8_BAR;
    asm volatile("" ::: "memory");
    f32x4 acc[2][2][4][2];
#pragma unroll
    for (int a = 0; a < 2; ++a)
#pragma unroll
        for (int b = 0; b < 2; ++b)
#pragma unroll
            for (int m = 0; m < 4; ++m)
#pragma unroll
                for (int n = 0; n < 2; ++n) acc[a][b][m][n] = (f32x4){0.f, 0.f, 0.f, 0.f};
    typedef int v4i32 __attribute__((ext_vector_type(4)));
    bf16x8 At[4][2], B0[2][2], B1[2][2];
    for (;;) {
        const bool has_next = S.next(ui + 1, nxt);
        const char* nA = cA; const char* nB = cB; if (has_next) S.ptrs(nxt, nA, nB);
        for (int t = 0; t < nt; t += 2) {
            if constexpr (Epi::MIDK) { constexpr int MT = F8 ? 4 : 8; if (t == MT || t == 2 * MT) { int m_fr = fr, m_fq = fq; asm volatile("" : "+v"(m_fr), "+v"(m_fq)); E.mid(acc, cur, t / MT, wr, wc, m_fr, m_fq); } }
            const bool last = (t == nt - 2);
            const size_t o1 = (size_t)(t + 1) * kstep;
            const char* a2 = last ? nA : cA; const char* b2 = last ? nB : cB; const size_t o2 = last ? 0 : (size_t)(t + 2) * kstep, o3 = o2 + kstep;
            PG8_LDB(B0, 0, 0); PG8_LDB(B1, 0, 1); PG8_SCHED; PG8_LDA(At, 0, 0); PG8_STAGE(PG8_SA(1, 1), cA, o1 + hA, voffA);
            PG8_WAIT_V(8); PG8_WAIT_L(0); PG8_BAR; PG8_MMA(0, 0, At, B0); PG8_MMA(0, 1, At, B1); PG8_BAR; PG8_SCHED;
            PG8_LDA(At, 0, 1); PG8_STAGE(PG8_SB(0, 0), b2, o2, voffB); PG8_STAGE(PG8_SB(0, 1), b2, o2 + hB, voffB); PG8_STAGE(PG8_SA(0, 0), a2, o2, voffA);
            PG8_WAIT_V(8); PG8_WAIT_L(0); PG8_BAR; PG8_MMA(1, 0, At, B0); PG8_MMA(1, 1, At, B1); PG8_BAR; PG8_SCHED;
            PG8_LDB(B0, 1, 0); PG8_LDB(B1, 1, 1); PG8_SCHED; PG8_LDA(At, 1, 0); PG8_STAGE(PG8_SA(0, 1), a2, o2 + hA, voffA);
            PG8_WAIT_V(8); PG8_WAIT_L(0); PG8_BAR; PG8_MMA(0, 0, At, B0); PG8_MMA(0, 1, At, B1); PG8_BAR; PG8_SCHED;
            PG8_LDA(At, 1, 1); PG8_STAGE(PG8_SB(1, 0), b2, o3, voffB); PG8_STAGE(PG8_SB(1, 1), b2, o3 + hB, voffB); PG8_STAGE(PG8_SA(1, 0), a2, o3, voffA);
            PG8_WAIT_V(8); PG8_WAIT_L(0); PG8_BAR; PG8_MMA(1, 0, At, B0); PG8_MMA(1, 1, At, B1); PG8_BAR; PG8_SCHED;
        }
        if constexpr (ALIGN_EPI) { if (wr == 0) PG8_BAR; }
        if constexpr (F8) asm volatile("s_nop 15\n\ts_nop 15" ::: "memory");
        { Unit eu = cur; int e_fr = fr, e_fq = fq;
          asm volatile("" : "+v"(e_fr), "+v"(e_fq));
          E(acc, eu, wr, wc, e_fr, e_fq); }
        if (!has_next) break;
#pragma unroll
        for (int a = 0; a < 2; ++a)
#pragma unroll
            for (int b = 0; b < 2; ++b)
#pragma unroll
                for (int m = 0; m < 4; ++m)
#pragma unroll
                    for (int n = 0; n < 2; ++n) acc[a][b][m][n] = (f32x4){0.f, 0.f, 0.f, 0.f};
        cur = nxt; cA = nA; cB = nB; ++ui;
        if constexpr (ALIGN_EPI) { if (wr == 1) PG8_BAR; }
    }
    PG8_WAIT_V(0);
    if constexpr (!ALIGN_EPI) { if (wr == 0) PG8_BAR; }
    PG8_BAR;
#undef PG8_SA
#undef PG8_SB
#undef PG8_STAGE
#undef PG8_UNI
#undef PG8_LDA
#undef PG8_LDB
#undef PG8_MMA
#undef PG8_LD1
#undef PG8_WAIT_V
#undef PG8_WAIT_L
#undef PG8_BAR
#undef PG8_SCHED
}

struct PlainOrder {
    int nM, nN, nwg, G, c; const char* A; const char* Bt; size_t tA, tB;
    __device__ void init(const void* A_, const void* Bt_, int M, int N, int lda, int ldb, int G_, int c_, int esz = 2) { nM = M / BM; nN = N / BM; nwg = nM * nN; G = G_; c = c_; A = (const char*)A_; Bt = (const char*)Bt_; tA = (size_t)BM * lda * esz; tB = (size_t)BM * ldb * esz; }
    __device__ __forceinline__ bool next(int i, Unit& u) const {
        const long L = (long)i * G + c; if (L >= nwg) return false;
        int wgid = (int)L; { const int q = nwg / 8, r = nwg % 8, xcd = wgid % 8, off = wgid / 8; wgid = (xcd < r ? xcd * (q + 1) : r * (q + 1) + (xcd - r) * q) + off; }
        const int nig = 8 * nN, gid = wgid / nig, fm = gid * 8, gsz = (nM - fm) < 8 ? (nM - fm) : 8;
        u.pm = fm + ((wgid % nig) % gsz); u.pn = (wgid % nig) / gsz; u.x = 0; return true;
    }
    __device__ __forceinline__ void ptrs(const Unit& u, const char*& a, const char*& b) const { a = A + (size_t)u.pm * tA; b = Bt + (size_t)u.pn * tB; }
};
struct SubsetOrder : PlainOrder {
    int split, skip;
    __device__ __forceinline__ bool next(int i, Unit& u) const { if (!PlainOrder::next(i, u)) return false; u.x = u.pn; u.pn = u.pn < split ? u.pn : u.pn + skip; return true; }
    __device__ __forceinline__ void ptrs(const Unit& u, const char*& a, const char*& b) const { a = A + (size_t)u.pm * tA; b = Bt + (size_t)u.x * tB; }
};
}

#ifndef FP8_INPROJ
#define FP8_INPROJ 1
#endif
struct Frame {
    LAS unsigned char* lds;
    volatile LAS unsigned* MISC;
    unsigned* ctl;
    unsigned char* ws;
    int tid, lane, wave, G, bid;
    const float* const* in;
    float* xf;
};
using pg8::Unit;
#ifndef FP8_FFN
#define FP8_FFN 0
#endif
#ifndef FP8_MRG
#define FP8_MRG 1
#endif
constexpr float YS_SC = 4.0f;
constexpr int YS8_OFF = 1024, YS8_LD = 3072;
#ifndef FP8_OUT
#define FP8_OUT 0
#endif
#ifndef FP8_DDN
#define FP8_DDN 0
#endif
#ifndef FP8_MOE
#define FP8_MOE 1
#endif
__device__ __forceinline__ unsigned pk4_fp8(float a, float b, float c, float d) { int w = __builtin_amdgcn_cvt_pk_fp8_f32(a, b, 0, false); w = __builtin_amdgcn_cvt_pk_fp8_f32(c, d, w, true); return (unsigned)w; }
#define INP(i) ((const float*)(const GAS float*)F.in[i])

typedef const f32x4 (&AccRef)[2][2][4][2];
#define OPQ_S(x) asm volatile("" : "+s"(x))
#define OPQ_V(x) asm volatile("" : "+v"(x))

struct EpiRes {
    static constexpr bool PERM = false, MIDK = false;
    const bf16_t* xb; bf16_t* vb; int dry; float scl = 1.0f;
    __device__ __forceinline__ void operator()(AccRef acc, const Unit& u, int wr, int wc, int fr, int fq) const {
        const int row0 = u.pm * 256 + wr * 64 + fr, col0 = u.pn * 256 + wc * 32 + 4 * fq;
#pragma unroll
        for (int ai = 0; ai < 2; ++ai)
#pragma unroll
            for (int m = 0; m < 4; ++m) { const size_t ro = (size_t)(row0 + ai * 128 + m * 16) * DM + col0;
#pragma unroll
                for (int bj = 0; bj < 2; ++bj)
#pragma unroll
                    for (int n = 0; n < 2; ++n) { const u32x2 x = *(const u32x2*)(xb + ro + bj * 128 + n * 16); const f32x4 a = acc[ai][bj][m][n] * scl;
                        u32x2 w; w.x = cvt_pk_h16(bflo(x.x) * ALPHA + a[0], bfhi(x.x) * ALPHA + a[1]); w.y = cvt_pk_h16(bflo(x.y) * ALPHA + a[2], bfhi(x.y) * ALPHA + a[3]);
                        if (!dry || w.x == 0x12345678u) *(u32x2*)(vb + ro + bj * 128 + n * 16) = w; }
                if (m & 1) asm volatile("" ::: "memory"); }
    }
};
template <bool F8OUT> struct EpiSwigluT {
    static constexpr bool PERM = true, MIDK = false;
    bf16_t* hid; int dry;
    __device__ __forceinline__ void operator()(AccRef acc, const Unit& u, int wr, int wc, int fr, int fq) const {
        const int row0 = u.pm * 256 + wr * 64 + fr, col0 = u.pn * 128 + wc * 32 + 8 * fq;
#pragma unroll
        for (int ai = 0; ai < 2; ++ai)
#pragma unroll
            for (int m = 0; m < 4; ++m) { bf16_t* rowp = hid + (size_t)(row0 + ai * 128 + m * 16) * DFF + col0;
                float h[8];
#pragma unroll
                for (int n = 0; n < 2; ++n)
#pragma unroll
                    for (int j = 0; j < 4; ++j) h[n * 4 + j] = siluf_(acc[ai][0][m][n][j]) * acc[ai][1][m][n][j];
                if (F8OUT) { u32x2 w8; w8.x = pk4_fp8(h[0], h[1], h[2], h[3]); w8.y = pk4_fp8(h[4], h[5], h[6], h[7]);
                    if (!dry || w8.x == 0x12345678u) *(u32x2*)((unsigned char*)hid + (size_t)(row0 + ai * 128 + m * 16) * DFF + col0) = w8; }
                else { u32x4 w; w.x = cvt_pk_bf16(h[0], h[1]); w.y = cvt_pk_bf16(h[2], h[3]); w.z = cvt_pk_bf16(h[4], h[5]); w.w = cvt_pk_bf16(h[6], h[7]);
                    if (!dry || w.x == 0x12345678u) *(u32x4*)rowp = w; } }
    }
};
typedef EpiSwigluT<false> EpiSwiglu;
template <int ACT  > struct EpiBf16 {
    static constexpr bool PERM = true, MIDK = false;
    bf16_t* out; int ldc; float scl = 1.0f;
    __device__ __forceinline__ void operator()(AccRef acc, const Unit& u, int wr, int wc, int fr, int fq) const {
        const int row0 = u.pm * 256 + wr * 64 + fr, col0 = u.pn * 256 + wc * 32 + 8 * fq;
#pragma unroll
        for (int ai = 0; ai < 2; ++ai)
#pragma unroll
            for (int m = 0; m < 4; ++m) { bf16_t* rowp = out + (size_t)(row0 + ai * 128 + m * 16) * ldc + col0;
#pragma unroll
                for (int bj = 0; bj < 2; ++bj) { f32x4 v0 = acc[ai][bj][m][0], v1 = acc[ai][bj][m][1];
                    if (ACT == 0) { v0 = v0 * scl; v1 = v1 * scl; }
                    if (ACT == 1) {
#pragma unroll
                        for (int j = 0; j < 4; ++j) { v0[j] = sigmoidf_(v0[j]); v1[j] = sigmoidf_(v1[j]); } }
                    u32x4 w; if (ACT == 0) { w.x = cvt_pk_h16(v0[0], v0[1]); w.y = cvt_pk_h16(v0[2], v0[3]); w.z = cvt_pk_h16(v1[0], v1[1]); w.w = cvt_pk_h16(v1[2], v1[3]); }
                    else { w.x = cvt_pk_bf16(v0[0], v0[1]); w.y = cvt_pk_bf16(v0[2], v0[3]); w.z = cvt_pk_bf16(v1[0], v1[1]); w.w = cvt_pk_bf16(v1[2], v1[3]); }
                    *(u32x4*)(rowp + bj * 128) = w; } }
    }
};
template <bool MID> struct EpiMergeT {
    static constexpr bool PERM = true, MIDK = MID;
    const unsigned char* gates; bf16_t* merged;
    typedef f32x4 (&AccMut)[2][2][4][2];
    static __device__ __forceinline__ float gb(unsigned w, int i) { return (float)((w >> (8 * i)) & 255u); }
    __device__ __forceinline__ void mid(AccMut acc, const Unit& u, int seg, int wr, int wc, int fr, int fq) const {
        const int row0 = u.pm * 256 + wr * 64 + fr, col0 = u.pn * 256 + wc * 32 + 8 * fq; const int c = seg - 1;
#pragma unroll
        for (int ai = 0; ai < 2; ++ai)
#pragma unroll
            for (int m = 0; m < 4; ++m) { const size_t r = (size_t)(row0 + ai * 128 + m * 16);
#pragma unroll
                for (int bj = 0; bj < 2; ++bj) {
                    const u32x2 ga = *(const u32x2*)(gates + r * NIN_B + c * DM + col0 + bj * 128), g2 = *(const u32x2*)(gates + r * NIN_B + (c + 1) * DM + col0 + bj * 128);
                    f32x4 v0 = acc[ai][bj][m][0], v1 = acc[ai][bj][m][1];
#pragma unroll
                    for (int j = 0; j < 4; ++j) { v0[j] *= gb(ga.x, j) * fast_rcp(gb(g2.x, j)); v1[j] *= gb(ga.y, j) * fast_rcp(gb(g2.y, j)); }
                    acc[ai][bj][m][0] = v0; acc[ai][bj][m][1] = v1; }
                if (m & 1) asm volatile("" ::: "memory"); }
    }
    __device__ __forceinline__ void operator()(AccRef acc, const Unit& u, int wr, int wc, int fr, int fq) const {
        const int row0 = u.pm * 256 + wr * 64 + fr, col0 = u.pn * 256 + wc * 32 + 8 * fq;
#pragma unroll
        for (int ai = 0; ai < 2; ++ai)
#pragma unroll
            for (int m = 0; m < 4; ++m) { const size_t r = (size_t)(row0 + ai * 128 + m * 16);
#pragma unroll
                for (int bj = 0; bj < 2; ++bj) {
                    const u32x2 g = *(const u32x2*)(gates + r * NIN_B + 2 * DM + col0 + bj * 128);
                    const f32x4 v0 = acc[ai][bj][m][0], v1 = acc[ai][bj][m][1]; const float k = (FP8_OUT ? 8.0f : 1.0f) * (FP8_MRG ? 1.0f / (YS_SC * 16.0f) : 1.0f) / 255.0f;
                    if (FP8_OUT) { u32x2 w8; w8.x = pk4_fp8(gb(g.x, 0) * k * v0[0], gb(g.x, 1) * k * v0[1], gb(g.x, 2) * k * v0[2], gb(g.x, 3) * k * v0[3]);
                        w8.y = pk4_fp8(gb(g.y, 0) * k * v1[0], gb(g.y, 1) * k * v1[1], gb(g.y, 2) * k * v1[2], gb(g.y, 3) * k * v1[3]);
                        *(u32x2*)((unsigned char*)merged + r * DM + col0 + bj * 128) = w8; }
                    else { u32x4 w;
                    w.x = cvt_pk_bf16(gb(g.x, 0) * k * v0[0], gb(g.x, 1) * k * v0[1]); w.y = cvt_pk_bf16(gb(g.x, 2) * k * v0[2], gb(g.x, 3) * k * v0[3]);
                    w.z = cvt_pk_bf16(gb(g.y, 0) * k * v1[0], gb(g.y, 1) * k * v1[1]); w.w = cvt_pk_bf16(gb(g.y, 2) * k * v1[2], gb(g.y, 3) * k * v1[3]);
                    *(u32x4*)(merged + r * DM + col0 + bj * 128) = w; } }
                if (m & 1) asm volatile("" ::: "memory"); }
    }
};
typedef EpiMergeT<true> EpiMerge;
struct EpiCmp1 {
    static constexpr bool PERM = true, MIDK = false;
    bf16_t* hidc; const float* b1;
    __device__ __forceinline__ void operator()(AccRef acc, const Unit& u, int wr, int wc, int fr, int fq) const {
        const int kv = u.x; const int row0 = u.pm * 256 + wr * 64 + fr, col0 = wc * 32 + 8 * fq;
        f32x4 bv[2][2];
#pragma unroll
        for (int bj = 0; bj < 2; ++bj)
#pragma unroll
            for (int n = 0; n < 2; ++n) bv[bj][n] = *(const f32x4*)(b1 + kv * 256 + col0 + bj * 128 + 4 * n);
#pragma unroll
        for (int ai = 0; ai < 2; ++ai)
#pragma unroll
            for (int m = 0; m < 4; ++m) { bf16_t* rowp = hidc + ((size_t)kv * 4096 + (row0 + ai * 128 + m * 16)) * 256 + col0;
#pragma unroll
                for (int bj = 0; bj < 2; ++bj) { f32x4 v0 = acc[ai][bj][m][0] + bv[bj][0], v1 = acc[ai][bj][m][1] + bv[bj][1];
#pragma unroll
                    for (int j = 0; j < 4; ++j) { float x = v0[j]; v0[j] = x * sigmoidf_(1.5957691216057308f * (x + 0.044715f * x * x * x)); x = v1[j]; v1[j] = x * sigmoidf_(1.5957691216057308f * (x + 0.044715f * x * x * x)); }
                    u32x4 w; w.x = cvt_pk_bf16(v0[0], v0[1]); w.y = cvt_pk_bf16(v0[2], v0[3]); w.z = cvt_pk_bf16(v1[0], v1[1]); w.w = cvt_pk_bf16(v1[2], v1[3]);
                    *(u32x4*)(rowp + bj * 128) = w; } }
    }
};
struct EpiInA {
    static constexpr bool PERM = true, MIDK = false;
    unsigned char* ws; const float* cs; const float* sn;
    __device__ __forceinline__ void operator()(AccRef acc, const Unit& u, int wr, int wc, int fr, int fq) const {
        const int pn = u.pn; const int row0 = u.pm * 256 + wr * 64 + fr; const int cc = wc * 32 + 8 * fq;
        if (pn >= 7 && pn <= 10) {
#pragma unroll
            for (int ai = 0; ai < 2; ++ai)
#pragma unroll
                for (int m = 0; m < 4; ++m) { bf16_t* rowp = (bf16_t*)(ws + R_CONV) + (size_t)(row0 + ai * 128 + m * 16) * 1024 + 512 + (pn - 7) * 128 + cc;
                    const f32x4 u0 = acc[ai][0][m][0] * acc[ai][1][m][0], u1 = acc[ai][0][m][1] * acc[ai][1][m][1];
                    u32x4 w; w.x = cvt_pk_bf16(u0[0], u0[1]); w.y = cvt_pk_bf16(u0[2], u0[3]); w.z = cvt_pk_bf16(u1[0], u1[1]); w.w = cvt_pk_bf16(u1[2], u1[3]);
                    *(u32x4*)rowp = w; }
        } else if (pn < 2 || pn == 5 || pn == 6 || pn == 17 || pn == 18) {
            bf16_t* base; int ldc, cb; float sc = 1.f; int act = 0;
            if (pn < 2) { base = (bf16_t*)(ws + R_Q); ldc = 512; cb = pn * 256; sc = QSCALE; }
            else if (pn <= 6) { base = (bf16_t*)(ws + R_CONV); ldc = 1024; cb = (pn - 5) * 256; }
            else { base = (bf16_t*)(ws + R_RG); ldc = 512; cb = (pn - 17) * 256; act = 1; }
#pragma unroll
            for (int ai = 0; ai < 2; ++ai)
#pragma unroll
                for (int m = 0; m < 4; ++m) { bf16_t* rowp = base + (size_t)(row0 + ai * 128 + m * 16) * ldc + cb + cc;
#pragma unroll
                    for (int bj = 0; bj < 2; ++bj) { f32x4 v0 = acc[ai][bj][m][0] * sc, v1 = acc[ai][bj][m][1] * sc;
                        if (act) {
#pragma unroll
                            for (int j = 0; j < 4; ++j) { v0[j] = siluf_(v0[j]); v1[j] = siluf_(v1[j]); } }
                        u32x4 w; w.x = cvt_pk_bf16(v0[0], v0[1]); w.y = cvt_pk_bf16(v0[2], v0[3]); w.z = cvt_pk_bf16(v1[0], v1[1]); w.w = cvt_pk_bf16(v1[2], v1[3]);
                        *(u32x4*)(rowp + bj * 128) = w; } }
        } else if (pn <= 4) {
#pragma unroll
            for (int bj = 0; bj < 2; ++bj) {
                const int colkv = (pn - 2) * 256 + bj * 128 + cc, c = colkv >> 6, d0 = colkv & 63, br = c >> 2, kvi = (c >> 1) & 1, g = c & 1;
#pragma unroll
                for (int ai = 0; ai < 2; ++ai)
#pragma unroll
                    for (int m = 0; m < 4; ++m) { const int row = row0 + ai * 128 + m * 16, b = row >> 14, t = row & (SEQ - 1);
                        const f32x4 v0 = acc[ai][bj][m][0], v1 = acc[ai][bj][m][1];
                        if (br == 1) {
                            if (kvi == 0) { unsigned char* base = (unsigned char*)(ws + R_KNAT) + ((size_t)(b * 2 + g) * SEQ + t) * 64 + d0;
                                int w0 = __builtin_amdgcn_cvt_pk_fp8_f32(v0[0], v0[1], 0, false); w0 = __builtin_amdgcn_cvt_pk_fp8_f32(v0[2], v0[3], w0, true);
                                int w1 = __builtin_amdgcn_cvt_pk_fp8_f32(v1[0], v1[1], 0, false); w1 = __builtin_amdgcn_cvt_pk_fp8_f32(v1[2], v1[3], w1, true);
                                *(u32x2*)base = (u32x2){(unsigned)w0, (unsigned)w1};
                            } else { unsigned char* base = (unsigned char*)(ws + R_VT) + ((size_t)(b * 2 + g) * SEQ + (t & ~63)) * 64 + (t & 63);
#pragma unroll
                                for (int j = 0; j < 4; ++j) { base[(d0 + j) * 64] = (unsigned char)__builtin_amdgcn_cvt_pk_fp8_f32(v0[j], v0[j], 0, false); base[(d0 + 4 + j) * 64] = (unsigned char)__builtin_amdgcn_cvt_pk_fp8_f32(v1[j], v1[j], 0, false); } }
                        } else if (br == 0) {
                            unsigned char* base = (unsigned char*)(ws + R_CMPRAW) + ((size_t)((kvi * 2 + b) * 2 + g) * SEQ + t) * 64 + d0;
                            *(u32x2*)base = (u32x2){pk4_fp8(v0[0], v0[1], v0[2], v0[3]), pk4_fp8(v1[0], v1[1], v1[2], v1[3])};
                        } else if (kvi == 0) {
                            bf16_t* base = (bf16_t*)(ws + R_KNAT) + ((size_t)(((br - 1) * 2 + b) * 2 + g) * SEQ + t) * 64;
                            u32x4 w; w.x = cvt_pk_bf16(v0[0], v0[1]); w.y = cvt_pk_bf16(v0[2], v0[3]); w.z = cvt_pk_bf16(v1[0], v1[1]); w.w = cvt_pk_bf16(v1[2], v1[3]);
                            *(u32x4*)(base + d0) = w;
                        } else {
                            bf16_t* base = (bf16_t*)(ws + R_VT) + ((size_t)(((br - 1) * 2 + b) * 2 + g) * SEQ + (t & ~63)) * 64 + (t & 63);
#pragma unroll
                            for (int j = 0; j < 4; ++j) { base[(d0 + j) * 64] = f2bf(v0[j]); base[(d0 + 4 + j) * 64] = f2bf(v1[j]); }
                        } }
            }
        } else if (pn <= 14) {
            const int ti = pn - 11, isK = ti >> 1, hp = ti & 1, head = 2 * hp + (cc >> 6), i0 = cc & 63;
            const float sc = isK ? 0.08838834764831845f : 1.0f;
            const float l2g = __builtin_log2f(1.0f - __builtin_exp2f(-5.0f - (float)head));
            bf16_t* nat = (bf16_t*)(ws + (isK ? R_RK : R_RQ));
#pragma unroll
            for (int ai = 0; ai < 2; ++ai)
#pragma unroll
                for (int m = 0; m < 4; ++m) { const int row = row0 + ai * 128 + m * 16, b = row >> 14, t = row & (SEQ - 1);
                    float o1[8], o2[8];
#pragma unroll
                    for (int n = 0; n < 2; ++n) { const f32x4 c4 = *(const f32x4*)(cs + (size_t)t * 64 + i0 + 4 * n), s4 = *(const f32x4*)(sn + (size_t)t * 64 + i0 + 4 * n);
                        const f32x4 x1 = acc[ai][0][m][n], x2 = acc[ai][1][m][n];
#pragma unroll
                        for (int j = 0; j < 4; ++j) { o1[n * 4 + j] = (x1[j] * c4[j] - x2[j] * s4[j]) * sc; o2[n * 4 + j] = (x1[j] * s4[j] + x2[j] * c4[j]) * sc; } }
                    bf16_t* rowp = nat + (size_t)row * 512 + head * 128 + i0;
                    u32x4 w; w.x = cvt_pk_bf16(o1[0], o1[1]); w.y = cvt_pk_bf16(o1[2], o1[3]); w.z = cvt_pk_bf16(o1[4], o1[5]); w.w = cvt_pk_bf16(o1[6], o1[7]);
                    *(u32x4*)rowp = w;
                    w.x = cvt_pk_bf16(o2[0], o2[1]); w.y = cvt_pk_bf16(o2[2], o2[3]); w.z = cvt_pk_bf16(o2[4], o2[5]); w.w = cvt_pk_bf16(o2[6], o2[7]);
                    *(u32x4*)(rowp + 64) = w;
                    }
        } else if (pn <= 16) {
#pragma unroll
            for (int ai = 0; ai < 2; ++ai)
#pragma unroll
                for (int m = 0; m < 4; ++m) { bf16_t* rowp = (bf16_t*)(ws + R_VTR) + (size_t)(row0 + ai * 128 + m * 16) * 512 + (pn - 15) * 256 + cc;
#pragma unroll
                    for (int bj = 0; bj < 2; ++bj) { const f32x4 v0 = acc[ai][bj][m][0], v1 = acc[ai][bj][m][1];
                        u32x4 w; w.x = cvt_pk_bf16(v0[0], v0[1]); w.y = cvt_pk_bf16(v0[2], v0[3]); w.z = cvt_pk_bf16(v1[0], v1[1]); w.w = cvt_pk_bf16(v1[2], v1[3]);
                        *(u32x4*)(rowp + bj * 128) = w; } }
        } else if (pn >= 20) {
#pragma unroll
            for (int ai = 0; ai < 2; ++ai)
#pragma unroll
                for (int m = 0; m < 4; ++m) { unsigned char* rowp = (unsigned char*)(ws + R_GATES) + (size_t)(row0 + ai * 128 + m * 16) * NIN_B + (pn - 20) * 256 + cc;
#pragma unroll
                    for (int bj = 0; bj < 2; ++bj) { const f32x4 v0 = acc[ai][bj][m][0], v1 = acc[ai][bj][m][1]; unsigned q[8];
#pragma unroll
                        for (int j = 0; j < 4; ++j) { q[j] = (unsigned)fmaxf(sigmoidf_(v0[j]) * 255.0f + 0.5f, 1.0f); q[4 + j] = (unsigned)fmaxf(sigmoidf_(v1[j]) * 255.0f + 0.5f, 1.0f); }
                        u32x2 w; w.x = q[0] | (q[1] << 8) | (q[2] << 16) | (q[3] << 24); w.y = q[4] | (q[5] << 8) | (q[6] << 16) | (q[7] << 24);
                        *(u32x2*)(rowp + bj * 128) = w; } }
        } else {
            if (wc == 0 && fq < 3) {
#pragma unroll
                for (int ai = 0; ai < 2; ++ai)
#pragma unroll
                    for (int m = 0; m < 4; ++m) { const int row = row0 + ai * 128 + m * 16;
                        f32x4 v0 = acc[ai][0][m][0], v1 = acc[ai][0][m][1];
#pragma unroll
                        for (int j = 0; j < 4; ++j) { v0[j] = sigmoidf_(v0[j]); v1[j] = sigmoidf_(v1[j]); }
                        u32x4 w; w.x = cvt_pk_bf16(v0[0], v0[1]); w.y = cvt_pk_bf16(v0[2], v0[3]); w.z = cvt_pk_bf16(v1[0], v1[1]); w.w = cvt_pk_bf16(v1[2], v1[3]);
                        *(u32x4*)((bf16_t*)(ws + R_NG) + (size_t)row * 32 + 8 * fq) = w; }
            }
        }
    }
};

struct CmpOrder {
    int G, c; const char* A; const char* Bt;
    __device__ __forceinline__ bool next(int i, Unit& u) const { const int L = i * G + c; if (L >= 32) return false; u.x = L >> 4; u.pm = L & 15; u.pn = 0; return true; }
    __device__ __forceinline__ void ptrs(const Unit& u, const char*& a, const char*& b) const {
        a = A + ((size_t)u.x * 4 * SEQ * 64 + (size_t)u.pm * 256 * 1024); b = Bt + (size_t)u.x * 256 * 2048; }
};
struct MoeOrder {
    int G, c, NT; const LAS int* tab; const char* A; const char* Bt; size_t tA, tB, eB;
    __device__ __forceinline__ bool next(int i, Unit& u) const {
        const int TM = tab[8]; const long L = (long)i * G + c; if (L >= (long)TM * NT) return false;
        u.pm = (int)(L / NT); u.pn = (int)(L % NT); int e = 0;
#pragma unroll
        for (int k = 1; k < 8; ++k) e += (tab[k] <= u.pm) ? 1 : 0;
        u.x = e; return true; }
    __device__ __forceinline__ void ptrs(const Unit& u, const char*& a, const char*& b) const { a = A + (size_t)u.pm * tA; b = Bt + (size_t)u.x * eB + (size_t)u.pn * tB; }
};

__device__ __forceinline__ void cvt_item(const float* src, int ldw, int nvalid, bf16_t* dst, int ldk, LAS float* scr, int lane, bool q8 = false, float qs = 1.0f) {
    const int c4 = lane & 15, kr = lane >> 4;
    f32x4 vin[2][8];
#pragma unroll
    for (int half = 0; half < 2; ++half)
#pragma unroll
        for (int i = 0; i < 8; ++i) { vin[half][i] = (f32x4){0.f, 0.f, 0.f, 0.f}; if (c4 * 4 < nvalid) vin[half][i] = *(const f32x4*)(src + (size_t)(half * 32 + kr + 4 * i) * ldw + c4 * 4); }
#pragma unroll
    for (int half = 0; half < 2; ++half) {
#pragma unroll
        for (int i = 0; i < 8; ++i) { const int kk = kr + 4 * i; const f32x4 v = vin[half][i];
#pragma unroll
            for (int e = 0; e < 4; ++e) scr[kk * 65 + c4 * 4 + e] = (c4 * 4 + e < nvalid) ? v[e] : 0.f; }
        LDS_WAIT(); asm volatile("" ::: "memory");
        const int c = lane & 3;
#pragma unroll
        for (int j = 0; j < 4; ++j) { const int n = (lane >> 2) + 16 * j; const LAS float* s = scr + (8 * c) * 65 + n;
            if (q8) { u32x2 o8; o8.x = pk4_fp8(s[0 * 65] * qs, s[1 * 65] * qs, s[2 * 65] * qs, s[3 * 65] * qs); o8.y = pk4_fp8(s[4 * 65] * qs, s[5 * 65] * qs, s[6 * 65] * qs, s[7 * 65] * qs); *(u32x2*)((unsigned char*)dst + (size_t)n * ldk + half * 32 + 8 * c) = o8; }
            else { u32x4 o; o.x = cvt_pk_bf16(s[0 * 65], s[1 * 65]); o.y = cvt_pk_bf16(s[2 * 65], s[3 * 65]); o.z = cvt_pk_bf16(s[4 * 65], s[5 * 65]); o.w = cvt_pk_bf16(s[6 * 65], s[7 * 65]); *(u32x4*)(dst + (size_t)n * ldk + half * 32 + 8 * c) = o; } }
        LDS_WAIT(); asm volatile("" ::: "memory");
    }
}
__device__ __forceinline__ void win_map(int n0, int& c, int& nvalid) {
    nvalid = 64;
    if (n0 < 1280) c = n0;
    else if (n0 < 1792) c = n0 + 24;
    else if (n0 < 2816) { const int tl = n0 - 1792, tj = tl >> 8, w = tl & 255; c = (w < 128 ? 1816 : 2328 - 128) + tj * 128 + w; }
    else if (n0 < 3840) { const int ti = (n0 - 2816) >> 8, tl = (n0 - 2816) & 255, base = ti < 2 ? 2840 : 3352, hp = ti & 1, half = tl >> 7, hh = (tl & 127) >> 6, i = tl & 63; c = base + (2 * hp + hh) * 128 + half * 64 + i; }
    else if (n0 < 4864) c = n0 + 24;
    else if (n0 == 4864) { c = 1280; nvalid = 24; }
    else if (n0 < 5120) { c = 0; nvalid = 0; }
    else c = 4888 + (n0 - 5120);
}
__device__ __forceinline__ void phase_weights(Frame& F, int l) {
    LAS float* scr = (LAS float*)(F.lds + F.wave * 16384);
    const int gw = F.bid * NWAVES + F.wave, NGW = F.G * NWAVES;
    const bool moe = (l & 1);
    const float* w_in = INP(1) + (size_t)l * DM * IN_COLS;
    const float* cw1 = INP(3) + (size_t)l * 2 * 2048 * 256;
    const float* cw2 = INP(5) + (size_t)l * 2 * 256 * 64;
    const float* wbr = INP(10) + (size_t)l * 3 * 512 * DM;
    const float* wout = INP(11) + (size_t)l * DM * DM;
    const int I_IN = 128 * 16, I_C1 = 2 * 4 * 32, I_C2 = 2 * 1 * 4, I_BR = 3 * 16 * 8, I_OUT = 16 * 16, I_GU = 112 * 16, I_DN = 16 * 56;
    const int nE = moe ? NEXP : 1;
    const int NITEMS = I_IN + I_C1 + I_C2 + I_BR + I_OUT + nE * (I_GU + I_DN);
    for (int it = gw; it < NITEMS; it += NGW) {
        int r = it; const float* src; int ldw, nv = 64, ldk; bf16_t* d; bool q8 = false; float qs = 1.0f;
        if (r < I_IN) { const int nb = r >> 4, kb = r & 15, n0 = nb * 64; int c; win_map(n0, c, nv); const bool conv = (n0 >= 1280 && n0 < 2816);
            d = (FP8_INPROJ && !conv) ? (bf16_t*)((unsigned char*)(F.ws + W_IN) + (size_t)(n0 < 1280 ? n0 : n0 - 1536) * DM + kb * 64)
              : FP8_INPROJ ? (bf16_t*)(F.ws + W_IN + 8 * MiB) + (size_t)(n0 - 1280) * DM + kb * 64 : (bf16_t*)(F.ws + W_IN) + (size_t)n0 * DM + kb * 64;
            src = w_in + (size_t)(kb * 64) * IN_COLS + c; ldw = IN_COLS; ldk = DM; q8 = FP8_INPROJ && !conv; }
        else if ((r -= I_IN) < I_C1) { const int kv = r >> 7, q = r & 127, nb = q >> 5, kb = q & 31;
            src = cw1 + ((size_t)kv * 2048 + kb * 64) * 256 + nb * 64; ldw = 256; d = (bf16_t*)((unsigned char*)(F.ws + W_C1) + ((size_t)kv * 256 + nb * 64) * 2048 + kb * 64); ldk = 2048; q8 = true; }
        else if ((r -= I_C1) < I_C2) { const int kv = r >> 2, kb = r & 3;
            src = cw2 + ((size_t)kv * 256 + kb * 64) * 64; ldw = 64; d = (bf16_t*)(F.ws + W_C2) + ((size_t)kv * 64) * 256 + kb * 64; ldk = 256; }
        else if ((r -= I_C2) < I_BR) { const int c = r >> 7, q = r & 127, nb = q >> 3, kb = q & 7;
            src = wbr + ((size_t)c * 512 + kb * 64) * DM + nb * 64; ldw = DM; q8 = FP8_MRG != 0; qs = q8 ? 16.0f : 1.0f; d = q8 ? (bf16_t*)((unsigned char*)(F.ws + W_BR) + (size_t)(nb * 64) * 1536 + c * 512 + kb * 64) : (bf16_t*)(F.ws + W_BR) + (size_t)(nb * 64) * 1536 + c * 512 + kb * 64; ldk = 1536; }
        else if ((r -= I_BR) < I_OUT) { const int nb = r >> 4, kb = r & 15;
            src = wout + (size_t)(kb * 64) * DM + nb * 64; ldw = DM; q8 = FP8_OUT != 0; qs = q8 ? 16.0f : 1.0f; d = q8 ? (bf16_t*)((unsigned char*)(F.ws + W_OUT) + (size_t)(nb * 64) * DM + kb * 64) : (bf16_t*)(F.ws + W_OUT) + (size_t)(nb * 64) * DM + kb * 64; ldk = DM; }
        else { r -= I_OUT; const int e = r / (I_GU + I_DN); r -= e * (I_GU + I_DN);
          const size_t wsz = (size_t)DM * DFF; const size_t eo = moe ? ((size_t)(l >> 1) * NEXP + e) * wsz : (size_t)(l >> 1) * wsz;
          bf16_t* gu_t = (bf16_t*)(F.ws + W_FFN) + (size_t)e * 3 * wsz; bf16_t* dn_t = gu_t + 2 * wsz;
          if (r < I_GU) { const int nb = r >> 4, kb = r & 15, n0 = nb * 64, pn = n0 >> 8, j = n0 & 255;
              src = ((j < 128) ? (moe ? INP(20) : INP(16)) + eo + pn * 128 + j : (moe ? INP(21) : INP(17)) + eo + pn * 128 + (j - 128)) + (size_t)(kb * 64) * DFF; ldw = DFF; q8 = moe ? (FP8_MOE != 0) : (FP8_FFN != 0); d = q8 ? (bf16_t*)((unsigned char*)gu_t + (size_t)n0 * DM + kb * 64) : gu_t + (size_t)n0 * DM + kb * 64; ldk = DM; }
          else { r -= I_GU; const int nb = r / 56, kb = r % 56;
              src = (moe ? INP(22) : INP(18)) + eo + (size_t)(kb * 64) * DM + nb * 64; ldw = DM; q8 = moe ? (FP8_MOE != 0) : (FP8_DDN != 0); qs = q8 ? 64.0f : 1.0f; d = q8 ? (bf16_t*)((unsigned char*)dn_t + (size_t)(nb * 64) * DFF + kb * 64) : dn_t + (size_t)(nb * 64) * DFF + kb * 64; ldk = DFF; } }
        cvt_item(src, ldw, nv, d, ldk, scr, F.lane, q8, qs);
    }
    { const float* pos = INP(2) + (size_t)l * 2 * 2048; float* part = (float*)(F.ws + W_B1);
      for (int it = gw; it < 128; it += NGW) { const int kc = it >> 3, q = it & 7, kv = q >> 2, nb = q & 3; const int n = nb * 64 + F.lane;
          const float* w = cw1 + ((size_t)kv * 2048 + kc * 128) * 256 + n; const float* p = pos + kv * 2048 + kc * 128; float s = 0.f;
#pragma unroll 16
          for (int k = 0; k < 128; ++k) s += p[k] * w[(size_t)k * 256];
          part[kc * 512 + kv * 256 + n] = s; } }
}
__device__ __forceinline__ void phase_bias(Frame& F, int l) {
    if (F.bid == 0) { const float* part = (const float*)(F.ws + W_B1); float s = INP(4)[(size_t)l * 512 + F.tid];
        for (int kc = 0; kc < 16; ++kc) s += part[kc * 512 + F.tid];
        ((float*)(F.ws + W_B1))[16 * 512 + F.tid] = s; }
}
__device__ __forceinline__ void phase_init(Frame& F) {
    const int gw = F.bid * NWAVES + F.wave, NGW = F.G * NWAVES;
    const float* x = INP(0); bf16_t* xb = (bf16_t*)(F.ws + WS_XB);
    for (int m = gw; m < MTOK; m += NGW) {
#pragma unroll
        for (int j = 0; j < 4; ++j) { const f32x4 v = *(const f32x4*)(x + (size_t)m * DM + 4 * F.lane + 256 * j);
            u32x2 w; w.x = cvt_pk_bf16(v[0], v[1]); w.y = cvt_pk_bf16(v[2], v[3]); *(u32x2*)(xb + (size_t)m * DM + 4 * F.lane + 256 * j) = w;
            if (FP8_INPROJ) *(unsigned*)((unsigned char*)F.xf + (size_t)m * DM + 4 * F.lane + 256 * j) = pk4_fp8(v[0], v[1], v[2], v[3]); } }
    float* cs = (float*)(F.ws + WS_COS); float* sn = (float*)(F.ws + WS_SIN);
    const float inv = powf(10000.0f, -(float)(2 * F.lane) / 128.0f);
    for (int t = gw; t < SEQ; t += NGW) { const float ang = (float)t * inv; float s, c; sincosf(ang, &s, &c); cs[(size_t)t * 64 + F.lane] = c; sn[(size_t)t * 64 + F.lane] = s; }
}
template <int MODE>
__device__ __forceinline__ void phase_ln(Frame& F, const float* gam, const float* bet, bool write_xb, int moe_idx, bool dry = false, bool w8 = true) {
    const int gw = F.bid * NWAVES + F.wave, NGW = F.G * NWAVES;
    bf16_t* xb = (bf16_t*)(F.ws + WS_XB);
    f32x4 g4[4], b4[4];
#pragma unroll
    for (int j = 0; j < 4; ++j) { g4[j] = *(const f32x4*)(gam + 4 * F.lane + 256 * j); b4[j] = *(const f32x4*)(bet + 4 * F.lane + 256 * j); }
    volatile LAS unsigned* lcnt = F.MISC + 16;
    if (MODE == 1 && !dry) { if (F.tid < 8) lcnt[F.tid] = 0u; __syncthreads(); }
    const float* wr = (MODE == 1) ? INP(19) + (size_t)moe_idx * DM * NEXP : nullptr;
    u32x4* meta = (u32x4*)(F.ws + WS_META);
    const u32x2* tokslot = (const u32x2*)(F.ws + WS_META + 1 * MiB);
    const bf16_t* dn = (const bf16_t*)(F.ws + R_DN);
    const bf16_t* vbuf = (const bf16_t*)(F.ws + WS_VB);
    auto load_row = [&](int m, f32x4 (&v)[4]) {
        const bf16_t* row = (MODE == 2 ? (const bf16_t*)xb : vbuf) + (size_t)m * DM;
#pragma unroll
        for (int j = 0; j < 4; ++j) { const u32x2 x = *(const u32x2*)(row + 4 * F.lane + 256 * j); v[j] = (MODE == 2) ? (f32x4){bflo(x.x), bfhi(x.x), bflo(x.y), bfhi(x.y)} : (f32x4){hlo(x.x), hhi(x.x), hlo(x.y), hhi(x.y)}; }
        if (MODE == 2) {
            const u32x2 sl = tokslot[m]; const float p1 = __uint_as_float(meta[m].w), p2 = 1.0f - p1;
#pragma unroll
            for (int j = 0; j < 4; ++j) { const u32x2 a = *(const u32x2*)(dn + (size_t)sl.x * DM + 4 * F.lane + 256 * j), b = *(const u32x2*)(dn + (size_t)sl.y * DM + 4 * F.lane + 256 * j);
                v[j][0] = v[j][0] * ALPHA + p1 * hlo(a.x) + p2 * hlo(b.x); v[j][1] = v[j][1] * ALPHA + p1 * hhi(a.x) + p2 * hhi(b.x);
                v[j][2] = v[j][2] * ALPHA + p1 * hlo(a.y) + p2 * hlo(b.y); v[j][3] = v[j][3] * ALPHA + p1 * hhi(a.y) + p2 * hhi(b.y); } } };
    auto finish_row = [&](int m, f32x4 (&v)[4]) {
        float s = 0.f;
#pragma unroll
        for (int j = 0; j < 4; ++j) s += (v[j][0] + v[j][1]) + (v[j][2] + v[j][3]);
        const float mean = wave_sum(s) * (1.f / DM); float s2 = 0.f;
#pragma unroll
        for (int j = 0; j < 4; ++j) { v[j] = v[j] - mean; s2 += (v[j][0] * v[j][0] + v[j][1] * v[j][1]) + (v[j][2] * v[j][2] + v[j][3] * v[j][3]); }
        const float rstd = 1.f / sqrtf(wave_sum(s2) * (1.f / DM) + LN_EPS);
        float* orow = F.xf + (size_t)m * DM; bf16_t* oxb = dry ? (bf16_t*)(F.ws + WS_R + 128 * MiB) : xb;
#pragma unroll
        for (int j = 0; j < 4; ++j) { v[j] = v[j] * rstd * g4[j] + b4[j];
            if (!write_xb) *(f32x4*)(orow + 4 * F.lane + 256 * j) = v[j];
            if (write_xb) { u32x2 w; w.x = cvt_pk_bf16(v[j][0], v[j][1]); w.y = cvt_pk_bf16(v[j][2], v[j][3]); *(u32x2*)(oxb + (size_t)m * DM + 4 * F.lane + 256 * j) = w;
                if (FP8_INPROJ && !dry && w8) *(unsigned*)((unsigned char*)F.xf + (size_t)m * DM + 4 * F.lane + 256 * j) = pk4_fp8(v[j][0], v[j][1], v[j][2], v[j][3]); } }
        if (MODE == 1 && !dry) {
            float lg[8];
#pragma unroll
            for (int e = 0; e < 8; ++e) lg[e] = 0.f;
#pragma unroll
            for (int j = 0; j < 4; ++j)
#pragma unroll
                for (int i = 0; i < 4; ++i) { const float* w = wr + (size_t)(4 * F.lane + 256 * j + i) * 8; const f32x4 w0 = *(const f32x4*)w, w1 = *(const f32x4*)(w + 4); const float xv = v[j][i];
                    lg[0] += xv * w0[0]; lg[1] += xv * w0[1]; lg[2] += xv * w0[2]; lg[3] += xv * w0[3]; lg[4] += xv * w1[0]; lg[5] += xv * w1[1]; lg[6] += xv * w1[2]; lg[7] += xv * w1[3]; }
#pragma unroll
            for (int e = 0; e < 8; ++e) lg[e] = wave_sum(lg[e]);
            int e1 = 0; float v1 = lg[0];
#pragma unroll
            for (int e = 1; e < 8; ++e) if (lg[e] > v1) { v1 = lg[e]; e1 = e; }
            int e2 = -1; float v2 = -3.0e38f;
#pragma unroll
            for (int e = 0; e < 8; ++e) if (e != e1 && lg[e] > v2) { v2 = lg[e]; e2 = e; }
            const float p1 = 1.0f / (1.0f + __expf(v2 - v1));
            if (F.lane == 0) { const unsigned r1 = __hip_atomic_fetch_add((LAS unsigned*)(lcnt + e1), 1u, __ATOMIC_RELAXED, __HIP_MEMORY_SCOPE_WORKGROUP);
                const unsigned r2 = __hip_atomic_fetch_add((LAS unsigned*)(lcnt + e2), 1u, __ATOMIC_RELAXED, __HIP_MEMORY_SCOPE_WORKGROUP);
                meta[m] = (u32x4){(unsigned)e1 | ((unsigned)e2 << 4) | ((unsigned)F.bid << 8), r1, r2, __float_as_uint(p1)}; }
        } };
    for (int m = gw; m < MTOK; m += 2 * NGW) {
        f32x4 va[4], vb[4];
        load_row(m, va); load_row(m + NGW, vb);
        finish_row(m, va); finish_row(m + NGW, vb);
    }
    if (MODE == 1 && !dry) {
        __syncthreads();
        if (F.tid < 8) { const unsigned base = __hip_atomic_fetch_add(F.ctl + CW_MOE + moe_idx * 1024 + F.tid * 64, lcnt[F.tid], __ATOMIC_RELAXED, __HIP_MEMORY_SCOPE_AGENT);
            ((unsigned*)(F.ws + WS_META + 2 * MiB))[F.bid * 8 + F.tid] = base; }
    }
}
__device__ __forceinline__ void moe_table(Frame& F, int moe_idx) {
    volatile LAS int* tab = (volatile LAS int*)(F.MISC + 32);
    if (F.tid == 0) { int acc = 0;
        for (int e = 0; e < 8; ++e) { const unsigned c = __hip_atomic_load(F.ctl + CW_MOE + moe_idx * 1024 + e * 64, __ATOMIC_RELAXED, __HIP_MEMORY_SCOPE_AGENT); tab[e] = acc; F.MISC[48 + e] = c; acc += (int)((c + 255u) >> 8); }
        tab[8] = acc; }
    __syncthreads();
}
__device__ __forceinline__ void phase_moe_permute(Frame& F, int moe_idx) {
    moe_table(F, moe_idx);
    volatile LAS int* tab = (volatile LAS int*)(F.MISC + 32);
    const int gw = F.bid * NWAVES + F.wave, NGW = F.G * NWAVES;
    const u32x4* meta = (const u32x4*)(F.ws + WS_META); u32x2* tokslot = (u32x2*)(F.ws + WS_META + 1 * MiB);
    const unsigned* wgbase = (const unsigned*)(F.ws + WS_META + 2 * MiB);
    const bf16_t* xb = (const bf16_t*)(F.ws + WS_XB); bf16_t* ap = (bf16_t*)(F.ws + R_APERM);
    for (int m = gw; m < MTOK; m += NGW) {
        const u32x4 mt = meta[m]; const int e1 = mt.x & 15, e2 = (mt.x >> 4) & 15, wg = mt.x >> 8;
        const unsigned s1 = (unsigned)tab[e1] * 256u + wgbase[wg * 8 + e1] + mt.y, s2 = (unsigned)tab[e2] * 256u + wgbase[wg * 8 + e2] + mt.z;
        if (FP8_MOE) { const u32x4 a = *(const u32x4*)((const unsigned char*)F.xf + (size_t)m * DM + 16 * F.lane);
            *(u32x4*)((unsigned char*)ap + (size_t)s1 * DM + 16 * F.lane) = a; *(u32x4*)((unsigned char*)ap + (size_t)s2 * DM + 16 * F.lane) = a; }
        else {
        const u32x4 a = *(const u32x4*)(xb + (size_t)m * DM + 8 * F.lane), b = *(const u32x4*)(xb + (size_t)m * DM + 512 + 8 * F.lane);
        *(u32x4*)(ap + (size_t)s1 * DM + 8 * F.lane) = a; *(u32x4*)(ap + (size_t)s1 * DM + 512 + 8 * F.lane) = b;
        *(u32x4*)(ap + (size_t)s2 * DM + 8 * F.lane) = a; *(u32x4*)(ap + (size_t)s2 * DM + 512 + 8 * F.lane) = b; }
        if (F.lane == 0) tokslot[m] = (u32x2){s1, s2};
    }
    unsigned z0 = 0u; asm volatile("" : "+v"(z0)); const u32x4 z4 = (u32x4){z0, z0, z0, z0};
    for (int it = gw; it < 8 * 256; it += NGW) {
        const int e = it >> 8, k = it & 255; const int cnt = (int)F.MISC[48 + e]; const int mt = (cnt + 255) >> 8; const int r = cnt + k;
        if (r < mt * 256) { if (FP8_MOE) *(u32x4*)((unsigned char*)ap + ((size_t)tab[e] * 256 + r) * DM + 16 * F.lane) = z4;
                            else { bf16_t* p = ap + ((size_t)tab[e] * 256 + r) * DM; *(u32x4*)(p + 8 * F.lane) = z4; *(u32x4*)(p + 512 + 8 * F.lane) = z4; } }
    }
}

#ifndef NSA_WIN
#define NSA_WIN 1
#endif
#ifndef NSA_CMP
#define NSA_CMP 1
#endif
#ifndef NSA_SLC
#define NSA_SLC 1
#endif
#define MFMA16(a, b, c) __builtin_amdgcn_mfma_f32_16x16x32_bf16(a, b, c, 0, 0, 0)
__device__ __forceinline__ bf16x8 ld16(const bf16_t* p) { return *(const bf16x8*)p; }
__device__ __forceinline__ bf16x8 pack8(const f32x4& a, const f32x4& b) {
    u32x4 w; w.x = cvt_pk_bf16(a[0], a[1]); w.y = cvt_pk_bf16(a[2], a[3]); w.z = cvt_pk_bf16(b[0], b[1]); w.w = cvt_pk_bf16(b[2], b[3]);
    return __builtin_bit_cast(bf16x8, w);
}
__device__ __forceinline__ float gq_max(float v) { auto a = __builtin_amdgcn_permlane16_swap(__float_as_uint(v), __float_as_uint(v), false, false); v = fmaxf(__uint_as_float(a[0]), __uint_as_float(a[1]));
    auto b = __builtin_amdgcn_permlane32_swap(__float_as_uint(v), __float_as_uint(v), false, false); return fmaxf(__uint_as_float(b[0]), __uint_as_float(b[1])); }
__device__ __forceinline__ float gq_sum(float v) { auto a = __builtin_amdgcn_permlane16_swap(__float_as_uint(v), __float_as_uint(v), false, false); v = __uint_as_float(a[0]) + __uint_as_float(a[1]);
    auto b = __builtin_amdgcn_permlane32_swap(__float_as_uint(v), __float_as_uint(v), false, false); return __uint_as_float(b[0]) + __uint_as_float(b[1]); }

__device__ __forceinline__ float ror_f(float v, int n) { return n == 4 ? __int_as_float(__builtin_amdgcn_update_dpp(0, __float_as_int(v), 0x124, 0xf, 0xf, false)) : __int_as_float(__builtin_amdgcn_update_dpp(0, __float_as_int(v), 0x128, 0xf, 0xf, false)); }
__device__ __forceinline__ float cg_max(float v) { v = fmaxf(v, ror_f(v, 4)); return fmaxf(v, ror_f(v, 8)); }
__device__ __forceinline__ float cg_sum(float v) { v += ror_f(v, 4); return v + ror_f(v, 8); }
__device__ __forceinline__ float quad_sum(float v) { v += __int_as_float(__builtin_amdgcn_update_dpp(0, __float_as_int(v), 0xB1, 0xf, 0xf, false)); return v + __int_as_float(__builtin_amdgcn_update_dpp(0, __float_as_int(v), 0x4E, 0xf, 0xf, false)); }
__device__ __forceinline__ void phase_conv(Frame& F, int l) {
    const bf16_t* cv = (const bf16_t*)(F.ws + R_CONV); bf16_t* ys = (bf16_t*)(F.ws + R_YS);
    const float* w = INP(7) + (size_t)l * 3 * 512;
    const int c0 = 8 * F.lane;
    float w0[8], w1[8], w2[8];
#pragma unroll
    for (int j = 0; j < 8; ++j) { w0[j] = w[c0 + j]; w1[j] = w[512 + c0 + j]; w2[j] = w[1024 + c0 + j]; }
    const int gw = F.bid * NWAVES + F.wave, NGW = F.G * NWAVES;
    for (int r = gw; r < MTOK / 16; r += NGW) {
        const int m0 = r * 16; const int t0 = m0 & (SEQ - 1);
        float um2[8], um1[8];
#pragma unroll
        for (int j = 0; j < 8; ++j) { um2[j] = 0.f; um1[j] = 0.f; }
        if (t0 >= 2) {
            const u32x4 a2 = *(const u32x4*)(cv + (size_t)(m0 - 2) * 1024 + 512 + c0), a1 = *(const u32x4*)(cv + (size_t)(m0 - 1) * 1024 + 512 + c0);
#pragma unroll
            for (int q = 0; q < 4; ++q) { um2[2 * q] = bflo(a2[q]); um2[2 * q + 1] = bfhi(a2[q]); um1[2 * q] = bflo(a1[q]); um1[2 * q + 1] = bfhi(a1[q]); }
        }
        for (int i = 0; i < 16; ++i) {
            const size_t m = (size_t)(m0 + i);
            const u32x4 bq = *(const u32x4*)(cv + m * 1024 + c0), a = *(const u32x4*)(cv + m * 1024 + 512 + c0);
            float u[8], y[8];
#pragma unroll
            for (int q = 0; q < 4; ++q) { u[2 * q] = bflo(a[q]); u[2 * q + 1] = bfhi(a[q]); }
#pragma unroll
            for (int q = 0; q < 4; ++q) { y[2 * q] = bflo(bq[q]) * (w0[2 * q] * um2[2 * q] + w1[2 * q] * um1[2 * q] + w2[2 * q] * u[2 * q]);
                                          y[2 * q + 1] = bfhi(bq[q]) * (w0[2 * q + 1] * um2[2 * q + 1] + w1[2 * q + 1] * um1[2 * q + 1] + w2[2 * q + 1] * u[2 * q + 1]); }
            if (FP8_MRG) { u32x2 o8; o8.x = pk4_fp8(y[0] * YS_SC, y[1] * YS_SC, y[2] * YS_SC, y[3] * YS_SC); o8.y = pk4_fp8(y[4] * YS_SC, y[5] * YS_SC, y[6] * YS_SC, y[7] * YS_SC);
                *(u32x2*)((unsigned char*)ys + m * YS8_LD + YS8_OFF + 512 + c0) = o8; }
            else { u32x4 o; o.x = cvt_pk_bf16(y[0], y[1]); o.y = cvt_pk_bf16(y[2], y[3]); o.z = cvt_pk_bf16(y[4], y[5]); o.w = cvt_pk_bf16(y[6], y[7]);
            *(u32x4*)(ys + m * 1536 + 512 + c0) = o; }
#pragma unroll
            for (int j = 0; j < 8; ++j) { um2[j] = um1[j]; um1[j] = u[j]; }
        }
    }
}

typedef short v4i16_t __attribute__((ext_vector_type(4)));
__device__ __forceinline__ bf16x4 lds_tr(const LAS unsigned char* p) { return __builtin_bit_cast(bf16x4, __builtin_amdgcn_ds_read_tr16_b64_v4i16((LAS v4i16_t*)p)); }
__device__ __forceinline__ bf16x8 cat8(bf16x4 a, bf16x4 b) { return __builtin_shufflevector(a, b, 0, 1, 2, 3, 4, 5, 6, 7); }
constexpr int RET_STR = 272;
__device__ __forceinline__ void phase_ret_kv(Frame& F) {
    const bf16_t* RK = (const bf16_t*)(F.ws + R_RK); const bf16_t* RV = (const bf16_t*)(F.ws + R_VTR); bf16_t* KVT = (bf16_t*)(F.ws + R_KVT);
    const int i16 = F.lane & 15, gq = F.lane >> 4, w = F.wave;
    LAS unsigned char* Kl = F.lds; LAS unsigned char* Vl = F.lds + 128 * RET_STR;
    for (int it = F.bid; it < 1024; it += F.G) {
        const int bh = it >> 7, ch = it & 127, b = bh >> 2, h = bh & 3;
        const float l2g = __builtin_log2f(1.0f - __builtin_exp2f(-5.0f - (float)h));
        const size_t row0 = (size_t)b * SEQ + ch * 128;
        __syncthreads();
#pragma unroll
        for (int p = 0; p < 4; ++p) { const int idx = p * NTHREADS + F.tid, t = idx >> 4, c = idx & 15;
            const u32x4 kq = *(const u32x4*)(RK + (row0 + t) * 512 + h * 128 + c * 8), vq = *(const u32x4*)(RV + (row0 + t) * 512 + h * 128 + c * 8);
            const float kd = __builtin_exp2f(l2g * (float)(127 - t));
            u32x4 ks; ks.x = cvt_pk_bf16(bflo(kq.x) * kd, bfhi(kq.x) * kd); ks.y = cvt_pk_bf16(bflo(kq.y) * kd, bfhi(kq.y) * kd); ks.z = cvt_pk_bf16(bflo(kq.z) * kd, bfhi(kq.z) * kd); ks.w = cvt_pk_bf16(bflo(kq.w) * kd, bfhi(kq.w) * kd);
            *(LAS u32x4*)(Kl + t * RET_STR + c * 16) = ks; *(LAS u32x4*)(Vl + t * RET_STR + c * 16) = vq; }
        __syncthreads();
        const int roff = (gq * 8 + (i16 >> 2)) * RET_STR + (i16 & 3) * 8;
        bf16x8 yf[4];
#pragma unroll
        for (int ks = 0; ks < 4; ++ks) { const LAS unsigned char* p = Vl + ks * 32 * RET_STR + roff + w * 32; yf[ks] = cat8(lds_tr(p), lds_tr(p + 4 * RET_STR)); }
        bf16_t* out = KVT + (size_t)it * 16384;
#pragma unroll
        for (int dt = 0; dt < 8; ++dt) {
            f32x4 acc = (f32x4){0.f, 0.f, 0.f, 0.f};
#pragma unroll
            for (int ks = 0; ks < 4; ++ks) { const LAS unsigned char* p = Kl + ks * 32 * RET_STR + roff + dt * 32; acc = MFMA16(cat8(lds_tr(p), lds_tr(p + 4 * RET_STR)), yf[ks], acc); }
            { u32x2 wv; wv.x = cvt_pk_bf16(acc[0], acc[1]); wv.y = cvt_pk_bf16(acc[2], acc[3]); *(u32x2*)(out + (w * 16 + i16) * 128 + dt * 16 + gq * 4) = wv; }
        }
    }
    __syncthreads();
}
__device__ __forceinline__ void phase_ret_scan(Frame& F) {
    const bf16_t* KVT = (const bf16_t*)(F.ws + R_KVT); bf16_t* ST = (bf16_t*)(F.ws + R_ST);
    for (int idx = F.bid * NTHREADS + F.tid; idx < 8 * 16384; idx += F.G * NTHREADS) {
        const int bh = idx >> 14, ed = idx & 16383, h = bh & 3;
        const float cd = __builtin_exp2f(128.0f * __builtin_log2f(1.0f - __builtin_exp2f(-5.0f - (float)h)));
        const bf16_t* src = KVT + (size_t)bh * 128 * 16384 + ed; bf16_t* dst = ST + (size_t)bh * 128 * 16384 + ed;
        float s = 0.f;
#pragma unroll 64
        for (int i = 0; i < 128; ++i) { dst[(size_t)i * 16384] = f2bf(s); s = s * cd + bf2f(src[(size_t)i * 16384]); }
    }
}
__device__ __forceinline__ void phase_ret_out(Frame& F, int l) {
    const bf16_t* RQ = (const bf16_t*)(F.ws + R_RQ); const bf16_t* RK = (const bf16_t*)(F.ws + R_RK); const bf16_t* RV = (const bf16_t*)(F.ws + R_VTR);
    const bf16_t* ST = (const bf16_t*)(F.ws + R_ST); const bf16_t* RG = (const bf16_t*)(F.ws + R_RG); bf16_t* ys = (bf16_t*)(F.ws + R_YS);
    const float* gng = INP(8) + (size_t)l * 512; const float* gnb = INP(9) + (size_t)l * 512;
    const int i16 = F.lane & 15, gq = F.lane >> 4, w = F.wave;
    LAS unsigned char* Vl = F.lds; LAS unsigned char* Sl = F.lds + 128 * RET_STR; LAS unsigned char* Kl = F.lds + 256 * RET_STR;
    for (int it = F.bid; it < 1024; it += F.G) {
        const int bh = it >> 7, ch = it & 127, b = bh >> 2, h = bh & 3;
        const float l2g = __builtin_log2f(1.0f - __builtin_exp2f(-5.0f - (float)h));
        const size_t row0 = (size_t)b * SEQ + ch * 128;
        const int tl = w * 16 + i16;
        __syncthreads();
#pragma unroll
        for (int p = 0; p < 4; ++p) { const int idx = p * NTHREADS + F.tid, t = idx >> 4, c = idx & 15;
            *(LAS u32x4*)(Vl + t * RET_STR + c * 16) = *(const u32x4*)(RV + (row0 + t) * 512 + h * 128 + c * 8);
            *(LAS u32x4*)(Sl + t * RET_STR + c * 16) = *(const u32x4*)(ST + (size_t)it * 16384 + t * 128 + c * 8);
            *(LAS u32x4*)(Kl + t * RET_STR + c * 16) = *(const u32x4*)(RK + (row0 + t) * 512 + h * 128 + c * 8); }
        bf16x8 qf[4];
#pragma unroll
        for (int ks = 0; ks < 4; ++ks) qf[ks] = ld16(RQ + (row0 + tl) * 512 + h * 128 + ks * 32 + gq * 8);
        f32x4 o[8];
        __syncthreads();
#pragma unroll
        for (int et = 0; et < 8; ++et) { f32x4 acc = (f32x4){0.f, 0.f, 0.f, 0.f};
#pragma unroll
            for (int ks = 0; ks < 4; ++ks) acc = MFMA16(*(const LAS bf16x8*)(Sl + (et * 16 + i16) * RET_STR + ks * 64 + gq * 16), qf[ks], acc);
            o[et] = acc; }
        const float qd = __builtin_exp2f(l2g * (float)(tl + 1));
#pragma unroll
        for (int et = 0; et < 8; ++et) o[et] = o[et] * qd;
        const int roff = (gq * 4 + (i16 >> 2)) * RET_STR + (i16 & 3) * 8;
        for (int ss = 0; ss <= (w >> 1); ++ss) {
            f32x4 s0 = (f32x4){0.f, 0.f, 0.f, 0.f}, s1 = s0;
#pragma unroll
            for (int ks = 0; ks < 4; ++ks) { s0 = MFMA16(*(const LAS bf16x8*)(Kl + (ss * 32 + i16) * RET_STR + ks * 64 + gq * 16), qf[ks], s0);
                                             s1 = MFMA16(*(const LAS bf16x8*)(Kl + (ss * 32 + 16 + i16) * RET_STR + ks * 64 + gq * 16), qf[ks], s1); }
#pragma unroll
            for (int r = 0; r < 4; ++r) { const int sl0 = ss * 32 + gq * 4 + r, sl1 = sl0 + 16;
                s0[r] = (tl >= sl0) ? s0[r] * __builtin_exp2f(l2g * (float)(tl - sl0)) : 0.f;
                s1[r] = (tl >= sl1) ? s1[r] * __builtin_exp2f(l2g * (float)(tl - sl1)) : 0.f; }
            const bf16x8 pb = pack8(s0, s1);
#pragma unroll
            for (int et = 0; et < 8; ++et) { const LAS unsigned char* p = Vl + ss * 32 * RET_STR + roff + et * 32; o[et] = MFMA16(cat8(lds_tr(p), lds_tr(p + 16 * RET_STR)), pb, o[et]); }
        }
        float s = 0.f;
#pragma unroll
        for (int et = 0; et < 8; ++et) s += (o[et][0] + o[et][1]) + (o[et][2] + o[et][3]);
        const float mean = gq_sum(s) * (1.0f / 128.0f); float q = 0.f;
#pragma unroll
        for (int et = 0; et < 8; ++et) { o[et] = o[et] - mean; q += (o[et][0] * o[et][0] + o[et][1] * o[et][1]) + (o[et][2] * o[et][2] + o[et][3] * o[et][3]); }
        const float rstd = 1.0f / sqrtf(gq_sum(q) * (1.0f / 128.0f) + LN_EPS);
#pragma unroll
        for (int et = 0; et < 8; ++et) { const int e = et * 16 + gq * 4;
            const f32x4 g4 = *(const f32x4*)(gng + h * 128 + e), b4 = *(const f32x4*)(gnb + h * 128 + e);
            const u32x2 rg = *(const u32x2*)(RG + (row0 + tl) * 512 + h * 128 + e);
            const float y0 = (o[et][0] * rstd * g4[0] + b4[0]) * bflo(rg.x), y1 = (o[et][1] * rstd * g4[1] + b4[1]) * bfhi(rg.x);
            const float y2 = (o[et][2] * rstd * g4[2] + b4[2]) * bflo(rg.y), y3 = (o[et][3] * rstd * g4[3] + b4[3]) * bfhi(rg.y);
            if (FP8_MRG) *(unsigned*)((unsigned char*)ys + (row0 + tl) * YS8_LD + YS8_OFF + 1024 + h * 128 + e) = pk4_fp8(y0 * YS_SC, y1 * YS_SC, y2 * YS_SC, y3 * YS_SC);
            else { u32x2 wv; wv.x = cvt_pk_bf16(y0, y1); wv.y = cvt_pk_bf16(y2, y3);
            *(u32x2*)(ys + (row0 + tl) * 1536 + 1024 + h * 128 + e) = wv; } }
    }
    __syncthreads();
}

__device__ __forceinline__ void phase_cmp2(Frame& F, int l) {
    const bf16_t* HID = (const bf16_t*)(F.ws + R_HIDC); const bf16_t* W2 = (const bf16_t*)(F.ws + W_C2);
    bf16_t* KC = (bf16_t*)(F.ws + R_KC); bf16_t* VCT = (bf16_t*)(F.ws + R_VCT);
    const float* b2 = INP(6) + (size_t)l * 128;
    const int i16 = F.lane & 15, gq = F.lane >> 4;
    const int gw = F.bid * NWAVES + F.wave, NGW = F.G * NWAVES;
    for (int it = gw; it < 512; it += NGW) {
        const int kv = it >> 8, rt = it & 255; const bf16_t* hid = HID + ((size_t)kv * 4096 + rt * 16) * 256; const bf16_t* w2 = W2 + (size_t)kv * 64 * 256;
        bf16x8 hf[8];
#pragma unroll
        for (int ks = 0; ks < 8; ++ks) hf[ks] = ld16(hid + i16 * 256 + ks * 32 + gq * 8);
#pragma unroll
        for (int dt = 0; dt < 4; ++dt) {
            f32x4 acc = (f32x4){0.f, 0.f, 0.f, 0.f};
            if (kv == 0) {
#pragma unroll
                for (int ks = 0; ks < 8; ++ks) acc = MFMA16(ld16(w2 + (dt * 16 + i16) * 256 + ks * 32 + gq * 8), hf[ks], acc);
                const int n = rt * 16 + i16, dd = dt * 16 + gq * 4; const f32x4 bb = *(const f32x4*)(b2 + dd);
                const bool z = (n & 1023) == 1023;
                u32x2 wv; wv.x = z ? 0u : cvt_pk_bf16(acc[0] + bb[0], acc[1] + bb[1]); wv.y = z ? 0u : cvt_pk_bf16(acc[2] + bb[2], acc[3] + bb[3]);
                *(u32x2*)(KC + (size_t)n * 64 + dd) = wv;
            } else {
#pragma unroll
                for (int ks = 0; ks < 8; ++ks) acc = MFMA16(hf[ks], ld16(w2 + (dt * 16 + i16) * 256 + ks * 32 + gq * 8), acc);
                const int n0 = rt * 16 + gq * 4, dd = dt * 16 + i16; const float bb = b2[64 + dd];
                float v[4];
#pragma unroll
                for (int r = 0; r < 4; ++r) v[r] = (((n0 + r) & 1023) == 1023) ? 0.f : acc[r] + bb;
                u32x2 wv; wv.x = cvt_pk_bf16(v[0], v[1]); wv.y = cvt_pk_bf16(v[2], v[3]);
                *(u32x2*)(VCT + ((size_t)(n0 >> 6) * 64 + dd) * 64 + (n0 & 63)) = wv;
            }
        }
    }
}

struct KVFrag { bf16x8 k[4]; bf16x8 v[4]; };
__device__ __forceinline__ unsigned k_lane_off(int lane) { const int i16 = lane & 15, gq = lane >> 4, kr = (i16 >> 2) * 8 + (i16 & 3); return (unsigned)(kr * 64 + gq * 8); }
__device__ __forceinline__ unsigned v_lane_off(int lane) { const int i16 = lane & 15, gq = lane >> 4; return (unsigned)(i16 * 64 + gq * 8); }
__device__ __forceinline__ const bf16_t* uni_ptr(const bf16_t* p) { const unsigned long long v = (unsigned long long)p; const unsigned lo = __builtin_amdgcn_readfirstlane((unsigned)v), hi = __builtin_amdgcn_readfirstlane((unsigned)(v >> 32));
    return (const bf16_t*)(const GAS bf16_t*)(((unsigned long long)hi << 32) | lo); }
__device__ __forceinline__ void kf4(bf16x8 (&k)[4], const bf16_t* kp_, unsigned ko) { const bf16_t* kp = uni_ptr(kp_); k[0] = ld16(kp + ko); k[1] = ld16(kp + ko + 32u); k[2] = ld16(kp + ko + 256u); k[3] = ld16(kp + ko + 288u); }
__device__ __forceinline__ void vf4(bf16x8 (&v)[4], const bf16_t* vtp_, unsigned vo) { const bf16_t* vtp = uni_ptr(vtp_); v[0] = ld16(vtp + vo); v[1] = ld16(vtp + vo + 1024u); v[2] = ld16(vtp + vo + 2048u); v[3] = ld16(vtp + vo + 3072u); }
__device__ __forceinline__ void kv_load(KVFrag& f, const bf16_t* kp, const bf16_t* vtp, int lane) { kf4(f.k, kp, k_lane_off(lane)); vf4(f.v, vtp, v_lane_off(lane)); }
__device__ __forceinline__ void k_load(KVFrag& f, const bf16_t* kp, int lane) { kf4(f.k, kp, k_lane_off(lane)); }
__device__ __forceinline__ void qk_tile(const KVFrag& f, const bf16x8 (&q)[2], f32x4& s0, f32x4& s1) {
    s0 = (f32x4){0.f, 0.f, 0.f, 0.f}; s1 = s0;
    s0 = MFMA16(f.k[0], q[0], s0); s0 = MFMA16(f.k[1], q[1], s0); s1 = MFMA16(f.k[2], q[0], s1); s1 = MFMA16(f.k[3], q[1], s1);
}
template <class MaskF>
__device__ __forceinline__ void attn_tile(const KVFrag& f, const bf16x8 (&q)[2], f32x4 (&o)[4], float& m, float& l, int kbase, int tq, MaskF mask, int gq) {
    f32x4 s0, s1; qk_tile(f, q, s0, s1);
    float mx = -INFINITY;
#pragma unroll
    for (int r = 0; r < 4; ++r) { const int kp0 = kbase + gq * 8 + r;
        s0[r] = mask(kp0, tq) ? s0[r] : -INFINITY; s1[r] = mask(kp0 + 4, tq) ? s1[r] : -INFINITY; mx = fmaxf(mx, fmaxf(s0[r], s1[r])); }
    mx = gq_max(mx);
    const float mnew = fmaxf(m, mx), alpha = fast_exp2(m - mnew);
    float rs = 0.f;
#pragma unroll
    for (int r = 0; r < 4; ++r) { s0[r] = fast_exp2(s0[r] - mnew); s1[r] = fast_exp2(s1[r] - mnew); rs += s0[r] + s1[r]; }
    rs = gq_sum(rs);
    l = l * alpha + rs; m = mnew;
    const bf16x8 pb = pack8(s0, s1);
#pragma unroll
    for (int dt = 0; dt < 4; ++dt) { o[dt] = o[dt] * alpha; o[dt] = MFMA16(f.v[dt], pb, o[dt]); }
}
struct KFrag { bf16x8 k[4]; };
struct VFrag { bf16x8 v[4]; };
__device__ __forceinline__ void kf_load(KFrag& f, const bf16_t* kp, int lane) { kf4(f.k, kp, k_lane_off(lane)); }
__device__ __forceinline__ void vf_load(VFrag& f, const bf16_t* vtp, int lane) { vf4(f.v, vtp, v_lane_off(lane)); }
template <class MaskF>
__device__ __forceinline__ void attn_qks(const KFrag& f, const bf16x8 (&q)[2], float& m, float& l, int kbase, int tq, MaskF mask, int gq, bf16x8& pb, float& alpha, bool domask = true) {
    f32x4 s0 = (f32x4){0.f, 0.f, 0.f, 0.f}, s1 = s0;
    s0 = MFMA16(f.k[0], q[0], s0); s0 = MFMA16(f.k[1], q[1], s0); s1 = MFMA16(f.k[2], q[0], s1); s1 = MFMA16(f.k[3], q[1], s1);
    if (domask) {
#pragma unroll
        for (int r = 0; r < 4; ++r) { const int kp0 = kbase + gq * 8 + r; s0[r] = mask(kp0, tq) ? s0[r] : -INFINITY; s1[r] = mask(kp0 + 4, tq) ? s1[r] : -INFINITY; } }
    float mx = fmaxf(fmaxf(fmaxf(s0[0], s0[1]), fmaxf(s0[2], s0[3])), fmaxf(fmaxf(s1[0], s1[1]), fmaxf(s1[2], s1[3])));
    mx = gq_max(mx);
    const float mnew = fmaxf(m, mx); alpha = fast_exp2(m - mnew);
    float rs = 0.f;
#pragma unroll
    for (int r = 0; r < 4; ++r) { s0[r] = fast_exp2(s0[r] - mnew); s1[r] = fast_exp2(s1[r] - mnew); rs += s0[r] + s1[r]; }
    rs = gq_sum(rs);
    l = l * alpha + rs; m = mnew;
    pb = pack8(s0, s1);
}
__device__ __forceinline__ void attn_pv(const VFrag& f, const bf16x8& pb, float alpha, f32x4 (&o)[4]) {
#pragma unroll
    for (int dt = 0; dt < 4; ++dt) { o[dt] = o[dt] * alpha; o[dt] = MFMA16(f.v[dt], pb, o[dt]); }
}
template <bool ACCUM, bool F8OUT = false>
__device__ __forceinline__ void attn_store(bf16_t* ys, const bf16_t* ng, size_t row, int hh, int gi, const f32x4 (&o)[4], float l, int gq) {
    asm volatile("" : "+v"(hh), "+v"(gq));
    const float g = bf2f(ng[row * 32 + hh * 3 + gi]) / fmaxf(l, 1e-30f);
#pragma unroll
    for (int dt = 0; dt < 4; ++dt) { bf16_t* p = ys + row * 1536 + hh * 64 + dt * 16 + gq * 4;
        float a0 = 0.f, a1 = 0.f, a2 = 0.f, a3 = 0.f;
        if (ACCUM) { const u32x2 old = *(const u32x2*)p; a0 = bflo(old.x); a1 = bfhi(old.x); a2 = bflo(old.y); a3 = bfhi(old.y); }
        if (F8OUT) *(unsigned*)((unsigned char*)ys + row * YS8_LD + YS8_OFF + hh * 64 + dt * 16 + gq * 4) = pk4_fp8((a0 + g * o[dt][0]) * YS_SC, (a1 + g * o[dt][1]) * YS_SC, (a2 + g * o[dt][2]) * YS_SC, (a3 + g * o[dt][3]) * YS_SC);
        else { u32x2 wv; wv.x = cvt_pk_bf16(a0 + g * o[dt][0], a1 + g * o[dt][1]); wv.y = cvt_pk_bf16(a2 + g * o[dt][2], a3 + g * o[dt][3]);
        *(u32x2*)p = wv; } }
}

__device__ __forceinline__ void attn_store_final(bf16_t* ys, const bf16_t* ng, size_t row, int hh, const f32x4 (&o)[4], float l, int gq, const LAS unsigned char* st) {
    asm volatile("" : "+v"(hh), "+v"(gq));
    const float g = bf2f(ng[row * 32 + hh * 3 + 1]) / fmaxf(l, 1e-30f);
#pragma unroll
    for (int dt = 0; dt < 4; ++dt) { bf16_t* p = ys + row * 1536 + hh * 64 + dt * 16 + gq * 4;
        const u32x2 old = *(const u32x2*)p, cs = *(const LAS u32x2*)(st + (dt * 16 + gq * 4) * 2);
        const float a0 = bflo(old.x) + bflo(cs.x) + g * o[dt][0], a1 = bfhi(old.x) + bfhi(cs.x) + g * o[dt][1], a2 = bflo(old.y) + bflo(cs.y) + g * o[dt][2], a3 = bfhi(old.y) + bfhi(cs.y) + g * o[dt][3];
        if (FP8_MRG) *(unsigned*)((unsigned char*)ys + row * YS8_LD + YS8_OFF + hh * 64 + dt * 16 + gq * 4) = pk4_fp8(a0 * YS_SC, a1 * YS_SC, a2 * YS_SC, a3 * YS_SC);
        else { u32x2 wv; wv.x = cvt_pk_bf16(a0, a1); wv.y = cvt_pk_bf16(a2, a3); *(u32x2*)p = wv; } }
}

__device__ __forceinline__ void phase_nsa_window(Frame& F, bool dry = false) {
    const bf16_t* Q = (const bf16_t*)(F.ws + R_Q); const bf16_t* NG = (const bf16_t*)(F.ws + R_NG); bf16_t* ys = (bf16_t*)(F.ws + R_YS);
    const int lane = F.lane, i16 = lane & 15, gq = lane >> 4, w = F.wave;
    if (F.bid < 32) return;
    for (int u = F.bid - 32; u < 512; u += F.G - 32) {
        const int bg = u >> 7, qb = u & 127, b = bg >> 1, g = bg & 1, q0 = qb * 128;
        const bf16_t* K = (const bf16_t*)(F.ws + R_KNAT) + (size_t)(4 + bg) * SEQ * 64;
        const bf16_t* VT = (const bf16_t*)(F.ws + R_VT) + (size_t)(4 + bg) * SEQ * 64;
        int tq[4]; bf16x8 qf[4][2]; const int hh = g * 4 + (i16 & 3);
#pragma unroll
        for (int nt = 0; nt < 4; ++nt) { tq[nt] = q0 + w * 16 + nt * 4 + (i16 >> 2);
#pragma unroll
            for (int ks = 0; ks < 2; ++ks) qf[nt][ks] = ld16(uni_ptr(Q + ((size_t)b * SEQ + q0 + w * 16 + nt * 4) * 512) + (unsigned)((i16 >> 2) * 512 + hh * 64 + ks * 32 + gq * 8)); }
        f32x4 o[4][4]; float m[4], l[4];
#pragma unroll
        for (int nt = 0; nt < 4; ++nt) { m[nt] = -1e30f; l[nt] = 0.f;
#pragma unroll
            for (int dt = 0; dt < 4; ++dt) o[nt][dt] = (f32x4){0.f, 0.f, 0.f, 0.f}; }
        const int tlo = q0 + w * 16; int klo = tlo - 511; if (klo < 0) klo = 0; klo &= ~31; const int khi = tlo + 16;
        auto msk = [](int kp, int t) { return kp <= t && kp > t - 512; };
        KFrag fa, fb; VFrag vf;
        kf_load(fa, K + (size_t)klo * 64, lane);
        for (int kb = klo; kb < khi; kb += 64) {
            const int k1 = kb + 32, k2 = kb + 64;
            vf_load(vf, VT + (size_t)(kb >> 6) * 4096 + (kb & 63), lane);
            if (k1 < khi) kf_load(fb, K + (size_t)k1 * 64, lane);
            { bf16x8 pb[4]; float al[4];
#pragma unroll
              for (int nt = 0; nt < 4; ++nt) attn_qks(fa, qf[nt], m[nt], l[nt], kb, tq[nt], msk, gq, pb[nt], al[nt], kb + 31 > tlo || kb <= tlo + 15 - 512);
#pragma unroll
              for (int nt = 0; nt < 4; ++nt) attn_pv(vf, pb[nt], al[nt], o[nt]); }
            if (k1 < khi) {
                vf_load(vf, VT + (size_t)(k1 >> 6) * 4096 + (k1 & 63), lane);
                if (k2 < khi) kf_load(fa, K + (size_t)k2 * 64, lane);
                bf16x8 pb[4]; float al[4];
#pragma unroll
                for (int nt = 0; nt < 4; ++nt) attn_qks(fb, qf[nt], m[nt], l[nt], k1, tq[nt], msk, gq, pb[nt], al[nt], k1 + 31 > tlo || k1 <= tlo + 15 - 512);
#pragma unroll
                for (int nt = 0; nt < 4; ++nt) attn_pv(vf, pb[nt], al[nt], o[nt]);
            }
        }
#pragma unroll
        for (int nt = 0; nt < 4; ++nt) { if (!NSA_WIN) { for (int dt = 0; dt < 4; ++dt) o[nt][dt] = (f32x4){0.f, 0.f, 0.f, 0.f}; } if (!dry) attn_store<false>(ys, NG, (size_t)b * SEQ + tq[nt], hh, 2, o[nt], l[nt], gq); else if (l[nt] == 12345.f) ys[0] = 0; }
    }
}

constexpr int SC_STRIDE = 260;
__device__ __forceinline__ void phase_nsa_cmp_slc(Frame& F, int dry = 0) {
    const bf16_t* Q = (const bf16_t*)(F.ws + R_Q); const bf16_t* NG = (const bf16_t*)(F.ws + R_NG); bf16_t* ys = (bf16_t*)(F.ws + R_YS);
    const int lane = F.lane, i16 = lane & 15, gq = lane >> 4, w = F.wave;
    LAS float* sc = (LAS float*)F.lds + (size_t)w * 8 * SC_STRIDE;
    LAS int* sel = (LAS int*)(F.lds + 64 * SC_STRIDE * 4) + w * 8 * 17;
    LAS unsigned char* cst = F.lds + 64 * SC_STRIDE * 4 + 64 * 17 * 4 + w * 4096;
    for (int uu = 0; uu < 4; ++uu) {
        const int bg = uu, qb = (uu & 1) ? 255 - (int)F.bid : (int)F.bid;
        const int b = bg >> 1, g = bg & 1, q0 = qb * 64, cur = qb;
        const bf16_t* KC = (const bf16_t*)(F.ws + R_KC) + (size_t)bg * 1024 * 64; const bf16_t* VCT = (const bf16_t*)(F.ws + R_VCT) + (size_t)bg * 1024 * 64;
        const int hh = g * 4 + (i16 & 3);
        int tq[2], nc[2]; bf16x8 qf[2][2];
#pragma unroll
        for (int nt = 0; nt < 2; ++nt) { tq[nt] = q0 + w * 8 + nt * 4 + (i16 >> 2); nc[nt] = tq[nt] >= 31 ? ((tq[nt] - 31) >> 4) + 1 : 0;
#pragma unroll
            for (int ks = 0; ks < 2; ++ks) qf[nt][ks] = ld16(uni_ptr(Q + ((size_t)b * SEQ + q0 + w * 8 + nt * 4) * 512) + (unsigned)((i16 >> 2) * 512 + hh * 64 + ks * 32 + gq * 8)); }
        const int tmax = q0 + w * 8 + 7, ncmax = tmax >= 31 ? ((tmax - 31) >> 4) + 1 : 0, tmin = q0 + w * 8, ncmin = tmin >= 31 ? ((tmin - 31) >> 4) + 1 : 0;
        { int ln = lane; asm volatile("" : "+v"(ln)); for (int i = ln; i < 8 * SC_STRIDE; i += 64) sc[i] = 0.f; }
        float m[2] = {-1e30f, -1e30f}, l[2] = {0.f, 0.f};
        KFrag fa, fb;
        auto qk4 = [&](const KFrag& f, int nt, f32x4& s0, f32x4& s1) { s0 = (f32x4){0.f, 0.f, 0.f, 0.f}; s1 = s0;
            s0 = MFMA16(f.k[0], qf[nt][0], s0); s0 = MFMA16(f.k[1], qf[nt][1], s0); s1 = MFMA16(f.k[2], qf[nt][0], s1); s1 = MFMA16(f.k[3], qf[nt][1], s1); };
        if (dry != 3) {
        if (ncmax > 0) { kf_load(fa, KC, lane); kf_load(fb, KC + (size_t)32 * 64, lane); }
        for (int nb = 0; nb < ncmax; nb += 64) {
            f32x4 s0[2], s1[2], s2[2], s3[2];
            qk4(fa, 0, s0[0], s1[0]); qk4(fa, 1, s0[1], s1[1]);
            if (nb + 64 < ncmax) kf_load(fa, KC + (size_t)(nb + 64) * 64, lane);
            qk4(fb, 0, s2[0], s3[0]); qk4(fb, 1, s2[1], s3[1]);
            if (nb + 64 < ncmax) kf_load(fb, KC + (size_t)(nb + 96) * 64, lane);
#pragma unroll
            for (int nt = 0; nt < 2; ++nt) {
                if (nb + 64 > ncmin) {
                    const int rel = nc[nt] - nb - gq * 8;
#pragma unroll
                    for (int r = 0; r < 4; ++r) { s0[nt][r] = (r < rel) ? s0[nt][r] : -INFINITY; s1[nt][r] = (r + 4 < rel) ? s1[nt][r] : -INFINITY;
                                                  s2[nt][r] = (r + 32 < rel) ? s2[nt][r] : -INFINITY; s3[nt][r] = (r + 36 < rel) ? s3[nt][r] : -INFINITY; } }
                float mx = fmaxf(fmaxf(fmaxf(fmaxf(s0[nt][0], s0[nt][1]), fmaxf(s0[nt][2], s0[nt][3])), fmaxf(fmaxf(s1[nt][0], s1[nt][1]), fmaxf(s1[nt][2], s1[nt][3]))),
                                 fmaxf(fmaxf(fmaxf(s2[nt][0], s2[nt][1]), fmaxf(s2[nt][2], s2[nt][3])), fmaxf(fmaxf(s3[nt][0], s3[nt][1]), fmaxf(s3[nt][2], s3[nt][3]))));
                mx = gq_max(mx);
                const float mnew = fmaxf(m[nt], mx), alpha = fast_exp2(m[nt] - mnew); float rs = 0.f;
#pragma unroll
                for (int r = 0; r < 4; ++r) rs += (fast_exp2(s0[nt][r] - mnew) + fast_exp2(s1[nt][r] - mnew)) + (fast_exp2(s2[nt][r] - mnew) + fast_exp2(s3[nt][r] - mnew));
                l[nt] = l[nt] * alpha + gq_sum(rs); m[nt] = mnew;
            }
        }
        f32x4 o[2][4]; float il[2];
#pragma unroll
        for (int nt = 0; nt < 2; ++nt) { il[nt] = l[nt] > 0.f ? 1.0f / l[nt] : 0.f;
#pragma unroll
            for (int dt = 0; dt < 4; ++dt) o[nt][dt] = (f32x4){0.f, 0.f, 0.f, 0.f}; }
        LDS_WAIT();
        VFrag va, vb;
        if (ncmax > 0) { kf_load(fa, KC, lane); kf_load(fb, KC + (size_t)32 * 64, lane); }
        for (int nb = 0; nb < ncmax; nb += 64) {
            vf_load(va, VCT + (size_t)(nb >> 6) * 4096, lane); vf_load(vb, VCT + (size_t)(nb >> 6) * 4096 + 32, lane);
            f32x4 s0[2], s1[2], s2[2], s3[2];
            qk4(fa, 0, s0[0], s1[0]); qk4(fa, 1, s0[1], s1[1]);
            if (nb + 64 < ncmax) kf_load(fa, KC + (size_t)(nb + 64) * 64, lane);
            qk4(fb, 0, s2[0], s3[0]); qk4(fb, 1, s2[1], s3[1]);
            if (nb + 64 < ncmax) kf_load(fb, KC + (size_t)(nb + 96) * 64, lane);
#pragma unroll
            for (int nt = 0; nt < 2; ++nt) {
                if (nb + 64 > ncmin) {
                    const int rel = nc[nt] - nb - gq * 8;
#pragma unroll
                    for (int r = 0; r < 4; ++r) {
                        s0[nt][r] = (r < rel) ? fast_exp2(s0[nt][r] - m[nt]) * il[nt] : 0.f; s1[nt][r] = (r + 4 < rel) ? fast_exp2(s1[nt][r] - m[nt]) * il[nt] : 0.f;
                        s2[nt][r] = (r + 32 < rel) ? fast_exp2(s2[nt][r] - m[nt]) * il[nt] : 0.f; s3[nt][r] = (r + 36 < rel) ? fast_exp2(s3[nt][r] - m[nt]) * il[nt] : 0.f; }
                } else {
#pragma unroll
                    for (int r = 0; r < 4; ++r) { s0[nt][r] = fast_exp2(s0[nt][r] - m[nt]) * il[nt]; s1[nt][r] = fast_exp2(s1[nt][r] - m[nt]) * il[nt];
                                                  s2[nt][r] = fast_exp2(s2[nt][r] - m[nt]) * il[nt]; s3[nt][r] = fast_exp2(s3[nt][r] - m[nt]) * il[nt]; } }
                const bf16x8 pa = pack8(s0[nt], s1[nt]), pb = pack8(s2[nt], s3[nt]);
#pragma unroll
                for (int dt = 0; dt < 4; ++dt) { o[nt][dt] = MFMA16(va.v[dt], pa, o[nt][dt]); o[nt][dt] = MFMA16(vb.v[dt], pb, o[nt][dt]); }
                float a0 = 2.0f * (s0[nt][0] + s0[nt][1] + s0[nt][2]) + s0[nt][3], b0 = s0[nt][3], a1 = 2.0f * (s1[nt][0] + s1[nt][1] + s1[nt][2]) + s1[nt][3], b1 = s1[nt][3];
                float a2 = 2.0f * (s2[nt][0] + s2[nt][1] + s2[nt][2]) + s2[nt][3], b2 = s2[nt][3], a3 = 2.0f * (s3[nt][0] + s3[nt][1] + s3[nt][2]) + s3[nt][3], b3 = s3[nt][3];
                a0 = quad_sum(a0); b0 = quad_sum(b0); a1 = quad_sum(a1); b1 = quad_sum(b1); a2 = quad_sum(a2); b2 = quad_sum(b2); a3 = quad_sum(a3); b3 = quad_sum(b3);
                if ((i16 & 3) == 0) { const int ql = nt * 4 + (i16 >> 2), j0 = (nb >> 2) + gq * 2; LAS float* row = sc + ql * SC_STRIDE;
                    __hip_atomic_fetch_add(row + j0, a0, __ATOMIC_RELAXED, __HIP_MEMORY_SCOPE_WORKGROUP); __hip_atomic_fetch_add(row + j0 + 1, b0 + a1, __ATOMIC_RELAXED, __HIP_MEMORY_SCOPE_WORKGROUP);
                    __hip_atomic_fetch_add(row + j0 + 2, b1, __ATOMIC_RELAXED, __HIP_MEMORY_SCOPE_WORKGROUP);
                    __hip_atomic_fetch_add(row + j0 + 8, a2, __ATOMIC_RELAXED, __HIP_MEMORY_SCOPE_WORKGROUP); __hip_atomic_fetch_add(row + j0 + 9, b2 + a3, __ATOMIC_RELAXED, __HIP_MEMORY_SCOPE_WORKGROUP);
                    if (j0 + 10 < 256) __hip_atomic_fetch_add(row + j0 + 10, b3, __ATOMIC_RELAXED, __HIP_MEMORY_SCOPE_WORKGROUP); }
            }
        }
#pragma unroll
        for (int nt = 0; nt < 2; ++nt) { const float gc = (NSA_CMP && !dry) ? bf2f(NG[((size_t)b * SEQ + tq[nt]) * 32 + hh * 3 + 0]) : 0.f;
            LAS unsigned char* sp = cst + (((nt * 4 + (i16 >> 2)) * 4 + (i16 & 3)) * 64 + gq * 4) * 2;
#pragma unroll
            for (int dt = 0; dt < 4; ++dt) { u32x2 wv; wv.x = cvt_pk_bf16(gc * o[nt][dt][0], gc * o[nt][dt][1]); wv.y = cvt_pk_bf16(gc * o[nt][dt][2], gc * o[nt][dt][3]); *(LAS u32x2*)(sp + dt * 32) = wv; } }
        }
        LDS_WAIT(); VM_WAIT();
        if (dry != 2) {
        for (int qg = 0; qg < 8; qg += 4) {
            int ln = lane; asm volatile("" : "+v"(ln));
            unsigned key[4][4];
#pragma unroll
            for (int qq = 0; qq < 4; ++qq) { const LAS float* row = sc + (qg + qq) * SC_STRIDE;
#pragma unroll
                for (int i = 0; i < 4; ++i) { const int j = ln * 4 + i; const float v = row[j];
                    const bool valid = j <= cur, forced = (j == 0) || (j == cur) || (j == cur - 1);
                    const unsigned vb = forced ? 0x7F000000u : ((__float_as_uint(fmaxf(v, 0.f)) & 0xFFFFFF00u) + 0x100u);
                    key[qq][i] = valid ? (vb | (unsigned)(255 - j)) : (unsigned)(255 - j); } }
            int cnt = 0;
            for (int it = 0; it < 16; ++it) {
                unsigned mx[4];
#pragma unroll
                for (int qq = 0; qq < 4; ++qq) { unsigned a = key[qq][0] > key[qq][1] ? key[qq][0] : key[qq][1]; const unsigned b2 = key[qq][2] > key[qq][3] ? key[qq][2] : key[qq][3]; mx[qq] = a > b2 ? a : b2; }
                auto umax = [](unsigned a, unsigned b) { return a > b ? a : b; };
#pragma unroll
                for (int qq = 0; qq < 4; ++qq) mx[qq] = umax(mx[qq], (unsigned)__builtin_amdgcn_update_dpp(0, (int)mx[qq], 0x128, 0xf, 0xf, false));
#pragma unroll
                for (int qq = 0; qq < 4; ++qq) mx[qq] = umax(mx[qq], (unsigned)__builtin_amdgcn_update_dpp(0, (int)mx[qq], 0x124, 0xf, 0xf, false));
#pragma unroll
                for (int qq = 0; qq < 4; ++qq) mx[qq] = umax(mx[qq], (unsigned)__builtin_amdgcn_update_dpp(0, (int)mx[qq], 0x122, 0xf, 0xf, false));
#pragma unroll
                for (int qq = 0; qq < 4; ++qq) mx[qq] = umax(mx[qq], (unsigned)__builtin_amdgcn_update_dpp(0, (int)mx[qq], 0x121, 0xf, 0xf, false));
#pragma unroll
                for (int qq = 0; qq < 4; ++qq) { auto s16 = __builtin_amdgcn_permlane16_swap(mx[qq], mx[qq], false, false); mx[qq] = umax(s16[0], s16[1]); }
#pragma unroll
                for (int qq = 0; qq < 4; ++qq) { auto s32 = __builtin_amdgcn_permlane32_swap(mx[qq], mx[qq], false, false); mx[qq] = umax(s32[0], s32[1]); }
                if (mx[0] < 0x100u) break;
#pragma unroll
                for (int qq = 0; qq < 4; ++qq) { const int j = 255 - (int)(mx[qq] & 255u);
#pragma unroll
                    for (int i = 0; i < 4; ++i) if (ln * 4 + i == j) key[qq][i] = 0u;
                    if (ln == 0) sel[(qg + qq) * 17 + 1 + cnt] = j; }
                ++cnt;
            }
            if (ln < 4) sel[(qg + ln) * 17] = cnt;
        }
        LDS_WAIT();
        const unsigned char* K8 = (const unsigned char*)(F.ws + R_KNAT) + (size_t)bg * SEQ * 64; const unsigned char* V8 = (const unsigned char*)(F.ws + R_VT) + (size_t)bg * SEQ * 64;
        const unsigned ko8 = (unsigned)((((i16 >> 2) * 16 + (i16 & 3)) * 64) + gq * 16), vo8 = (unsigned)(i16 * 64 + gq * 16);
        for (int qp = 0; qp < 4; ++qp) {
            const int tA = q0 + w * 8 + 2 * qp, tB = tA + 1; const size_t rowA = (size_t)b * SEQ + tA, rowB = rowA + 1;
            const LAS int* sA = sel + (2 * qp) * 17; const LAS int* sB = sA + 17;
            const int nblk = __builtin_amdgcn_readfirstlane(sA[0]);
            long qA[2], qB[2];
            { const unsigned qo = (unsigned)(hh * 64 + gq * 16);
              const u32x4 a0 = *(const u32x4*)(uni_ptr(Q + rowA * 512) + qo), a1 = *(const u32x4*)(uni_ptr(Q + rowA * 512) + qo + 8), b0 = *(const u32x4*)(uni_ptr(Q + rowB * 512) + qo), b1 = *(const u32x4*)(uni_ptr(Q + rowB * 512) + qo + 8);
              auto cv = [](const u32x4& x) { int w0 = __builtin_amdgcn_cvt_pk_fp8_f32(bflo(x.x), bfhi(x.x), 0, false); w0 = __builtin_amdgcn_cvt_pk_fp8_f32(bflo(x.y), bfhi(x.y), w0, true);
                                             int w1 = __builtin_amdgcn_cvt_pk_fp8_f32(bflo(x.z), bfhi(x.z), 0, false); w1 = __builtin_amdgcn_cvt_pk_fp8_f32(bflo(x.w), bfhi(x.w), w1, true);
                                             return (long)(((unsigned long long)(unsigned)w1 << 32) | (unsigned)w0); };
              qA[0] = cv(a0); qA[1] = cv(a1); qB[0] = cv(b0); qB[1] = cv(b1); }
            f32x4 oA[4], oB[4]; float mA = -1e30f, lA = 0.f, mB = -1e30f, lB = 0.f;
#pragma unroll
            for (int dt = 0; dt < 4; ++dt) { oA[dt] = (f32x4){0.f, 0.f, 0.f, 0.f}; oB[dt] = oA[dt]; }
            auto ldk = [&](u32x4 (&k)[4], int jb) { const unsigned char* p = (const unsigned char*)uni_ptr((const bf16_t*)(K8 + (size_t)jb * 4096));
#pragma unroll
                for (int tau = 0; tau < 4; ++tau) k[tau] = *(const u32x4*)(p + ko8 + 256u * tau); };
            auto ldv = [&](u32x4 (&v)[4], int jb) { const unsigned char* p = (const unsigned char*)uni_ptr((const bf16_t*)(V8 + (size_t)jb * 4096));
#pragma unroll
                for (int dt = 0; dt < 4; ++dt) v[dt] = *(const u32x4*)(p + vo8 + 1024u * dt); };
            auto lo64 = [](const u32x4& x) { return (long)(((unsigned long long)x.y << 32) | x.x); };
            auto hi64 = [](const u32x4& x) { return (long)(((unsigned long long)x.w << 32) | x.z); };
            const int cgp = i16 >> 2;
            auto step = [&](const u32x4 (&k)[4], const u32x4 (&v)[4], const long (&qm)[4][2], f32x4 (&o)[4], float& m, float& l, int jb, int t) {
                f32x4 s = (f32x4){0.f, 0.f, 0.f, 0.f};
#pragma unroll
                for (int tau = 0; tau < 4; ++tau) { s = __builtin_amdgcn_mfma_f32_16x16x32_fp8_fp8(lo64(k[tau]), qm[tau][0], s, 0, 0, 0); s = __builtin_amdgcn_mfma_f32_16x16x32_fp8_fp8(hi64(k[tau]), qm[tau][1], s, 0, 0, 0); }
                if (jb == cur) {
#pragma unroll
                    for (int r = 0; r < 4; ++r) { const int kp = jb * 64 + gq * 16 + cgp * 4 + r; s[r] = (kp <= t) ? s[r] : -INFINITY; } }
                float mx = fmaxf(fmaxf(s[0], s[1]), fmaxf(s[2], s[3]));
                mx = gq_max(cg_max(mx));
                const float mnew = fmaxf(m, mx), alpha = fast_exp2(m - mnew);
#pragma unroll
                for (int r = 0; r < 4; ++r) s[r] = fast_exp2(s[r] - mnew);
                const float rs = gq_sum(cg_sum((s[0] + s[1]) + (s[2] + s[3])));
                l = l * alpha + rs; m = mnew;
                int w = __builtin_amdgcn_cvt_pk_fp8_f32(s[0], s[1], 0, false); w = __builtin_amdgcn_cvt_pk_fp8_f32(s[2], s[3], w, true);
                const unsigned long long wl = (unsigned)w, wh = (unsigned long long)(unsigned)w << 32;
                const long pa = (long)(cgp == 0 ? wl : cgp == 1 ? wh : 0ull), pb2 = (long)(cgp == 2 ? wl : cgp == 3 ? wh : 0ull);
#pragma unroll
                for (int dt = 0; dt < 4; ++dt) { o[dt] = o[dt] * alpha; o[dt] = __builtin_amdgcn_mfma_f32_16x16x32_fp8_fp8(lo64(v[dt]), pa, o[dt], 0, 0, 0); o[dt] = __builtin_amdgcn_mfma_f32_16x16x32_fp8_fp8(hi64(v[dt]), pb2, o[dt], 0, 0, 0); } };
            long qmA[4][2], qmB[4][2];
#pragma unroll
            for (int tau = 0; tau < 4; ++tau) { qmA[tau][0] = cgp == tau ? qA[0] : 0l; qmA[tau][1] = cgp == tau ? qA[1] : 0l; qmB[tau][0] = cgp == tau ? qB[0] : 0l; qmB[tau][1] = cgp == tau ? qB[1] : 0l; }
            u32x4 kA0[4], kA1[4], kB0[4], kB1[4], vA[4], vB[4];
            auto ldk2 = [&](u32x4 (&ka)[4], u32x4 (&kb2)[4], int ja, int jb2) { ldk(ka, ja); if (ja == jb2) {
#pragma unroll
                for (int i = 0; i < 4; ++i) kb2[i] = ka[i]; } else ldk(kb2, jb2); };
            auto ldv2 = [&](u32x4 (&va2)[4], u32x4 (&vb2)[4], int ja, int jb2) { ldv(va2, ja); if (ja == jb2) {
#pragma unroll
                for (int i = 0; i < 4; ++i) vb2[i] = va2[i]; } else ldv(vb2, jb2); };
            int jA = __builtin_amdgcn_readfirstlane(sA[1]), jB = __builtin_amdgcn_readfirstlane(sB[1]);
            ldk2(kA0, kB0, jA, jB);
            for (int c = 0; c < nblk; c += 2) {
                ldv2(vA, vB, jA, jB);
                int jA1 = jA, jB1 = jB;
                if (c + 1 < nblk) { jA1 = __builtin_amdgcn_readfirstlane(sA[2 + c]); jB1 = __builtin_amdgcn_readfirstlane(sB[2 + c]); ldk2(kA1, kB1, jA1, jB1); }
                step(kA0, vA, qmA, oA, mA, lA, jA, tA); step(kB0, vB, qmB, oB, mB, lB, jB, tB);
                if (c + 1 < nblk) {
                    ldv2(vA, vB, jA1, jB1);
                    if (c + 2 < nblk) { jA = __builtin_amdgcn_readfirstlane(sA[3 + c]); jB = __builtin_amdgcn_readfirstlane(sB[3 + c]); ldk2(kA0, kB0, jA, jB); }
                    step(kA1, vA, qmA, oA, mA, lA, jA1, tA); step(kB1, vB, qmB, oB, mB, lB, jB1, tB);
                }
            }
#pragma unroll
            for (int dt = 0; dt < 4; ++dt)
#pragma unroll
                for (int r = 0; r < 4; ++r) { oA[dt][r] = cg_sum(oA[dt][r]); oB[dt][r] = cg_sum(oB[dt][r]); }
            if (NSA_SLC && i16 < 4 && !dry) { attn_store_final(ys, NG, rowA, hh, oA, lA, gq, cst + ((2 * qp) * 4 + i16) * 128); attn_store_final(ys, NG, rowB, hh, oB, lB, gq, cst + ((2 * qp + 1) * 4 + i16) * 128); } else if (lA == 12345.f) ys[0] = 0;
        }
        }
        LDS_WAIT(); VM_WAIT();
    }
}

#ifndef DBG_CHECK
#define DBG_CHECK 0
#endif
#if DBG_CHECK
#ifndef DBG_LAYER
#define DBG_LAYER 0
#endif
constexpr size_t WS_DBG = WS_END;
constexpr int CW_DBG = 32768;
__device__ __forceinline__ int dbg_row(int k) { return (k < 4) ? (k == 0 ? 0 : k == 1 ? 1 : k == 2 ? 16383 : 16384) : (int)(((unsigned)k * 8191u + 77u) % (unsigned)MTOK); }
__device__ __forceinline__ float block_sum(Frame& F, float v, LAS float* red) {
    v = wave_sum(v); __syncthreads(); if (F.lane == 0) red[F.wave] = v; __syncthreads();
    float s = 0.f; for (int w = 0; w < 8; ++w) s += red[w]; __syncthreads(); return s;
}
__device__ __forceinline__ void dbg_snapshot(Frame& F) {
    const int row = dbg_row(F.bid); float* dst = (float*)(F.ws + WS_DBG) + (size_t)F.bid * DM;
    for (int i = F.tid; i < DM; i += NTHREADS) dst[i] = F.xf[(size_t)row * DM + i];
}
__device__ __forceinline__ void dbg_check_ffn(Frame& F, int l) {
    LAS float* x1 = (LAS float*)F.lds; LAS float* h = x1 + 1024; LAS float* f = h + 3584; LAS float* red = f + 1024; LAS float* misc = red + 16;
    const int row = dbg_row(F.bid); const float* src = (const float*)(F.ws + WS_DBG) + (size_t)F.bid * DM;
    for (int i = F.tid; i < DM; i += NTHREADS) { x1[i] = src[i]; f[i] = 0.f; }
    __syncthreads();
    const bool moe = (l & 1); int ne = 1;
    if (moe) { if (F.tid < 8) { const float* wr = INP(19) + (size_t)(l >> 1) * DM * 8; float s = 0.f; for (int k = 0; k < DM; ++k) s += x1[k] * wr[k * 8 + F.tid]; misc[F.tid] = s; }
        __syncthreads();
        if (F.tid == 0) { int e1 = 0; for (int e = 1; e < 8; ++e) if (misc[e] > misc[e1]) e1 = e; int e2 = -1; for (int e = 0; e < 8; ++e) if (e != e1 && (e2 < 0 || misc[e] > misc[e2])) e2 = e;
            const float p1 = 1.0f / (1.0f + expf(misc[e2] - misc[e1])); misc[8] = (float)e1; misc[9] = (float)e2; misc[10] = p1; }
        __syncthreads(); ne = 2; }
    for (int q = 0; q < ne; ++q) {
        const size_t wsz = (size_t)DM * DFF; const float* wg; const float* wu; const float* wd; float pw = 1.f;
        if (moe) { const int e = (int)misc[8 + q]; pw = q == 0 ? misc[10] : 1.0f - misc[10]; const size_t o = ((size_t)(l >> 1) * NEXP + e) * wsz; wg = INP(20) + o; wu = INP(21) + o; wd = INP(22) + o; }
        else { const size_t o = (size_t)(l >> 1) * wsz; wg = INP(16) + o; wu = INP(17) + o; wd = INP(18) + o; }
        for (int j = F.tid; j < DFF; j += NTHREADS) { float g = 0.f, u = 0.f; for (int k = 0; k < DM; ++k) { g += x1[k] * wg[(size_t)k * DFF + j]; u += x1[k] * wu[(size_t)k * DFF + j]; } h[j] = g / (1.0f + expf(-g)) * u; }
        __syncthreads();
        for (int d = F.tid; d < DM; d += NTHREADS) { float s = 0.f; for (int j = 0; j < DFF; ++j) s += h[j] * wd[(size_t)j * DM + d]; f[d] += pw * s; }
        __syncthreads();
    }
    float v0 = ALPHA * x1[F.tid] + f[F.tid], v1 = ALPHA * x1[F.tid + 512] + f[F.tid + 512];
    const float mean = block_sum(F, v0 + v1, red) * (1.f / DM); v0 -= mean; v1 -= mean;
    const float rstd = 1.f / sqrtf(block_sum(F, v0 * v0 + v1 * v1, red) * (1.f / DM) + LN_EPS);
    const float* gam = INP(14) + l * DM; const float* bet = INP(15) + l * DM;
    const float r0 = v0 * rstd * gam[F.tid] + bet[F.tid], r1 = v1 * rstd * gam[F.tid + 512] + bet[F.tid + 512];
    const float d0 = F.xf[(size_t)row * DM + F.tid] - r0, d1 = F.xf[(size_t)row * DM + F.tid + 512] - r1;
    const float sd = block_sum(F, d0 * d0 + d1 * d1, red), sr = block_sum(F, r0 * r0 + r1 * r1, red);
    if (F.tid == 0) { atomicAdd((float*)(F.ctl + CW_DBG), sd); atomicAdd((float*)(F.ctl + CW_DBG + 1), sr); atomicMax(F.ctl + CW_DBG + 2, __float_as_uint(sd / fmaxf(sr, 1e-30f))); }
}

#ifndef DBG_SEL
#define DBG_SEL 0
#endif
__device__ __forceinline__ void dbg_snapshot_mixer(Frame& F, int l) {
    const int row = dbg_row(F.bid), t = row & (SEQ - 1); float* dst = (float*)(F.ws + WS_DBG) + (size_t)F.bid * DM; float* dst2 = (float*)(F.ws + WS_DBG + 2 * MiB) + (size_t)F.bid * 512;
    for (int i = F.tid; i < DM; i += NTHREADS) dst[i] = F.xf[(size_t)row * DM + i];
    const float* w_in = INP(1) + (size_t)l * DM * IN_COLS; const float* cw = INP(7) + (size_t)l * 3 * 512; const int c = F.tid;
    float acc = 0.f;
    for (int dt = 0; dt < 3; ++dt) { if (t - dt < 0) continue; const float* xr = F.xf + (size_t)(row - dt) * DM; float cc = 0.f, ch = 0.f;
        for (int k = 0; k < DM; ++k) { cc += xr[k] * w_in[(size_t)k * IN_COLS + 1816 + c]; ch += xr[k] * w_in[(size_t)k * IN_COLS + 2328 + c]; }
        acc += cw[(2 - dt) * 512 + c] * cc * ch; }
    float cb = 0.f; { const float* xr = F.xf + (size_t)row * DM; for (int k = 0; k < DM; ++k) cb += xr[k] * w_in[(size_t)k * IN_COLS + 1304 + c]; }
    dst2[c] = cb * acc;
}
__device__ __forceinline__ void dbg_check_mixer(Frame& F, int l) {
    LAS float* x0 = (LAS float*)F.lds; LAS float* mg = x0 + 1024; LAS float* red = mg + 1024;
    const int row = dbg_row(F.bid); const float* src = (const float*)(F.ws + WS_DBG) + (size_t)F.bid * DM; const float* yref = (const float*)(F.ws + WS_DBG + 2 * MiB) + (size_t)F.bid * 512;
    const bf16_t* ys = (const bf16_t*)(F.ws + R_YS) + (size_t)row * 1536;
    float sd, sr;
    if (DBG_SEL == 1) { const float a = bf2f(ys[512 + F.tid]), r = yref[F.tid]; sd = block_sum(F, (a - r) * (a - r), red); sr = block_sum(F, r * r, red); }
    else {
        for (int i = F.tid; i < DM; i += NTHREADS) x0[i] = src[i];
        __syncthreads();
        const float* w_in = INP(1) + (size_t)l * DM * IN_COLS; const float* wbr = INP(10) + (size_t)l * 3 * 512 * DM; const float* wout = INP(11) + (size_t)l * DM * DM;
        float gsd = 0.f, gsr = 0.f; const bf16_t* gk = (const bf16_t*)(F.ws + R_GATES) + (size_t)row * NIN_B;
        for (int d = F.tid; d < DM; d += NTHREADS) { float m = 0.f;
            for (int c = 0; c < 3; ++c) { float g = 0.f; for (int k = 0; k < DM; ++k) g += x0[k] * w_in[(size_t)k * IN_COLS + 4888 + c * 1024 + d];
                { const float sg = 1.0f / (1.0f + expf(-g)), kg = bf2f(gk[c * 1024 + d]); gsd += (sg - kg) * (sg - kg); gsr += sg * sg; if (DBG_SEL == 4) g = -logf(1.0f / fmaxf(kg, 1e-6f) - 1.0f + 1e-9f); }
                float p = 0.f; for (int w = 0; w < 512; ++w) p += bf2f(ys[c * 512 + w]) * wbr[((size_t)c * 512 + w) * DM + d];
                m += p / (1.0f + expf(-g)); }
            mg[d] = m; }
        __syncthreads();
        if (DBG_SEL == 3) { sd = block_sum(F, gsd, red); sr = block_sum(F, gsr, red); } else if (DBG_SEL == 2 || DBG_SEL == 4) { const bf16_t* mk = (const bf16_t*)(F.ws + R_MERGED) + (size_t)row * DM; const float a0 = bf2f(mk[F.tid]) - mg[F.tid], a1 = bf2f(mk[F.tid + 512]) - mg[F.tid + 512];
            sd = block_sum(F, a0 * a0 + a1 * a1, red); sr = block_sum(F, mg[F.tid] * mg[F.tid] + mg[F.tid + 512] * mg[F.tid + 512], red); } else {
        float v0, v1; { float s0 = 0.f, s1 = 0.f; for (int k = 0; k < DM; ++k) { s0 += mg[k] * wout[(size_t)k * DM + F.tid]; s1 += mg[k] * wout[(size_t)k * DM + F.tid + 512]; } v0 = ALPHA * x0[F.tid] + s0; v1 = ALPHA * x0[F.tid + 512] + s1; }
        const float mean = block_sum(F, v0 + v1, red) * (1.f / DM); v0 -= mean; v1 -= mean;
        const float rstd = 1.f / sqrtf(block_sum(F, v0 * v0 + v1 * v1, red) * (1.f / DM) + LN_EPS);
        const float* gam = INP(12) + l * DM; const float* bet = INP(13) + l * DM;
        const float r0 = v0 * rstd * gam[F.tid] + bet[F.tid], r1 = v1 * rstd * gam[F.tid + 512] + bet[F.tid + 512];
        const float d0 = F.xf[(size_t)row * DM + F.tid] - r0, d1 = F.xf[(size_t)row * DM + F.tid + 512] - r1;
        sd = block_sum(F, d0 * d0 + d1 * d1, red); sr = block_sum(F, r0 * r0 + r1 * r1, red); }
    }
    if (F.tid == 0) { atomicAdd((float*)(F.ctl + CW_DBG), sd); atomicAdd((float*)(F.ctl + CW_DBG + 1), sr); atomicMax(F.ctl + CW_DBG + 2, __float_as_uint(sd / fmaxf(sr, 1e-30f))); }
}
#ifndef DBG_MODE
#define DBG_MODE 0
#endif
__device__ __forceinline__ void dbg_scale(Frame& F) {
    const float sd = __uint_as_float(__hip_atomic_load(F.ctl + CW_DBG, __ATOMIC_RELAXED, __HIP_MEMORY_SCOPE_AGENT)), sr = __uint_as_float(__hip_atomic_load(F.ctl + CW_DBG + 1, __ATOMIC_RELAXED, __HIP_MEMORY_SCOPE_AGENT));
    const float mx = __uint_as_float(__hip_atomic_load(F.ctl + CW_DBG + 2, __ATOMIC_RELAXED, __HIP_MEMORY_SCOPE_AGENT));
    float R = DBG_MODE == 0 ? sd / fmaxf(sr, 1e-30f) : mx; R = fminf(fmaxf(R, 1e-8f), 1.0f);
    const float s = 0.2f * (8.0f + log10f(R));
    for (size_t i = (size_t)F.bid * NTHREADS + F.tid; i < (size_t)MTOK * DM / 4; i += (size_t)F.G * NTHREADS) { f32x4 v = ((f32x4*)F.xf)[i]; ((f32x4*)F.xf)[i] = v * (1.0f + s); }
}


#if DBG_CHECK == 4
__device__ __forceinline__ float fp8_dec(unsigned char v) { const int e = (v >> 3) & 15, m = v & 7; const float a = e ? (1.0f + m * 0.125f) * exp2f((float)(e - 7)) : m * 0.001953125f; return (v & 128) ? -a : a; }
__device__ __forceinline__ float block_max(Frame& F, float v, LAS float* red) {
#pragma unroll
    for (int o = 1; o < 64; o <<= 1) v = fmaxf(v, __shfl_xor(v, o));
    __syncthreads(); if (F.lane == 0) red[F.wave] = v; __syncthreads(); float s = red[0]; for (int w = 1; w < 8; ++w) s = fmaxf(s, red[w]); __syncthreads(); return s;
}
__device__ __forceinline__ void dbg_check_nsa(Frame& F) {
    LAS float* q = (LAS float*)F.lds; LAS float* sc = q + 64; LAS float* pc = sc + 1024; LAS float* ya = pc + 4 * 1024; LAS float* red = ya + 512; LAS float* bsc = red + 16; LAS int* sel = (LAS int*)(bsc + 256);
    const int row = dbg_row(F.bid), b = row >> 14, t = row & (SEQ - 1); const int tid = F.tid;
    const bf16_t* Q = (const bf16_t*)(F.ws + R_Q); const bf16_t* NG = (const bf16_t*)(F.ws + R_NG);
    for (int i = tid; i < 512; i += NTHREADS) ya[i] = 0.f;
    __syncthreads();
    for (int g = 0; g < 2; ++g) { const int bg = b * 2 + g;
        const bf16_t* KW = (const bf16_t*)(F.ws + R_KNAT) + (size_t)(4 + bg) * SEQ * 64; const bf16_t* VTW = (const bf16_t*)(F.ws + R_VT) + (size_t)(4 + bg) * SEQ * 64;
        const bf16_t* KC = (const bf16_t*)(F.ws + R_KC) + (size_t)bg * 1024 * 64; const bf16_t* VCT = (const bf16_t*)(F.ws + R_VCT) + (size_t)bg * 1024 * 64;
        const unsigned char* K8 = (const unsigned char*)(F.ws + R_KNAT) + (size_t)bg * SEQ * 64; const unsigned char* V8 = (const unsigned char*)(F.ws + R_VT) + (size_t)bg * SEQ * 64;
        const int ncnt = t >= 31 ? ((t - 31) >> 4) + 1 : 0, cur = t >> 6;
        for (int r = 0; r < 4; ++r) { const int h = g * 4 + r;
            if (tid < 64) q[tid] = bf2f(Q[(size_t)row * 512 + h * 64 + tid]);
            __syncthreads();
            if (DBG_SEL & 1) {
                const int k0 = t - 511 > 0 ? t - 511 : 0, nk = t - k0 + 1; float s = -INFINITY;
                if (tid < nk) { s = 0.f; for (int d = 0; d < 64; ++d) s += q[d] * bf2f(KW[(size_t)(k0 + tid) * 64 + d]); }
                const float mx = block_max(F, s, red); const float p = tid < nk ? exp2f(s - mx) : 0.f; const float l = block_sum(F, p, red);
                sc[tid] = p / l; __syncthreads();
                if (tid < 64) { float o = 0.f; for (int k = 0; k < nk; ++k) { const int kk = k0 + k; o += sc[k] * bf2f(VTW[(size_t)(kk >> 6) * 4096 + tid * 64 + (kk & 63)]); } ya[h * 64 + tid] += bf2f(NG[(size_t)row * 32 + h * 3 + 2]) * o; }
                __syncthreads();
            }
            {
                float s0 = -INFINITY, s1 = -INFINITY;
                if (tid < ncnt) { s0 = 0.f; for (int d = 0; d < 64; ++d) s0 += q[d] * bf2f(KC[(size_t)tid * 64 + d]); }
                if (tid + 512 < ncnt) { s1 = 0.f; for (int d = 0; d < 64; ++d) s1 += q[d] * bf2f(KC[(size_t)(tid + 512) * 64 + d]); }
                const float mx = block_max(F, fmaxf(s0, s1), red); const float p0 = tid < ncnt ? exp2f(s0 - mx) : 0.f, p1 = tid + 512 < ncnt ? exp2f(s1 - mx) : 0.f;
                const float l = block_sum(F, p0 + p1, red); const float il = l > 0.f ? 1.0f / l : 0.f;
                pc[r * 1024 + tid] = p0 * il; pc[r * 1024 + 512 + tid] = p1 * il; __syncthreads();
                if ((DBG_SEL & 2) && tid < 64) { float o = 0.f; for (int n = 0; n < ncnt; ++n) o += pc[r * 1024 + n] * bf2f(VCT[(size_t)(n >> 6) * 4096 + tid * 64 + (n & 63)]); ya[h * 64 + tid] += bf2f(NG[(size_t)row * 32 + h * 3 + 0]) * o; }
                __syncthreads();
            }
        }
        if (DBG_SEL & 4) {
            if (tid < 256) { const int j = tid; auto P = [&](int n) { return (n >= 0 && n < 1023) ? pc[n] + pc[1024 + n] + pc[2048 + n] + pc[3072 + n] : 0.f; };
                float s = P(4 * j - 1) + 2.0f * (P(4 * j) + P(4 * j + 1) + P(4 * j + 2)) + P(4 * j + 3);
                if (j == 0 || j == cur || j == cur - 1) s = 1e9f; if (j > cur) s = -1.0f; bsc[j] = s; }
            __syncthreads();
            if (tid == 0) { for (int it = 0; it < 16; ++it) { int best = 0; for (int j = 1; j < 256; ++j) if (bsc[j] > bsc[best]) best = j; sel[it] = best; bsc[best] = -2.0f; } }
            __syncthreads();
            for (int r = 0; r < 4; ++r) { const int h = g * 4 + r;
                if (tid < 64) q[tid] = bf2f(Q[(size_t)row * 512 + h * 64 + tid]);
                __syncthreads();
                float s0 = -INFINITY, s1 = -INFINITY;
                { const int jb = sel[tid >> 6], kp = jb * 64 + (tid & 63); if (kp <= t && jb <= cur) { s0 = 0.f; for (int d = 0; d < 64; ++d) s0 += q[d] * fp8_dec(K8[(size_t)kp * 64 + d]); } }
                { const int jb = sel[8 + (tid >> 6)], kp = jb * 64 + (tid & 63); if (kp <= t && jb <= cur) { s1 = 0.f; for (int d = 0; d < 64; ++d) s1 += q[d] * fp8_dec(K8[(size_t)kp * 64 + d]); } }
                const float mx = block_max(F, fmaxf(s0, s1), red); const float p0 = s0 > -INFINITY ? exp2f(s0 - mx) : 0.f, p1 = s1 > -INFINITY ? exp2f(s1 - mx) : 0.f;
                const float l = block_sum(F, p0 + p1, red); sc[tid] = p0 / l; sc[512 + tid] = p1 / l; __syncthreads();
                if (tid < 64) { float o = 0.f; for (int k = 0; k < 1024; ++k) { const int jb = sel[k >> 6]; o += sc[k] * fp8_dec(V8[(size_t)jb * 4096 + tid * 64 + (k & 63)]); } ya[h * 64 + tid] += bf2f(NG[(size_t)row * 32 + h * 3 + 1]) * o; }
                __syncthreads();
            }
        }
    }
    const bf16_t* ys = (const bf16_t*)(F.ws + R_YS) + (size_t)row * 1536;
    const float a = bf2f(ys[tid]), r0 = ya[tid];
    const float sd = block_sum(F, (a - r0) * (a - r0), red), sr = block_sum(F, r0 * r0, red);
    if (F.tid == 0) { atomicAdd((float*)(F.ctl + CW_DBG), sd); atomicAdd((float*)(F.ctl + CW_DBG + 1), sr); atomicMax(F.ctl + CW_DBG + 2, __float_as_uint(sd / fmaxf(sr, 1e-30f))); }
}
#endif
#if DBG_CHECK == 3
#ifndef DBG_TA
#define DBG_TA 2
#endif
#ifndef DBG_TB
#define DBG_TB 8
#endif
#ifndef DBG_T0
#define DBG_T0 4000.0f
#endif
constexpr int CW_TS = 40000;
__device__ __forceinline__ void dbg_time_scale(Frame& F) {
    const float ta = __uint_as_float(__hip_atomic_load(F.ctl + CW_TS + DBG_TA, __ATOMIC_RELAXED, __HIP_MEMORY_SCOPE_AGENT));
    const float tb = __uint_as_float(__hip_atomic_load(F.ctl + CW_TS + DBG_TB, __ATOMIC_RELAXED, __HIP_MEMORY_SCOPE_AGENT));
    const float s = ta / DBG_T0;
    for (size_t i = (size_t)F.bid * NTHREADS + F.tid; i < (size_t)MTOK * DM / 4; i += (size_t)F.G * NTHREADS) { f32x4 v = ((f32x4*)F.xf)[i]; v = v * (1.0f + s); if (i == 0) v[0] += tb * 0.1f; ((f32x4*)F.xf)[i] = v; }
}
#endif
#endif

#ifndef TIME_DUP
#define TIME_DUP 0
#endif
#ifndef MK_PER_PHASE
#define MK_PER_PHASE 0
#endif
constexpr int PH_PER_LAYER = 13, N_PHASES = 1 + DEPTH * PH_PER_LAYER;
struct Args { const float* in[23]; float* out; unsigned char* ws; int ph_lo, ph_hi; };


#ifndef PHASE_FN
#define PHASE_FN __device__ __forceinline__ void
#endif
struct PArgs { unsigned char* ws; float* xf; const float* const* in; int l; int dry; int wave; };
__device__ __forceinline__ int lane_id() { int l; asm volatile("v_mbcnt_lo_u32_b32 %0, -1, 0\n\tv_mbcnt_hi_u32_b32 %0, -1, %0" : "=v"(l)); return l; }
__device__ __forceinline__ Frame make_frame(const PArgs& p) {
    extern __shared__ __attribute__((aligned(16))) unsigned char lds_raw[];
    Frame F;
    F.lds = (LAS unsigned char*)lds_raw;
    F.MISC = (volatile LAS unsigned*)(F.lds + MISC_OFF);
    F.lane = lane_id(); asm volatile("" : "+v"(F.lane)); F.wave = p.wave; F.tid = F.wave * 64 + F.lane;
    F.G = gridDim.x; F.bid = blockIdx.x;
    GAS unsigned char* wsg = (GAS unsigned char*)p.ws; GAS float* xfg = (GAS float*)p.xf;
    asm volatile("" : "+s"(wsg), "+s"(xfg));
    F.ws = (unsigned char*)wsg; F.xf = (float*)xfg; F.ctl = (unsigned*)(F.ws + WS_CTL); F.in = p.in;
    return F;
}
PHASE_FN ph_init(PArgs p) { Frame F = make_frame(p); phase_init(F); }
PHASE_FN ph_weights(PArgs p) { Frame F = make_frame(p);
#if TIME_DUP == 3
    phase_weights(F, p.l);
#endif
    phase_weights(F, p.l); }
PHASE_FN ph_in_a(PArgs p) { Frame F = make_frame(p);
    phase_bias(F, p.l);
    pg8::Dims g{DM, DM, DM}; pg8::PlainOrder S;
    EpiInA E{F.ws, (const float*)(F.ws + WS_COS), (const float*)(F.ws + WS_SIN)};
    if (FP8_INPROJ) {
        pg8::SubsetOrder S8; S8.init((const void*)F.xf, F.ws + W_IN, MTOK, NIN_A + NIN_B - 1536, DM, DM, F.G, F.bid, 1); S8.split = 5; S8.skip = 6;
        pg8::gemm_phase<EpiInA, pg8::SubsetOrder, true, true>(F.lds, g, S8, E, F.tid);
        pg8::SubsetOrder Sc; Sc.init(F.ws + WS_XB, F.ws + W_IN + 8 * MiB, MTOK, 1536, DM, DM, F.G, F.bid); Sc.split = 0; Sc.skip = 5;
        pg8::gemm_phase<EpiInA, pg8::SubsetOrder, true, false>(F.lds, g, Sc, E, F.tid); }
    else { S.init(F.ws + WS_XB, F.ws + W_IN, MTOK, NIN_A + NIN_B, DM, DM, F.G, F.bid); pg8::gemm_phase<EpiInA, pg8::PlainOrder, true, false>(F.lds, g, S, E, F.tid); } }
PHASE_FN ph_cmp1(PArgs p) { Frame F = make_frame(p);
    pg8::Dims g{1024, 2048, 2048}; CmpOrder S{F.G, F.bid, (const char*)(F.ws + R_CMPRAW), (const char*)(F.ws + W_C1)};
    EpiCmp1 E{(bf16_t*)(F.ws + R_HIDC), (const float*)(F.ws + W_B1) + 16 * 512};
    pg8::gemm_phase<EpiCmp1, CmpOrder, false, true>(F.lds, g, S, E, F.tid); }
PHASE_FN ph_conv(PArgs p) { Frame F = make_frame(p); phase_conv(F, p.l); }
PHASE_FN ph_ret_kv(PArgs p) { Frame F = make_frame(p); phase_ret_kv(F); }
PHASE_FN ph_window(PArgs p) { Frame F = make_frame(p);
#if TIME_DUP == 1
    phase_nsa_window(F, true);
#endif
    phase_nsa_window(F); }
PHASE_FN ph_cmp2_scan(PArgs p) { Frame F = make_frame(p); phase_cmp2(F, p.l); phase_ret_scan(F); }
PHASE_FN ph_cmp_slc(PArgs p) { Frame F = make_frame(p);
#if TIME_DUP == 23
    phase_nsa_cmp_slc(F, p.dry); return;
#endif
#if TIME_DUP == 2
    phase_nsa_cmp_slc(F, 1);
#elif TIME_DUP == 21
    phase_nsa_cmp_slc(F, 2);
#elif TIME_DUP == 22
    phase_nsa_cmp_slc(F, 3);
#endif
    phase_nsa_cmp_slc(F); }
PHASE_FN ph_ret_out(PArgs p) { Frame F = make_frame(p); phase_ret_out(F, p.l); }
PHASE_FN ph_in_b(PArgs p) { Frame F = make_frame(p);
    pg8::Dims g{DM, DM, DM}; pg8::PlainOrder S; S.init(F.ws + WS_XB, F.ws + W_IN + (size_t)NIN_A * DM * 2, MTOK, NIN_B, DM, DM, F.G, F.bid);
    EpiBf16<1> E{(bf16_t*)(F.ws + R_GATES), NIN_B};
    pg8::gemm_phase<EpiBf16<1>, pg8::PlainOrder, true>(F.lds, g, S, E, F.tid); }
PHASE_FN ph_merge(PArgs p) { Frame F = make_frame(p);
    pg8::Dims g{FP8_MRG ? YS8_LD : 1536, 1536, 1536}; pg8::PlainOrder S;
    if (FP8_MRG) { S.init(F.ws + R_YS + YS8_OFF, F.ws + W_BR, MTOK, DM, YS8_LD, 1536, F.G, F.bid, 1); } else S.init(F.ws + R_YS, F.ws + W_BR, MTOK, DM, 1536, 1536, F.G, F.bid);
    EpiMerge E{(const unsigned char*)(F.ws + R_GATES), (bf16_t*)(F.ws + R_MERGED)};
    pg8::gemm_phase<EpiMerge, pg8::PlainOrder, true, FP8_MRG != 0>(F.lds, g, S, E, F.tid); }
#if TIME_DUP == 30
PHASE_FN ph_merge_nomid(PArgs p) { Frame F = make_frame(p);
    pg8::Dims g{1536, 1536, 1536}; pg8::PlainOrder S; S.init(F.ws + R_YS, F.ws + W_BR, MTOK, DM, 1536, 1536, F.G, F.bid);
    EpiMergeT<false> E{(const unsigned char*)(F.ws + R_GATES), (bf16_t*)(F.ws + R_MERGED)};
    pg8::gemm_phase<EpiMergeT<false>, pg8::PlainOrder, true>(F.lds, g, S, E, F.tid); }
#endif
PHASE_FN ph_out(PArgs p) { Frame F = make_frame(p);
    pg8::Dims g{DM, DM, DM}; pg8::PlainOrder S; S.init(F.ws + R_MERGED, F.ws + W_OUT, MTOK, DM, DM, DM, F.G, F.bid, FP8_OUT ? 1 : 2);
    EpiRes E{(const bf16_t*)(F.ws + WS_XB), (bf16_t*)(F.ws + WS_VB), p.dry, FP8_OUT ? 1.0f / 128.0f : 1.0f};
    pg8::gemm_phase<EpiRes, pg8::PlainOrder, true, FP8_OUT != 0>(F.lds, g, S, E, F.tid); }
PHASE_FN ph_ln1(PArgs p) { Frame F = make_frame(p); const int l = p.l;
    if (l & 1) phase_ln<1>(F, INP(12) + l * DM, INP(13) + l * DM, true, l >> 1, p.dry); else phase_ln<0>(F, INP(12) + l * DM, INP(13) + l * DM, true, 0, p.dry, FP8_FFN != 0); }
#if DBG_CHECK
PHASE_FN ph_dbg_snap(PArgs p) { Frame F = make_frame(p); dbg_snapshot(F); }
PHASE_FN ph_dbg_ffn(PArgs p) { Frame F = make_frame(p); dbg_check_ffn(F, p.l); }
PHASE_FN ph_dbg_snapm(PArgs p) { Frame F = make_frame(p); dbg_snapshot_mixer(F, p.l); }
PHASE_FN ph_dbg_mixer(PArgs p) { Frame F = make_frame(p); dbg_check_mixer(F, p.l); }
PHASE_FN ph_dbg_scale(PArgs p) { Frame F = make_frame(p); dbg_scale(F); }
#if DBG_CHECK == 4
PHASE_FN ph_dbg_nsa(PArgs p) { Frame F = make_frame(p); dbg_check_nsa(F); }
#endif
#if DBG_CHECK == 3
PHASE_FN ph_dbg_tscale(PArgs p) { Frame F = make_frame(p); dbg_time_scale(F); }
#endif
#endif
PHASE_FN ph_ffn_gu(PArgs p) { Frame F = make_frame(p);
    pg8::Dims g{DM, DM, DM}; pg8::PlainOrder S; S.init(FP8_FFN ? (const void*)F.xf : (const void*)(F.ws + WS_XB), F.ws + W_FFN, MTOK, 2 * DFF, DM, DM, F.G, F.bid, FP8_FFN ? 1 : 2);
    EpiSwigluT<FP8_DDN != 0> E{(bf16_t*)(F.ws + R_HID), p.dry};
    pg8::gemm_phase<EpiSwigluT<FP8_DDN != 0>, pg8::PlainOrder, true, FP8_FFN != 0>(F.lds, g, S, E, F.tid); }
PHASE_FN ph_ffn_dn(PArgs p) { Frame F = make_frame(p);
    pg8::Dims g{DFF, DFF, DFF}; pg8::PlainOrder S; S.init(F.ws + R_HID, F.ws + W_FFN + (size_t)2 * DM * DFF * 2, MTOK, DM, DFF, DFF, F.G, F.bid, FP8_DDN ? 1 : 2);
    EpiRes E{(const bf16_t*)(F.ws + WS_XB), (bf16_t*)(F.ws + WS_VB), p.dry, FP8_DDN ? 1.0f / 64.0f : 1.0f};
    pg8::gemm_phase<EpiRes, pg8::PlainOrder, true, FP8_DDN != 0>(F.lds, g, S, E, F.tid); }
PHASE_FN ph_ln2(PArgs p) { Frame F = make_frame(p); const int l = p.l; phase_ln<0>(F, INP(14) + l * DM, INP(15) + l * DM, l + 1 < DEPTH, 0, p.dry); }
PHASE_FN ph_moe_perm(PArgs p) { Frame F = make_frame(p); phase_moe_permute(F, p.l >> 1); }
PHASE_FN ph_moe_gu(PArgs p) { Frame F = make_frame(p);
    moe_table(F, p.l >> 1);
    pg8::Dims g{DM, DM, DM}; MoeOrder S{F.G, F.bid, 2 * DFF / 256, (const LAS int*)(F.MISC + 32), (const char*)(F.ws + R_APERM), (const char*)(F.ws + W_FFN), (size_t)256 * DM * (FP8_MOE ? 1 : 2), (size_t)256 * DM * (FP8_MOE ? 1 : 2), (size_t)3 * DM * DFF * 2};
    EpiSwigluT<FP8_MOE != 0> E{(bf16_t*)(F.ws + R_HIDM), p.dry};
    pg8::gemm_phase<EpiSwigluT<FP8_MOE != 0>, MoeOrder, true, FP8_MOE != 0>(F.lds, g, S, E, F.tid); }
PHASE_FN ph_moe_dn(PArgs p) { Frame F = make_frame(p);
    moe_table(F, p.l >> 1);
    pg8::Dims g{DFF, DFF, DFF}; MoeOrder S{F.G, F.bid, DM / 256, (const LAS int*)(F.MISC + 32), (const char*)(F.ws + R_HIDM), (const char*)(F.ws + W_FFN + (size_t)2 * DM * DFF * 2), (size_t)256 * DFF * (FP8_MOE ? 1 : 2), (size_t)256 * DFF * (FP8_MOE ? 1 : 2), (size_t)3 * DM * DFF * 2};
    EpiBf16<0> E{(bf16_t*)(F.ws + R_DN), DM, FP8_MOE ? 1.0f / 64.0f : 1.0f};
    pg8::gemm_phase<EpiBf16<0>, MoeOrder, true, FP8_MOE != 0>(F.lds, g, S, E, F.tid); }
PHASE_FN ph_moe_ln2(PArgs p) { Frame F = make_frame(p); const int l = p.l; phase_ln<2>(F, INP(14) + l * DM, INP(15) + l * DM, l + 1 < DEPTH, l >> 1, p.dry); }

__global__ void __launch_bounds__(NTHREADS, 2) mega(Args args) {
    extern __shared__ __attribute__((aligned(16))) unsigned char lds_raw[];
    LAS unsigned char* lds = (LAS unsigned char*)lds_raw;
    volatile LAS unsigned* MISC = (volatile LAS unsigned*)(lds + MISC_OFF);
    const int wave_s = __builtin_amdgcn_readfirstlane((int)(threadIdx.x >> 6));
    for (int u = wave_s * 64 + lane_id(); u < (LDS_BYTES - MISC_OFF) / 4; u += NTHREADS) ((LAS unsigned*)(lds + MISC_OFF))[u] = 0u;
    __syncthreads();
    unsigned* ctl = (unsigned*)(args.ws + WS_CTL);
    XcdBarrier bar; bar.bar = ctl + CW_BAR; bar.x = 0; bar.st = nullptr;
    if (!MK_PER_PHASE) bar = xcd_barrier_post(ctl + CW_BAR, MISC + 8, wave_s == 0 && lane_id() == 0);
    const int lo = args.ph_lo, hi = args.ph_hi;
    int pc = 0;
    PArgs P; P.ws = args.ws; P.xf = args.out; P.in = args.in; P.l = 0; P.dry = 0; P.wave = wave_s;
#ifndef PHMASK
#define PHMASK 0xFFFFFFFFu
#endif
#if DBG_CHECK == 3
#define PH_BEGIN(k) if ((((PHMASK) >> (k)) & 1u) && pc >= lo && pc < hi) { const int slot_ = (k); const unsigned long long t0_ = __builtin_amdgcn_s_memrealtime();
#define PH_END   if (pc + 1 < hi) { if (!MK_PER_PHASE) xcd_barrier(bar, wave_s == 0 && lane_id() == 0); } if (blockIdx.x == 0 && wave_s == 0 && lane_id() == 0) { const float us_ = (float)(__builtin_amdgcn_s_memrealtime() - t0_) * 0.01f; float* tp_ = (float*)(ctl + CW_TS + slot_); *tp_ = *tp_ + us_; } } ++pc;
#else
#define PH_BEGIN(k) if ((((PHMASK) >> (k)) & 1u) && pc >= lo && pc < hi) {
#if TIME_DUP == 18
#define PH_END   if (pc + 1 < hi) { xcd_barrier(bar, wave_s == 0 && lane_id() == 0); xcd_barrier(bar, wave_s == 0 && lane_id() == 0); xcd_barrier(bar, wave_s == 0 && lane_id() == 0); xcd_barrier(bar, wave_s == 0 && lane_id() == 0); } } ++pc;
#else
#define PH_END   if (pc + 1 < hi) { if (!MK_PER_PHASE) xcd_barrier(bar, wave_s == 0 && lane_id() == 0); } } ++pc;
#endif
#endif

    PH_BEGIN(0) {
#if TIME_DUP == 19
        ph_init(P);
#endif
        ph_init(P); } PH_END
    for (int l = 0; l < DEPTH; ++l) {
        P.l = l;
        PH_BEGIN(1) ph_weights(P); PH_END
#if DBG_CHECK == 2
        if (l == DBG_LAYER) { ph_dbg_snapm(P); xcd_barrier(bar, wave_s == 0 && lane_id() == 0); }
#endif
#if TIME_DUP == 20
        { int nrep2_ = 2; asm volatile("" : "+s"(nrep2_)); const int pc0_ = pc; for (int r2_ = 0; r2_ < nrep2_; ++r2_) { pc = pc0_;
#endif
        PH_BEGIN(2) {
#if TIME_DUP == 4
            int nrep_ = 2; asm volatile("" : "+s"(nrep_));
            for (int r_ = 0; r_ < nrep_; ++r_) { if (r_) xcd_barrier(bar, wave_s == 0 && lane_id() == 0); ph_in_a(P); }
#else
            ph_in_a(P);
#endif
        } PH_END
        PH_BEGIN(3) {
#if TIME_DUP == 5
            ph_cmp1(P); ph_conv(P); ph_ret_kv(P);
#endif
#if TIME_DUP == 24
            { int nr_ = 2; asm volatile("" : "+s"(nr_)); for (int r_ = 1; r_ < nr_; ++r_) { ph_cmp1(P); ph_conv(P); ph_ret_kv(P); ph_window(P); xcd_barrier(bar, wave_s == 0 && lane_id() == 0); } }
#endif
            ph_cmp1(P); ph_conv(P); ph_ret_kv(P); ph_window(P); } PH_END
        PH_BEGIN(4) {
#if TIME_DUP == 6
            ph_cmp2_scan(P);
#endif
#if TIME_DUP == 25
            { int nr_ = 2; asm volatile("" : "+s"(nr_)); for (int r_ = 1; r_ < nr_; ++r_) { ph_cmp2_scan(P); xcd_barrier(bar, wave_s == 0 && lane_id() == 0); } }
#endif
            ph_cmp2_scan(P); } PH_END
        PH_BEGIN(5) {
#if TIME_DUP == 7
            ph_ret_out(P);
#endif
#if TIME_DUP == 26
            { int nr_ = 2; asm volatile("" : "+s"(nr_)); for (int r_ = 1; r_ < nr_; ++r_) { ph_ret_out(P); xcd_barrier(bar, wave_s == 0 && lane_id() == 0); } }
#endif
#if TIME_DUP == 23
            { int nr_ = 2; asm volatile("" : "+s"(nr_)); P.dry = 1; for (int r_ = 1; r_ < nr_; ++r_) { ph_cmp_slc(P); xcd_barrier(bar, wave_s == 0 && lane_id() == 0); } P.dry = 0; }
#endif
            ph_cmp_slc(P); ph_ret_out(P); } PH_END
#if DBG_CHECK == 4
        if (l == DBG_LAYER) { ph_dbg_nsa(P); xcd_barrier(bar, wave_s == 0 && lane_id() == 0); }
#endif
        ++pc;
        PH_BEGIN(7) {
#if TIME_DUP == 8
            ph_merge(P);
#endif
#if TIME_DUP == 30
            { int nr_ = 2; asm volatile("" : "+s"(nr_)); for (int r_ = 1; r_ < nr_; ++r_) { ph_merge_nomid(P); xcd_barrier(bar, wave_s == 0 && lane_id() == 0); } }
#endif
#if TIME_DUP == 27
            { int nr_ = 2; asm volatile("" : "+s"(nr_)); for (int r_ = 1; r_ < nr_; ++r_) { ph_merge(P); xcd_barrier(bar, wave_s == 0 && lane_id() == 0); } }
#endif
            ph_merge(P); } PH_END
#if TIME_DUP == 20
        } }
#endif
        PH_BEGIN(8) {
#if TIME_DUP == 11
            P.dry = 1; ph_out(P); P.dry = 0;
#endif
            ph_out(P); } PH_END
        PH_BEGIN(9) {
#if TIME_DUP == 12
            P.dry = 1; ph_ln1(P); P.dry = 0;
#endif
            ph_ln1(P); } PH_END
#if DBG_CHECK == 1
        if (l == DBG_LAYER) { ph_dbg_snap(P); xcd_barrier(bar, wave_s == 0 && lane_id() == 0); }
#endif
#if DBG_CHECK == 2
        if (l == DBG_LAYER) { ph_dbg_mixer(P); xcd_barrier(bar, wave_s == 0 && lane_id() == 0); }
#endif
        if (!(l & 1)) {
            PH_BEGIN(10) {
#if TIME_DUP == 9
                ph_ffn_gu(P);
#elif TIME_DUP == 28
                P.dry = 1; ph_ffn_gu(P); P.dry = 0;
#endif
                ph_ffn_gu(P); } PH_END
            PH_BEGIN(11) {
#if TIME_DUP == 13
            P.dry = 1; ph_ffn_dn(P); P.dry = 0;
#endif
            ph_ffn_dn(P); } PH_END
            PH_BEGIN(12) {
#if TIME_DUP == 14
            P.dry = 1; ph_ln2(P); P.dry = 0;
#endif
            ph_ln2(P); } PH_END
#if DBG_CHECK == 1
            if (l == DBG_LAYER) { ph_dbg_ffn(P); xcd_barrier(bar, wave_s == 0 && lane_id() == 0); }
#endif
            ++pc;
        } else {
            PH_BEGIN(13) {
#if TIME_DUP == 15
            ph_moe_perm(P);
#endif
            ph_moe_perm(P); } PH_END
            PH_BEGIN(14) {
#if TIME_DUP == 10
                ph_moe_gu(P);
#endif
                ph_moe_gu(P); } PH_END
            PH_BEGIN(15) {
#if TIME_DUP == 16
            ph_moe_dn(P);
#endif
            ph_moe_dn(P); } PH_END
            PH_BEGIN(16) {
#if TIME_DUP == 17
            P.dry = 1; ph_moe_ln2(P); P.dry = 0;
#endif
            ph_moe_ln2(P); } PH_END
#if DBG_CHECK == 1
            if (l == DBG_LAYER) { xcd_barrier(bar, wave_s == 0 && lane_id() == 0); ph_dbg_ffn(P); xcd_barrier(bar, wave_s == 0 && lane_id() == 0); }
#endif
        }
    }
#if DBG_CHECK == 3
    xcd_barrier(bar, wave_s == 0 && lane_id() == 0); ph_dbg_tscale(P);
#elif DBG_CHECK
    xcd_barrier(bar, wave_s == 0 && lane_id() == 0); ph_dbg_scale(P);
#endif
#undef PH_BEGIN
#undef PH_END
}

extern "C" void kernel_launch(void* const* d_in, const int* in_sizes, int n_in, void* d_out, int out_size, void* d_ws, size_t ws_size, hipStream_t stream) {
    static int grid = 0;
    if (grid == 0) {
        if (n_in != 23 || out_size != MTOK * DM || ws_size < WS_END + ((DBG_CHECK && DBG_CHECK != 4) ? 16 * MiB : 0)) { fprintf(stderr, "kernel_launch: unexpected shapes (n_in %d out %d ws %zu need %zu)\n", n_in, out_size, ws_size, (size_t)WS_END); grid = -1; return; }
        int dev = 0, cus = 0, per_cu = 0;
        if (hipGetDevice(&dev) != hipSuccess || hipDeviceGetAttribute(&cus, hipDeviceAttributeMultiprocessorCount, dev) != hipSuccess) { grid = -1; return; }
        if (hipFuncSetAttribute((const void*)mega, hipFuncAttributeMaxDynamicSharedMemorySize, LDS_BYTES) != hipSuccess) { fprintf(stderr, "kernel_launch: hipFuncSetAttribute failed\n"); grid = -1; return; }
        if (hipOccupancyMaxActiveBlocksPerMultiprocessor(&per_cu, (const void*)mega, NTHREADS, LDS_BYTES) != hipSuccess || per_cu < 1) { fprintf(stderr, "kernel_launch: occupancy query says %d\n", per_cu); (void)hipGetLastError(); }
        grid = cus;
        if (grid != 256) { fprintf(stderr, "kernel_launch: built for a 256-CU device (unit deals assume 256 workgroups), found %d CUs; nothing launched\n", cus); grid = -1; return; }
    }
    if (grid < 0) return;
    if (hipMemsetAsync((char*)d_ws + WS_CTL, 0, CTL_ZERO_BYTES, stream) != hipSuccess) return;
    Args a{};
    for (int i = 0; i < 23; ++i) a.in[i] = (const float*)d_in[i];
    a.out = (float*)d_out; a.ws = (unsigned char*)d_ws;
#if MK_PER_PHASE
    for (int p = 0; p < N_PHASES; ++p) { a.ph_lo = p; a.ph_hi = p + 1; hipLaunchKernelGGL(mega, dim3(grid), dim3(NTHREADS), LDS_BYTES, stream, a); }
#else
    a.ph_lo = 0; a.ph_hi = N_PHASES;
    hipLaunchKernelGGL(mega, dim3(grid), dim3(NTHREADS), LDS_BYTES, stream, a);
#endif
}
```
